# Optimizing an MI355X kernel written in HIP

```python
import functools
import jax, jax.numpy as jnp
from jax import lax
import numpy as np

D_MODEL = 2048
BATCH = 4
SEQ = 4096
DEPTH = 2

GRID_W = 64
CTX_LEN = 256
N_EVEN = (DEPTH + 1) // 2
N_ODD = DEPTH // 2
D_FF = 5504
N_MOD = 9
EPS = 1e-6
CHUNK = 128
Q_BLOCK = 128
ROPE_BASE = 10000.0
NEG_BIG = -1e30

RET_HEADS = 4
RET_DK = 128
RET_DV = 256
MLSTM_HEADS = 4
MLSTM_DK = 128
MLSTM_DV = 256
LRU_WIDTH = 1024
LRU_BLOCKS = 8
LRU_BLOCK = LRU_WIDTH // LRU_BLOCKS
LRU_CONV = 4
LRU_C = 8.0
MLA_HEADS = 8
MLA_Q_RANK = 512
MLA_KV_RANK = 256
MLA_NOPE = 128
MLA_ROPE = 64
MLA_V = 128

AB_SPLITS = (RET_HEADS * RET_DK, RET_HEADS * RET_DK, RET_HEADS * RET_DV, RET_HEADS * RET_DV,
             MLSTM_HEADS * MLSTM_DK, MLSTM_HEADS * MLSTM_DK, MLSTM_HEADS * MLSTM_DV, MLSTM_HEADS * MLSTM_DV,
             4 * MLSTM_HEADS)
AB_IN = sum(AB_SPLITS)
AB_OUT = RET_HEADS * RET_DV + MLSTM_HEADS * MLSTM_DV
CD_SPLITS = (LRU_WIDTH, LRU_WIDTH, MLA_Q_RANK, MLA_KV_RANK, MLA_ROPE)
CD_IN = sum(CD_SPLITS)
CD_OUT = LRU_WIDTH + MLA_HEADS * MLA_V

kernel_name = "hybrid_retention_mlstm_rglru_mla_dit"

F32 = jnp.float32


def split_cols(p, sizes):
    return jnp.split(p, np.cumsum(sizes)[:-1].tolist(), axis=-1)


def split_heads(t, n_heads):
    return t.reshape(t.shape[0], t.shape[1], n_heads, -1)


def rms_norm(x, g):
    xf = x.astype(F32)
    y = xf * lax.rsqrt(jnp.mean(xf * xf, axis=-1, keepdims=True) + EPS)
    return (y * g.astype(F32)).astype(x.dtype)


def head_layernorm(y, g):
    yf = y.astype(F32)
    mu = jnp.mean(yf, axis=-1, keepdims=True)
    var = jnp.mean(jnp.square(yf - mu), axis=-1, keepdims=True)
    yn = (yf - mu) * lax.rsqrt(var + EPS)
    return yn.reshape(y.shape[0], y.shape[1], -1) * g.astype(F32)


def modulate(h, shift, scale):
    return h * (1.0 + scale) + shift


def adaln(cond, w, b):
    return jnp.split(jax.nn.silu(cond) @ w + b, N_MOD, axis=-1)


def half_ffn(x, g, shift, scale, gate, wg, wu, wd):
    h = modulate(rms_norm(x, g), shift, scale)
    return x + 0.5 * gate * ((jax.nn.silu(h @ wg) * (h @ wu)) @ wd)


def rope_rotate(x, ang):
    m = ang.shape[-1]
    cos = jnp.cos(ang)[:, None, :].astype(x.dtype)
    sin = jnp.sin(ang)[:, None, :].astype(x.dtype)
    x1, x2 = x[..., :m], x[..., m:]
    return jnp.concatenate([x1 * cos - x2 * sin, x1 * sin + x2 * cos], axis=-1)


def grid_positions(n_tokens):
    rows = n_tokens // GRID_W
    row = jnp.repeat(jnp.arange(rows, dtype=F32), GRID_W)
    col = jnp.tile(jnp.arange(GRID_W, dtype=F32), rows)
    return row, col


def axial_rope(x):
    row, col = grid_positions(x.shape[1])
    half = MLA_ROPE // 2
    freqs = ROPE_BASE ** (-jnp.arange(half // 2, dtype=F32) / (half // 2))
    xn = x[..., :MLA_NOPE]
    xr = x[..., MLA_NOPE:MLA_NOPE + half]
    xc = x[..., MLA_NOPE + half:]
    return jnp.concatenate([xn, rope_rotate(xr, row[:, None] * freqs), rope_rotate(xc, col[:, None] * freqs)], axis=-1)


def retnet_angles(n_tokens):
    freqs = ROPE_BASE ** (-jnp.arange(RET_DK // 2, dtype=F32) / (RET_DK // 2))
    return jnp.arange(n_tokens, dtype=F32)[:, None] * freqs


def dwconv_centred(x, w, b):
    k = w.shape[0]
    out = lax.conv_general_dilated(x, w[:, None, :].astype(x.dtype), window_strides=(1,),
                                   padding=[(k // 2, k - 1 - k // 2)],
                                   dimension_numbers=('NWC', 'WIO', 'NWC'),
                                   feature_group_count=x.shape[-1])
    return out + b


def bidirectional(scan_fwd, scan_bwd, ctx_f, lat_f, ctx_b, lat_b, state0):
    flip = lambda t: jnp.flip(t, axis=1)
    yc_f, st_f = scan_fwd(ctx_f, state0)
    yl_f, _ = scan_fwd(lat_f, st_f)
    yc_b, st_b = scan_bwd(tuple(flip(t) for t in ctx_b), state0)
    yl_b, _ = scan_bwd(tuple(flip(t) for t in lat_b), st_b)
    return yl_f + flip(yl_b), yc_f + flip(yc_b)


def retention_chunkwise(seq, s0, log_gamma):
    q, k, v = seq
    B, T, H, dk = q.shape
    dv = v.shape[-1]
    n = T // CHUNK
    qc = q.reshape(B, n, CHUNK, H, dk)
    kc = k.reshape(B, n, CHUNK, H, dk)
    vc = v.reshape(B, n, CHUNK, H, dv)
    pos = jnp.arange(CHUNK, dtype=F32)
    rel = pos[:, None] - pos[None, :]
    decay = jnp.where((rel >= 0)[None], jnp.exp(jnp.maximum(rel, 0.0)[None] * log_gamma[:, None, None]), 0.0)
    scores = jnp.einsum('bnqhd,bnkhd->bnhqk', qc, kc) * decay
    inner = jnp.einsum('bnhqk,bnkhe->bnqhe', scores, vc)
    zeta = jnp.exp((CHUNK - 1.0 - pos)[:, None] * log_gamma[None, :])
    u = jnp.einsum('bnchd,bnche->bnhde', kc * zeta[:, :, None], vc).astype(F32)
    gamma_chunk = jnp.exp(CHUNK * log_gamma)[None, :, None, None]

    def step(s, u_j):
        return gamma_chunk * s + u_j, s

    s_last, s_prev = lax.scan(step, s0, jnp.moveaxis(u, 1, 0))
    s_prev = jnp.moveaxis(s_prev, 0, 1)
    xi = jnp.exp((pos + 1.0)[:, None] * log_gamma[None, :])
    cross = jnp.einsum('bnqhd,bnhde->bnqhe', qc, s_prev) * xi[:, :, None]
    return (inner + cross).reshape(B, T, H, dv), s_last


def mlstm_chunkwise(seq, state):
    q, k, v, i_pre, log_f = seq
    B, T, H, dk = q.shape
    dv = v.shape[-1]
    n = T // CHUNK
    qc = (q * dk ** -0.5).reshape(B, n, CHUNK, H, dk)
    kc = k.reshape(B, n, CHUNK, H, dk)
    vc = v.reshape(B, n, CHUNK, H, dv)
    ic = i_pre.reshape(B, n, CHUNK, H)
    b = jnp.cumsum(log_f.reshape(B, n, CHUNK, H), axis=2)
    lower = jnp.tril(jnp.ones((CHUNK, CHUNK), dtype=bool))
    log_d = jnp.where(lower[None, None, :, :, None],
                      b[:, :, :, None, :] - b[:, :, None, :, :] + ic[:, :, None, :, :], -jnp.inf)
    m_intra = jnp.max(log_d, axis=3)
    b_last = b[:, :, -1]
    log_w = b_last[:, :, None] - b + ic
    m_loc = jnp.max(log_w, axis=2)
    kw = kc * jnp.exp(log_w - m_loc[:, :, None])[..., None]
    u_c = jnp.einsum('bnchd,bnche->bnhde', kw, vc).astype(F32)
    u_n = jnp.sum(kw, axis=2).astype(F32)

    def step(carry, inp):
        c_s, n_s, m_s = carry
        uc, un, ml, bl = inp
        m_new = jnp.maximum(bl + m_s, ml)
        a = jnp.exp(bl + m_s - m_new)
        g = jnp.exp(ml - m_new)
        new = (a[..., None, None] * c_s + g[..., None, None] * uc, a[..., None] * n_s + g[..., None] * un, m_new)
        return new, carry

    final, prev = lax.scan(step, state, tuple(jnp.moveaxis(t, 1, 0) for t in (u_c, u_n, m_loc, b_last)))
    c_prev, n_prev, m_prev = (jnp.moveaxis(t, 0, 1) for t in prev)
    log_inter = b + m_prev[:, :, None]
    m_t = jnp.maximum(log_inter, m_intra)
    d = jnp.exp(log_d - m_t[:, :, :, None])
    s = jnp.einsum('bnqhd,bnkhd->bnqkh', qc, kc) * d
    inter = jnp.exp(log_inter - m_t)
    num = jnp.einsum('bnqkh,bnkhe->bnqhe', s, vc) + jnp.einsum('bnqhd,bnhde->bnqhe', qc, c_prev) * inter[..., None]
    den = jnp.sum(s, axis=3) + jnp.einsum('bnqhd,bnhd->bnqh', qc, n_prev) * inter
    h = num / jnp.maximum(jnp.abs(den), jnp.exp(-m_t))[..., None]
    return h.reshape(B, T, H, dv), final


def lru_scan(seq, h0):
    a, b = seq
    acc_a, acc_b = lax.associative_scan(lambda e1, e2: (e1[0] * e2[0], e2[0] * e1[1] + e2[1]), (a, b), axis=1)
    h = acc_a * h0[:, None, :] + acc_b
    return h, h[:, -1]


def lru_coeffs(xc, wa, ba, wx, bx, lam):
    xb = xc.reshape(xc.shape[0], xc.shape[1], LRU_BLOCKS, LRU_BLOCK)
    r = jax.nn.sigmoid(jnp.einsum('btgi,gij->btgj', xb, wa.astype(F32)).reshape(xc.shape) + ba.astype(F32))
    i = jax.nn.sigmoid(jnp.einsum('btgi,gij->btgj', xb, wx.astype(F32)).reshape(xc.shape) + bx.astype(F32))
    log_a = -LRU_C * r * jax.nn.softplus(-lam.astype(F32))
    a = jnp.exp(log_a)
    return a, jnp.sqrt(-jnp.expm1(2.0 * log_a)) * (i * xc)


def attend_blocks(q, k, v):
    B, S, H, d = q.shape
    nb = S // Q_BLOCK
    qb = jnp.moveaxis(q.reshape(B, nb, Q_BLOCK, H, d), 1, 0)
    kf = k.astype(F32)
    scale = d ** -0.5

    def one(q_blk):
        s = jnp.einsum('bqhd,bkhd->bhqk', q_blk.astype(F32), kf) * scale
        p = jax.nn.softmax(s, axis=-1)
        return jnp.einsum('bhqk,bkhe->bqhe', p.astype(v.dtype), v)

    o = lax.map(one, qb)
    return jnp.moveaxis(o, 0, 1).reshape(B, S, H, v.shape[-1])


def mixer_ab(h, hc, w_in, w_out, decay_logit, ret_gn_g, gate_b, mlstm_gn_g, need_ctx):
    dt = h.dtype
    B = h.shape[0]
    lat = split_cols(h @ w_in, AB_SPLITS)
    ctx = split_cols(hc @ w_in, AB_SPLITS)
    ang = retnet_angles(h.shape[1])
    log_gamma = jax.nn.log_sigmoid(decay_logit.astype(F32))

    def ret_seq(parts, rotate):
        q = split_heads(parts[0], RET_HEADS)
        k = split_heads(parts[1], RET_HEADS)
        v = split_heads(parts[2], RET_HEADS)
        if rotate:
            q, k = rope_rotate(q, ang), rope_rotate(k, ang)
        return (q, k * RET_DK ** -0.5, v)

    r_lat, r_ctx = ret_seq(lat, True), ret_seq(ctx, False)
    s0 = jnp.zeros((B, RET_HEADS, RET_DK, RET_DV), F32)
    ret_l, ret_c = bidirectional(functools.partial(retention_chunkwise, log_gamma=log_gamma[0]),
                                 functools.partial(retention_chunkwise, log_gamma=log_gamma[1]),
                                 r_ctx, r_lat, r_ctx, r_lat, s0)

    def mlstm_seqs(parts):
        q = split_heads(parts[4], MLSTM_HEADS)
        k = split_heads(parts[5], MLSTM_HEADS)
        v = split_heads(parts[6], MLSTM_HEADS)
        g = parts[8].astype(F32).reshape(q.shape[0], q.shape[1], 4, MLSTM_HEADS) + gate_b.astype(F32)
        fwd = (q, k, v, g[:, :, 0], jax.nn.log_sigmoid(g[:, :, 1]))
        bwd = (q, k, v, g[:, :, 2], jax.nn.log_sigmoid(g[:, :, 3]))
        return fwd, bwd

    ml_f, ml_b = mlstm_seqs(lat)
    mc_f, mc_b = mlstm_seqs(ctx)
    st0 = (jnp.zeros((B, MLSTM_HEADS, MLSTM_DK, MLSTM_DV), F32),
           jnp.zeros((B, MLSTM_HEADS, MLSTM_DK), F32),
           jnp.full((B, MLSTM_HEADS), NEG_BIG, F32))
    ml_l, ml_c = bidirectional(mlstm_chunkwise, mlstm_chunkwise, mc_f, ml_f, mc_b, ml_b, st0)

    def merge(ret, ml, parts):
        ret_y = jax.nn.silu(parts[3]) * head_layernorm(ret, ret_gn_g).astype(dt)
        ml_y = jax.nn.sigmoid(parts[7]) * head_layernorm(ml, mlstm_gn_g).astype(dt)
        return jnp.concatenate([ret_y, ml_y], axis=-1) @ w_out

    y = merge(ret_l, ml_l, lat)
    yc = merge(ret_c, ml_c, ctx) if need_ctx else None
    return y, yc


def mla_qkv(cq, ckv, kr, q_norm_g, kv_norm_g, w_uq, w_uk, w_uv, qk_norm_g, rotate):
    B, T, _ = cq.shape
    q = (rms_norm(cq, q_norm_g) @ w_uq).reshape(B, T, MLA_HEADS, MLA_NOPE + MLA_ROPE)
    ckv = rms_norm(ckv, kv_norm_g)
    k_nope = (ckv @ w_uk).reshape(B, T, MLA_HEADS, MLA_NOPE)
    v = (ckv @ w_uv).reshape(B, T, MLA_HEADS, MLA_V)
    k_rope = jnp.broadcast_to(kr[:, :, None, :], (B, T, MLA_HEADS, MLA_ROPE))
    k = jnp.concatenate([k_nope, k_rope], axis=-1)
    q = rms_norm(q, qk_norm_g[0])
    k = rms_norm(k, qk_norm_g[1])
    if rotate:
        q, k = axial_rope(q), axial_rope(k)
    return q, k, v


def mixer_cd(h, hc, w_in, w_out, conv_w, conv_b, wa, ba, wx, bx, lam,
             q_norm_g, kv_norm_g, w_uq, w_uk, w_uv, qk_norm_g, need_ctx):
    dt = h.dtype
    B, S, _ = h.shape
    yb, xb, cq, ckv, kr = split_cols(h @ w_in, CD_SPLITS)
    ybc, xbc, cqc, ckvc, krc = split_cols(hc @ w_in, CD_SPLITS)
    xl = dwconv_centred(xb, conv_w, conv_b).astype(F32)
    xcx = dwconv_centred(xbc, conv_w, conv_b).astype(F32)
    lat_f = lru_coeffs(xl, wa[0], ba[0], wx[0], bx[0], lam[0])
    lat_b = lru_coeffs(xl, wa[1], ba[1], wx[1], bx[1], lam[1])
    ctx_f = lru_coeffs(xcx, wa[0], ba[0], wx[0], bx[0], lam[0])
    ctx_b = lru_coeffs(xcx, wa[1], ba[1], wx[1], bx[1], lam[1])
    h0 = jnp.zeros((B, LRU_WIDTH), F32)
    rl, rc = bidirectional(lru_scan, lru_scan, ctx_f, lat_f, ctx_b, lat_b, h0)
    q, k, v = mla_qkv(cq, ckv, kr, q_norm_g, kv_norm_g, w_uq, w_uk, w_uv, qk_norm_g, True)
    qc, kc, vc = mla_qkv(cqc, ckvc, krc, q_norm_g, kv_norm_g, w_uq, w_uk, w_uv, qk_norm_g, False)
    att = attend_blocks(q, jnp.concatenate([kc, k], axis=1), jnp.concatenate([vc, v], axis=1))
    y = jnp.concatenate([jax.nn.gelu(yb) * rl.astype(dt), att.reshape(B, S, MLA_HEADS * MLA_V)], axis=-1) @ w_out
    yc = None
    if need_ctx:
        att_c = attend_blocks(qc, kc, vc)
        yc = jnp.concatenate([jax.nn.gelu(ybc) * rc.astype(dt),
                              att_c.reshape(B, hc.shape[1], MLA_HEADS * MLA_V)], axis=-1) @ w_out
    return y, yc


def setup_inputs(seed: int = 0) -> dict:
    key = jax.random.key(seed)
    keys = iter(jax.random.split(key, 40))

    def nrm(shape, std):
        return jax.random.normal(next(keys), shape, F32) * std

    D = D_MODEL
    x = nrm((BATCH, SEQ, D), 1.0)
    c = nrm((BATCH, D), 1.0)
    ctx = nrm((BATCH, CTX_LEN, D), 1.0)
    c_ctx = nrm((D,), 1.0)
    ada_w = nrm((DEPTH, D, N_MOD * D), 0.5 * D ** -0.5)
    ada_b = nrm((DEPTH, N_MOD * D), 0.01)
    norm_g = 1.0 + nrm((DEPTH, 3, D), 0.01)
    ffn_wg = nrm((DEPTH, 2, D, D_FF), D ** -0.5)
    ffn_wu = nrm((DEPTH, 2, D, D_FF), D ** -0.5)
    ffn_wd = nrm((DEPTH, 2, D_FF, D), D_FF ** -0.5)
    ab_w_in = nrm((N_EVEN, D, AB_IN), D ** -0.5)
    ab_w_out = nrm((N_EVEN, AB_OUT, D), AB_OUT ** -0.5)
    gamma = 1.0 - 2.0 ** (-jnp.linspace(5.0, 12.0, RET_HEADS))
    ret_decay_logit = (jnp.log(gamma) - jnp.log1p(-gamma)) + nrm((N_EVEN, 2, RET_HEADS), 0.1)
    ret_gn_g = 1.0 + nrm((N_EVEN, RET_HEADS * RET_DV), 0.01)
    f_bias = jnp.linspace(3.0, 6.0, MLSTM_HEADS)
    mlstm_gate_b = jnp.stack([nrm((N_EVEN, MLSTM_HEADS), 0.1), f_bias + nrm((N_EVEN, MLSTM_HEADS), 0.1),
                              nrm((N_EVEN, MLSTM_HEADS), 0.1), f_bias + nrm((N_EVEN, MLSTM_HEADS), 0.1)], axis=1)
    mlstm_gn_g = 1.0 + nrm((N_EVEN, MLSTM_HEADS * MLSTM_DV), 0.01)
    cd_w_in = nrm((N_ODD, D, CD_IN), D ** -0.5)
    cd_w_out = nrm((N_ODD, CD_OUT, D), CD_OUT ** -0.5)
    lru_conv_w = nrm((N_ODD, LRU_CONV, LRU_WIDTH), LRU_CONV ** -0.5)
    lru_conv_b = nrm((N_ODD, LRU_WIDTH), 0.01)
    lru_wa = nrm((N_ODD, 2, LRU_BLOCKS, LRU_BLOCK, LRU_BLOCK), LRU_BLOCK ** -0.5)
    lru_ba = nrm((N_ODD, 2, LRU_WIDTH), 0.01)
    lru_wx = nrm((N_ODD, 2, LRU_BLOCKS, LRU_BLOCK, LRU_BLOCK), LRU_BLOCK ** -0.5)
    lru_bx = nrm((N_ODD, 2, LRU_WIDTH), 0.01)
    a_init = jax.random.uniform(next(keys), (N_ODD, 2, LRU_WIDTH), F32, 0.9, 0.999) ** (1.0 / LRU_C)
    lru_lambda = jnp.log(a_init) - jnp.log1p(-a_init)
    mla_q_norm_g = 1.0 + nrm((N_ODD, MLA_Q_RANK), 0.01)
    mla_kv_norm_g = 1.0 + nrm((N_ODD, MLA_KV_RANK), 0.01)
    mla_w_uq = nrm((N_ODD, MLA_Q_RANK, MLA_HEADS * (MLA_NOPE + MLA_ROPE)), MLA_Q_RANK ** -0.5)
    mla_w_uk = nrm((N_ODD, MLA_KV_RANK, MLA_HEADS * MLA_NOPE), MLA_KV_RANK ** -0.5)
    mla_w_uv = nrm((N_ODD, MLA_KV_RANK, MLA_HEADS * MLA_V), MLA_KV_RANK ** -0.5)
    mla_qk_norm_g = 1.0 + nrm((N_ODD, 2, MLA_NOPE + MLA_ROPE), 0.01)
    return {"x": x, "c": c, "ctx": ctx, "c_ctx": c_ctx, "ada_w": ada_w, "ada_b": ada_b, "norm_g": norm_g,
            "ffn_wg": ffn_wg, "ffn_wu": ffn_wu, "ffn_wd": ffn_wd, "ab_w_in": ab_w_in, "ab_w_out": ab_w_out,
            "ret_decay_logit": ret_decay_logit, "ret_gn_g": ret_gn_g, "mlstm_gate_b": mlstm_gate_b,
            "mlstm_gn_g": mlstm_gn_g, "cd_w_in": cd_w_in, "cd_w_out": cd_w_out, "lru_conv_w": lru_conv_w,
            "lru_conv_b": lru_conv_b, "lru_wa": lru_wa, "lru_ba": lru_ba, "lru_wx": lru_wx, "lru_bx": lru_bx,
            "lru_lambda": lru_lambda, "mla_q_norm_g": mla_q_norm_g, "mla_kv_norm_g": mla_kv_norm_g,
            "mla_w_uq": mla_w_uq, "mla_w_uk": mla_w_uk, "mla_w_uv": mla_w_uv, "mla_qk_norm_g": mla_qk_norm_g}


def reference(x, c, ctx, c_ctx, ada_w, ada_b, norm_g, ffn_wg, ffn_wu, ffn_wd, ab_w_in, ab_w_out,
              ret_decay_logit, ret_gn_g, mlstm_gate_b, mlstm_gn_g, cd_w_in, cd_w_out, lru_conv_w,
              lru_conv_b, lru_wa, lru_ba, lru_wx, lru_bx, lru_lambda, mla_q_norm_g, mla_kv_norm_g,
              mla_w_uq, mla_w_uk, mla_w_uv, mla_qk_norm_g):
    for l in range(DEPTH):
        need_ctx = l < DEPTH - 1
        ml = [m[:, None, :] for m in adaln(c, ada_w[l], ada_b[l])]
        mc = adaln(c_ctx, ada_w[l], ada_b[l])
        x = half_ffn(x, norm_g[l, 0], ml[0], ml[1], ml[2], ffn_wg[l, 0], ffn_wu[l, 0], ffn_wd[l, 0])
        ctx = half_ffn(ctx, norm_g[l, 0], mc[0], mc[1], mc[2], ffn_wg[l, 0], ffn_wu[l, 0], ffn_wd[l, 0])
        h = modulate(rms_norm(x, norm_g[l, 1]), ml[3], ml[4])
        hc = modulate(rms_norm(ctx, norm_g[l, 1]), mc[3], mc[4])
        j = l // 2
        if l % 2 == 0:
            y, yc = mixer_ab(h, hc, ab_w_in[j], ab_w_out[j], ret_decay_logit[j], ret_gn_g[j],
                             mlstm_gate_b[j], mlstm_gn_g[j], need_ctx)
        else:
            y, yc = mixer_cd(h, hc, cd_w_in[j], cd_w_out[j], lru_conv_w[j], lru_conv_b[j], lru_wa[j], lru_ba[j],
                             lru_wx[j], lru_bx[j], lru_lambda[j], mla_q_norm_g[j], mla_kv_norm_g[j],
                             mla_w_uq[j], mla_w_uk[j], mla_w_uv[j], mla_qk_norm_g[j], need_ctx)
        x = x + ml[5] * y
        x = half_ffn(x, norm_g[l, 2], ml[6], ml[7], ml[8], ffn_wg[l, 1], ffn_wu[l, 1], ffn_wd[l, 1])
        if need_ctx:
            ctx = ctx + mc[5] * yc
            ctx = half_ffn(ctx, norm_g[l, 2], mc[6], mc[7], mc[8], ffn_wg[l, 1], ffn_wu[l, 1], ffn_wd[l, 1])
    return x
```

```cpp
#include <hip/hip_runtime.h>
#include <cstdio>
#include <cstdint>
#define MK_ONE_LAUNCH 1
namespace pg8 {
#define PG8_LAS __attribute__((address_space(3)))
typedef unsigned short bf16_t;
typedef short bf16x8 __attribute__((ext_vector_type(8)));
typedef float f32x4 __attribute__((ext_vector_type(4)));
typedef unsigned u32x4 __attribute__((ext_vector_type(4)));
constexpr int BM = 256, BK = 64, HALF = 128, HTB = HALF * BK * 2  , STAGE_BYTES = 8 * HTB, NXCD = 8, WGM = 8;

__host__ __device__ __forceinline__ int lds_byte(int r, int c) { const int st = (r >> 4) * 2 + (c >> 5), rr = r & 15, cc = c & 31, ob = rr * 64 + cc * 2; return st * 1024 + (ob ^ (((ob >> 9) & 1) << 5)); }
__host__ __device__ __forceinline__ void stage_rc(int b, int& R, int& C) { const int st = b / 1024, sb = b % 1024, swz = sb ^ (((sb >> 9) & 1) << 5); R = (st >> 1) * 16 + swz / 64; C = (st & 1) * 32 + (swz % 64) / 2; }
__host__ __device__ __forceinline__ int perm32(int rho) { const int n = rho >> 4, i = rho & 15; return 8 * (i >> 2) + 4 * n + (i & 3); }

struct Unit { int pm, pn, koff, rot; };
struct Gemm { const bf16_t* A; const bf16_t* Bt; int M, N, K, ldk; };

struct SplitOrder {
    int c, koff;
    __host__ __device__ bool next(int i, Unit& u) const { if (i > 0 || c >= 256) return false; u.pm = c & 3; u.pn = (c >> 2) & 7; u.koff = koff; u.rot = 0; return true; }
    __device__ __forceinline__ void a_ready(const Unit&) const {}
    __device__ __forceinline__ void done(const Unit&) const {}
};
template <bool FIXA, bool FIXB> struct ProbeOrder;
struct SameTileOrder {
    int nwg, G, c;
    __host__ __device__ void init(int M, int N, int G_, int c_) { nwg = (M / BM) * (N / BM); G = G_; c = c_; }
    __host__ __device__ bool next(int i, Unit& u) const { const long L = (long)i * G + c; if (L >= nwg) return false; u.pm = 0; u.pn = 0; u.koff = 0; u.rot = 0; return true; }
    __device__ __forceinline__ void a_ready(const Unit&) const {}
    __device__ __forceinline__ void done(const Unit&) const {}
};
struct StaticOrder {
    int nM, nN, nwg, G, c, rot_en;
    __host__ __device__ void init(int M, int N, int G_, int c_, int rot_en_ = 0) { nM = M / BM; nN = N / BM; nwg = nM * nN; G = G_; c = c_; rot_en = rot_en_; }
    __host__ __device__ bool next(int i, Unit& u) const {
        const long L = (long)i * G + c; if (L >= nwg) return false;
        int wgid = (int)L; { const int q = nwg / NXCD, r = nwg % NXCD, xcd = wgid % NXCD, off = wgid / NXCD; wgid = (xcd < r ? xcd * (q + 1) : r * (q + 1) + (xcd - r) * q) + off; }
        const int nig = WGM * nN, gid = wgid / nig, fm = gid * WGM, gsz = (nM - fm) < WGM ? (nM - fm) : WGM;
        u.pm = fm + ((wgid % nig) % gsz); u.pn = (wgid % nig) / gsz; u.koff = 0; u.rot = rot_en ? 2 * (((u.pm & 3) + (u.pn & 3) + i) & 3) : 0; return true;
    }
    __device__ __forceinline__ void a_ready(const Unit&) const {}
    __device__ __forceinline__ void done(const Unit&) const {}
};
typedef __bf16 bf16x2_t __attribute__((ext_vector_type(2)));
__device__ __forceinline__ unsigned cvt_pk_bf16(float lo, float hi) { bf16x2_t v = {(__bf16)lo, (__bf16)hi}; return __builtin_bit_cast(unsigned, v); }
template <class Epi, class Sched, bool ALIGN_EPI = false, bool SP2 = false>
__device__ __forceinline__ void gemm_phase(PG8_LAS unsigned char* lds, const Gemm g, const Sched& S, const Epi& E) {
    const int tid = threadIdx.x, wid = __builtin_amdgcn_readfirstlane(tid >> 6), lane = tid & 63, wr = wid >> 2, wc = wid & 3, fr = lane & 15, fq = lane >> 4;
    const int K = g.ldk, nt = g.K / BK;
    unsigned voffA[2], voffB[2];
#pragma unroll
    for (int i = 0; i < 2; ++i) { int R, C; stage_rc(tid * 16 + i * 8192, R, C); const int Rb = Epi::PERM ? ((R & ~31) + perm32(R & 31)) : R;
        voffA[i] = (unsigned)(R * K + C) * 2u; voffB[i] = (unsigned)(Rb * K + C) * 2u; }
    const size_t kstep = (size_t)(BK * 2);
    const size_t hstep = (size_t)HALF * K * 2;
    const size_t tstep = 2 * hstep;
    const unsigned ldsw = (unsigned)wid * 1024u;
    const int aoff = lds_byte(wr * 64 + fr, fq * 8), boff = lds_byte(wc * 32 + fr, fq * 8);
#define PG8_SA(b, h) (((b) * 2 + (h)) * HTB)
#define PG8_SB(b, h) ((4 + (b) * 2 + (h)) * HTB)
#define PG8_STAGE(bufoff, gbase, voff) do { _Pragma("unroll") for (int _i = 0; _i < 2; ++_i) \
        __builtin_amdgcn_global_load_lds((const unsigned*)((const char*)(gbase) + (voff)[_i]), (PG8_LAS unsigned*)(lds + (bufoff) + ldsw + _i * 8192), 16, 0, 0); } while (0)
#define PG8_LDA(dst, b, h) do { _Pragma("unroll") for (int m = 0; m < 4; ++m) _Pragma("unroll") for (int k = 0; k < 2; ++k) dst[m][k] = *(const PG8_LAS bf16x8*)(lds + PG8_SA(b, h) + aoff + m * 2048 + k * 1024); } while (0)
#define PG8_LDB(dst, b, h) do { _Pragma("unroll") for (int n = 0; n < 2; ++n) _Pragma("unroll") for (int k = 0; k < 2; ++k) dst[n][k] = *(const PG8_LAS bf16x8*)(lds + PG8_SB(b, h) + boff + n * 2048 + k * 1024); } while (0)
#define PG8_MMA(ai, bj, At, Bt) do { __builtin_amdgcn_s_setprio(1); _Pragma("unroll") for (int m = 0; m < 4; ++m) _Pragma("unroll") for (int n = 0; n < 2; ++n) _Pragma("unroll") for (int k = 0; k < 2; ++k) \
        acc[ai][bj][m][n] = __builtin_amdgcn_mfma_f32_16x16x32_bf16(Bt[n][k], At[m][k], acc[ai][bj][m][n], 0, 0, 0); __builtin_amdgcn_s_setprio(0); } while (0)
#define PG8_WAIT_V(n) asm volatile("s_waitcnt vmcnt(" #n ")" ::: "memory")
#define PG8_WAIT_L(n) asm volatile("s_waitcnt lgkmcnt(" #n ")" ::: "memory")
#define PG8_BAR __builtin_amdgcn_s_barrier()
#define PG8_SCHED __builtin_amdgcn_sched_barrier(0)
    Unit cur, nxt; int ui = 0;
    if (!S.next(0, cur)) return;
    f32x4 acc[2][2][4][2];
#pragma unroll
    for (int a = 0; a < 2; ++a)
#pragma unroll
        for (int b = 0; b < 2; ++b)
#pragma unroll
            for (int m = 0; m < 4; ++m)
#pragma unroll
                for (int n = 0; n < 2; ++n) acc[a][b][m][n] = (f32x4){0.f, 0.f, 0.f, 0.f};
    bf16x8 At[4][2], B0[2][2], B1[2][2];
    const char* cA = (const char*)g.A + (size_t)cur.pm * tstep + (size_t)cur.koff * 2; const char* cB = (const char*)g.Bt + (size_t)cur.pn * tstep + (size_t)cur.koff * 2;
    size_t kc = (size_t)cur.rot * kstep; const size_t kwrap = (size_t)nt * kstep;
    const char* pA = cA + kc; const char* pB = cB + kc;
    S.a_ready(cur);
    if constexpr (SP2) {
        PG8_STAGE(PG8_SB(0, 0), pB, voffB); PG8_STAGE(PG8_SB(0, 1), pB + hstep, voffB); PG8_STAGE(PG8_SA(0, 0), pA, voffA); PG8_STAGE(PG8_SA(0, 1), pA + hstep, voffA);
        if (wr == 1) PG8_BAR;
        PG8_WAIT_V(2); PG8_BAR;
        PG8_STAGE(PG8_SB(1, 0), pB + kstep, voffB); PG8_STAGE(PG8_SA(1, 0), pA + kstep, voffA); PG8_STAGE(PG8_SB(1, 1), pB + hstep + kstep, voffB);
        PG8_WAIT_V(6); PG8_BAR;
    } else {
        PG8_STAGE(PG8_SB(0, 0), pB, voffB); PG8_STAGE(PG8_SA(0, 0), pA, voffA); PG8_STAGE(PG8_SB(0, 1), pB + hstep, voffB); PG8_STAGE(PG8_SA(0, 1), pA + hstep, voffA);
        if (wr == 1) PG8_BAR;
        PG8_WAIT_V(4); PG8_BAR;
        PG8_STAGE(PG8_SB(1, 0), pB + kstep, voffB); PG8_STAGE(PG8_SA(1, 0), pA + kstep, voffA); PG8_STAGE(PG8_SB(1, 1), pB + hstep + kstep, voffB);
        PG8_WAIT_V(6); PG8_BAR;
    }
    for (;;) {
        const bool has_next = S.next(ui + 1, nxt);
        const char* nA = has_next ? (const char*)g.A + (size_t)nxt.pm * tstep + (size_t)nxt.koff * 2 : cA; const char* nB = has_next ? (const char*)g.Bt + (size_t)nxt.pn * tstep + (size_t)nxt.koff * 2 : cB;
        const size_t nk = (size_t)(has_next ? nxt.rot : cur.rot) * kstep;
        for (int t = 0; t < nt; t += 2) {
            const bool last = (t == nt - 2);
            const char* a1 = cA + kc + kstep;
            size_t k2 = kc + 2 * kstep; if (k2 >= kwrap) k2 -= kwrap;
            const char* a2 = last ? nA + nk : cA + k2; const char* b2 = last ? nB + nk : cB + k2;
            kc = k2;
            const char* a3 = a2 + kstep; const char* b3 = b2 + kstep;
            if (last && has_next) S.a_ready(nxt);
            if constexpr (SP2) {
            PG8_LDB(B0, 0, 0); PG8_LDB(B1, 0, 1); PG8_SCHED; PG8_LDA(At, 0, 0); PG8_STAGE(PG8_SA(1, 1), a1 + hstep, voffA);
            PG8_WAIT_V(8); PG8_WAIT_L(0); PG8_BAR; PG8_MMA(0, 0, At, B0); PG8_MMA(0, 1, At, B1); PG8_BAR; PG8_SCHED;
            PG8_LDA(At, 0, 1); PG8_STAGE(PG8_SB(0, 0), b2, voffB); PG8_STAGE(PG8_SB(0, 1), b2 + hstep, voffB); PG8_STAGE(PG8_SA(0, 0), a2, voffA);
            PG8_WAIT_V(8); PG8_WAIT_L(0); PG8_BAR; PG8_MMA(1, 0, At, B0); PG8_MMA(1, 1, At, B1); PG8_BAR; PG8_SCHED;
            PG8_LDB(B0, 1, 0); PG8_LDB(B1, 1, 1); PG8_SCHED; PG8_LDA(At, 1, 0); PG8_STAGE(PG8_SA(0, 1), a2 + hstep, voffA);
            PG8_WAIT_V(8); PG8_WAIT_L(0); PG8_BAR; PG8_MMA(0, 0, At, B0); PG8_MMA(0, 1, At, B1); PG8_BAR; PG8_SCHED;
            PG8_LDA(At, 1, 1); PG8_STAGE(PG8_SB(1, 0), b3, voffB); PG8_STAGE(PG8_SB(1, 1), b3 + hstep, voffB); PG8_STAGE(PG8_SA(1, 0), a3, voffA);
            PG8_WAIT_V(8); PG8_WAIT_L(0); PG8_BAR; PG8_MMA(1, 0, At, B0); PG8_MMA(1, 1, At, B1); PG8_BAR; PG8_SCHED;
            } else {
            PG8_LDB(B0, 0, 0); PG8_SCHED; PG8_LDA(At, 0, 0); PG8_STAGE(PG8_SA(1, 1), a1 + hstep, voffA);
            PG8_WAIT_L(8); PG8_BAR; PG8_WAIT_L(0); PG8_MMA(0, 0, At, B0); PG8_BAR; PG8_SCHED;
            PG8_LDB(B1, 0, 1); PG8_STAGE(PG8_SB(0, 0), b2, voffB);
            PG8_BAR; PG8_WAIT_L(0); PG8_MMA(0, 1, At, B1); PG8_BAR;
            PG8_LDA(At, 0, 1); PG8_STAGE(PG8_SA(0, 0), a2, voffA);
            PG8_BAR; PG8_WAIT_L(0); PG8_MMA(1, 0, At, B0); PG8_BAR; PG8_SCHED;
            PG8_STAGE(PG8_SB(0, 1), b2 + hstep, voffB);
            PG8_WAIT_V(6); PG8_BAR; PG8_MMA(1, 1, At, B1); PG8_BAR;
            PG8_LDB(B0, 1, 0); PG8_SCHED; PG8_LDA(At, 1, 0); PG8_STAGE(PG8_SA(0, 1), a2 + hstep, voffA);
            PG8_WAIT_L(8); PG8_BAR; PG8_WAIT_L(0); PG8_MMA(0, 0, At, B0); PG8_BAR; PG8_SCHED;
            PG8_LDB(B1, 1, 1); PG8_STAGE(PG8_SB(1, 0), b3, voffB);
            PG8_BAR; PG8_WAIT_L(0); PG8_MMA(0, 1, At, B1); PG8_BAR;
            PG8_LDA(At, 1, 1); PG8_STAGE(PG8_SA(1, 0), a3, voffA);
            PG8_BAR; PG8_WAIT_L(0); PG8_MMA(1, 0, At, B0); PG8_BAR; PG8_SCHED;
            PG8_STAGE(PG8_SB(1, 1), b3 + hstep, voffB);
            PG8_WAIT_V(6); PG8_BAR; PG8_MMA(1, 1, At, B1); PG8_BAR;
            }
        }
        if constexpr (ALIGN_EPI) { if (wr == 0) PG8_BAR; }
        if constexpr (!Epi::AFTER_DRAIN) { E(acc, cur, wr, wc, fr, fq); S.done(cur); }
        if (!has_next) break;
#pragma unroll
        for (int a = 0; a < 2; ++a)
#pragma unroll
            for (int b = 0; b < 2; ++b)
#pragma unroll
                for (int m = 0; m < 4; ++m)
#pragma unroll
                    for (int n = 0; n < 2; ++n) acc[a][b][m][n] = (f32x4){0.f, 0.f, 0.f, 0.f};
        cur = nxt; cA = nA; cB = nB; kc = (size_t)cur.rot * kstep; ++ui;
        if constexpr (ALIGN_EPI) { if (wr == 1) PG8_BAR; }
    }
    PG8_WAIT_V(0);
    if constexpr (!ALIGN_EPI) { if (wr == 0) PG8_BAR; }
    PG8_BAR;
    if constexpr (Epi::AFTER_DRAIN) { E.fused(acc, cur, wr, wc, fr, fq, lds, wid, lane); S.done(cur); }
#undef PG8_SA
#undef PG8_SB
#undef PG8_STAGE
#undef PG8_LDA
#undef PG8_LDB
#undef PG8_MMA
#undef PG8_WAIT_V
#undef PG8_WAIT_L
#undef PG8_BAR
#undef PG8_SCHED
}
struct FewTileOrder : StaticOrder {
    __host__ __device__ bool next(int i, Unit& u) const { if (!StaticOrder::next(i, u)) return false; u.pm = c & 3; u.pn = (c >> 2) & 7; return true; }
};
template <bool FIXA, bool FIXB> struct ProbeOrder : StaticOrder {
    __host__ __device__ bool next(int i, Unit& u) const { if (!StaticOrder::next(i, u)) return false; if (FIXA) u.pm = 0; if (FIXB) u.pn = 0; return true; }
};
}

#ifndef MK_ONE_LAUNCH
#define MK_ONE_LAUNCH 0
#endif
#ifndef MK_STOP_AFTER
#define MK_STOP_AFTER 99
#endif
constexpr int NWAVES = 8, NTHR = 512;
constexpr int DM = 2048, NB = 4, SEQ = 4096, CTXL = 256, FF = 5504, MODW = 9 * DM;
constexpr int ML = NB * SEQ, MC = NB * CTXL, MT = ML + MC;
constexpr int NGU = 2 * FF;
constexpr int AB_N = 6400, AB_LD = 6144, CD_N = 3072;
constexpr int NCH = 34;
constexpr int USLOT = 272 * 128;
constexpr float EPS = 1e-6f;
constexpr int NPHASE = 26;

constexpr size_t MiB = 1u << 20;
constexpr size_t WS_CTL = 0, CTL_ZERO_BYTES = 2 * MiB;
constexpr size_t WS_MOD = 1 * MiB;
constexpr size_t WS_ROPEC = 2 * MiB, WS_ROPES = 3 * MiB;
constexpr size_t WS_AXC = 4 * MiB, WS_AXS = 4 * MiB + 8192;
constexpr size_t WS_GATES = 5 * MiB;
constexpr size_t WS_SCAL = 7 * MiB;
constexpr size_t WS_AGG = 8 * MiB;
constexpr size_t WS_XC = 16 * MiB;
constexpr size_t WS_WGU = 32 * MiB;
constexpr size_t WS_WD = 204 * MiB;
constexpr size_t WS_ABWIN = 290 * MiB;
constexpr size_t WS_ABWOUT = 315 * MiB;
constexpr size_t WS_CDWIN = 323 * MiB;
constexpr size_t WS_CDWOUT = 335 * MiB;
constexpr size_t WS_WUQ = 343 * MiB;
constexpr size_t WS_WUKV = 345 * MiB;
constexpr size_t WS_LWT = 346 * MiB;
constexpr size_t WS_XN = 348 * MiB;
constexpr size_t WS_BIG = 416 * MiB;
constexpr size_t WS_A = 620 * MiB;
constexpr size_t WS_KVRAW = 668 * MiB;
constexpr size_t WS_B = 765 * MiB;
constexpr size_t WS_CQN = 765 * MiB, WS_CKVN = 782 * MiB, WS_QF = 791 * MiB, WS_KF = 839 * MiB;
constexpr size_t WS_END = 910 * MiB;
constexpr int CW_BAR = 4096;

constexpr int RING_BYTES = 131072;
constexpr int LDS_BYTES = 159744;
constexpr int MISC_OFF = LDS_BYTES - 256;

#define GAS __attribute__((address_space(1)))
#define LAS __attribute__((address_space(3)))
#define DI __device__ __forceinline__
typedef unsigned short bf16;
typedef unsigned v4u __attribute__((ext_vector_type(4)));
typedef unsigned v2u __attribute__((ext_vector_type(2)));
typedef float f32x4 __attribute__((ext_vector_type(4)));
typedef float f32x2 __attribute__((ext_vector_type(2)));
typedef short bf16x8 __attribute__((ext_vector_type(8)));
typedef short s16x4 __attribute__((ext_vector_type(4)));
typedef GAS unsigned gu32;
#define RLX_AGENT __ATOMIC_RELAXED, __HIP_MEMORY_SCOPE_AGENT
#define LDS_WAIT() asm volatile("s_waitcnt lgkmcnt(0)" ::: "memory")
#define VM_WAIT() asm volatile("s_waitcnt vmcnt(0)" ::: "memory")
DI int lane_id() { int l; asm volatile("v_mbcnt_lo_u32_b32 %0, -1, 0\n\tv_mbcnt_hi_u32_b32 %0, -1, %0" : "=v"(l)); return l; }
DI float bf2f(unsigned h) { return __builtin_bit_cast(float, h << 16); }
DI float bflo(unsigned w) { return __builtin_bit_cast(float, w << 16); }
DI float bfhi(unsigned w) { return __builtin_bit_cast(float, w & 0xffff0000u); }
DI unsigned pk2(float lo, float hi) { return pg8::cvt_pk_bf16(lo, hi); }
DI unsigned short f2bf(float f) { return (unsigned short)(pk2(f, 0.f) & 0xffffu); }
DI float wave_sum(float v) {
#pragma unroll
    for (int o = 1; o < 64; o <<= 1) v += __shfl_xor(v, o);
    return v;
}
DI float wave_max(float v) {
#pragma unroll
    for (int o = 1; o < 64; o <<= 1) v = fmaxf(v, __shfl_xor(v, o));
    return v;
}
DI float sigmoidf_(float x) { return __builtin_amdgcn_rcpf(1.f + __expf(-x)); }
DI float siluf_(float x) { return x * sigmoidf_(x); }
DI float logsigf_(float x) { return fminf(x, 0.f) - log1pf(__expf(-fabsf(x))); }
DI float gelu_tanh(float x) { const float z = 0.7978845608028654f * (x + 0.044715f * x * x * x); const float t = 1.f - 2.f * __builtin_amdgcn_rcpf(1.f + __expf(2.f * z)); return 0.5f * x * (1.f + t); }
DI f32x4 mfma16(bf16x8 a, bf16x8 b, f32x4 c) { return __builtin_amdgcn_mfma_f32_16x16x32_bf16(a, b, c, 0, 0, 0); }
DI bf16x8 frag_row(const LAS unsigned char* base, int stride_b, int row0, int k0, int lane) {
    return *(const LAS bf16x8*)(base + (row0 + (lane & 15)) * stride_b + (k0 + 8 * (lane >> 4)) * 2);
}
DI bf16x8 frag_tr(const LAS unsigned char* base, int stride_b, int ka, int kb, int c0, int lane) {
    const int idx = lane & 15, qq = idx >> 2, p = idx & 3;
    const s16x4 lo = __builtin_amdgcn_ds_read_tr16_b64_v4i16((LAS s16x4*)(base + (ka + qq) * stride_b + (c0 + 4 * p) * 2));
    const s16x4 hi = __builtin_amdgcn_ds_read_tr16_b64_v4i16((LAS s16x4*)(base + (kb + qq) * stride_b + (c0 + 4 * p) * 2));
    bf16x8 o; o[0] = lo[0]; o[1] = lo[1]; o[2] = lo[2]; o[3] = lo[3]; o[4] = hi[0]; o[5] = hi[1]; o[6] = hi[2]; o[7] = hi[3]; return o;
}

DI void glds16(const void* gsrc, unsigned lds_dst) {
    unsigned keep; asm volatile("s_mov_b32 %0, m0\n\ts_mov_b32 m0, %2\n\ts_nop 0\n\tglobal_load_lds_dwordx4 %1, off\n\ts_mov_b32 m0, %0" : "=&s"(keep) : "v"(gsrc), "s"(lds_dst) : "memory");
}
#define XB_TMO      128
#define XB_XCNT(j)  (256  + 64 * (j))
#define XB_XSUB(j)  (1280 + 64 * (j))
#define XB_XGEN(j)  (2304 + 64 * (j))
#define XB_TOP      3328
#define XB_TOPGEN   3392
#define XCD_BAR_WORDS 3456
#define XB_SPIN_CAP (1u << 18)

__device__ __forceinline__ unsigned xb_ld(unsigned* p)              { return __hip_atomic_load(p, __ATOMIC_RELAXED, __HIP_MEMORY_SCOPE_AGENT); }
__device__ __forceinline__ unsigned xb_add(unsigned* p, unsigned v) { return __hip_atomic_fetch_add(p, v, __ATOMIC_RELAXED, __HIP_MEMORY_SCOPE_AGENT); }
__device__ __forceinline__ unsigned xb_xcc_id() { return (unsigned)__builtin_amdgcn_s_getreg((3 << 11) | 20) & 0xFu; }
#define XB_SPIN(cond, bar) do { unsigned _sp = 0; while (cond) { __builtin_amdgcn_s_sleep(1); \
    if ((++_sp & 255u) == 0u) { if (xb_ld(&(bar)[XB_TMO])) break; if (_sp > XB_SPIN_CAP) { atomicAdd(&(bar)[XB_TMO], 1u); break; } } } } while (0)

struct XcdBarrier {
    unsigned* bar; unsigned x; int w;
    volatile LAS unsigned* st;
};

__device__ __forceinline__ XcdBarrier xcd_barrier_post(unsigned* bar, volatile LAS unsigned* st) {
    XcdBarrier b; b.bar = bar; b.x = xb_xcc_id(); b.st = st;
    b.w = __builtin_amdgcn_readfirstlane((int)threadIdx.x >> 6);
    if (threadIdx.x == 0) (void)xb_add(&bar[XB_XCNT(b.x)], 1u);
    return b;
}
__device__ __forceinline__ void xcd_barrier_complete(unsigned* bar, unsigned x, unsigned& nloc, unsigned& nx) {
    const unsigned G = gridDim.x * gridDim.y * gridDim.z;
    unsigned sum, cnt, mine, sp = 0u;
    for (;;) {
        sum = 0u; cnt = 0u; mine = 0u;
#pragma unroll
        for (unsigned j = 0; j < 16; ++j) { const unsigned c = xb_ld(&bar[XB_XCNT(j)]); sum += c; cnt += (c > 0u) ? 1u : 0u; mine = (j == x) ? c : mine; }
        if (sum == G) break;
        __builtin_amdgcn_s_sleep(1);
        if ((++sp & 255u) == 0u) { if (xb_ld(&bar[XB_TMO])) break; if (sp > XB_SPIN_CAP) { atomicAdd(&bar[XB_TMO], 1u); break; } }
    }
    nloc = mine > 0u ? mine : 1u; nx = cnt > 0u ? cnt : 1u;
}

__device__ __forceinline__ void xcd_barrier(const XcdBarrier& b) {
    asm volatile("s_waitcnt vmcnt(0)" ::: "memory");
    __syncthreads();
    if (b.w == 0 && lane_id() == 0) {
        unsigned* bar = b.bar;
        __builtin_amdgcn_s_waitcnt(0);
        unsigned nloc = b.st[0], nx = b.st[1];
        if (nloc == 0u) { xcd_barrier_complete(bar, b.x, nloc, nx); b.st[0] = nloc; b.st[1] = nx; }
        const unsigned old = xb_add(&bar[XB_XSUB(b.x)], 1u);
        const unsigned gen = old / nloc;
        if (old + 1u == (gen + 1u) * nloc) {
            __builtin_amdgcn_fence(__ATOMIC_RELEASE, "agent");
            asm volatile("s_waitcnt vmcnt(0)" ::: "memory");
            const unsigned og = xb_add(&bar[XB_TOP], 1u);
            const unsigned tg = og / nx;
            if (og + 1u == (tg + 1u) * nx) xb_add(&bar[XB_TOPGEN], 1u);
            else XB_SPIN(xb_ld(&bar[XB_TOPGEN]) == tg, bar);
            __builtin_amdgcn_fence(__ATOMIC_ACQUIRE, "agent");
            xb_add(&bar[XB_XGEN(b.x)], 1u);
            asm volatile("s_waitcnt vmcnt(0)" ::: "memory");
        } else {
            XB_SPIN(xb_ld(&bar[XB_XGEN(b.x)]) == gen, bar);
            __builtin_amdgcn_fence(__ATOMIC_ACQUIRE, "agent");
            asm volatile("s_waitcnt vmcnt(0)" ::: "memory");
        }
    }
    __syncthreads();
}


struct Args { const float* in[31]; float* out; unsigned char* ws; int ph_lo, ph_hi; };
enum { I_X = 0, I_C, I_CTX, I_CCTX, I_ADAW, I_ADAB, I_NORMG, I_WG, I_WU, I_WD, I_ABWIN, I_ABWOUT, I_DECAY, I_RETGN, I_GATEB, I_MLGN, I_CDWIN, I_CDWOUT,
       I_CONVW, I_CONVB, I_LWA, I_LBA, I_LWX, I_LBX, I_LAM, I_QNG, I_KVNG, I_WUQ, I_WUK, I_WUV, I_QKNG };

typedef pg8::f32x4 accv;
struct EpiUp {
    static constexpr bool PERM = true, AFTER_DRAIN = false;
    bf16* O;
    DI void operator()(const accv (&acc)[2][2][4][2], const pg8::Unit& u, int wr, int wc, int fr, int fq) const {
        const int row0 = u.pm * 256 + wr * 64 + fr, col0 = u.pn * 128 + wc * 32 + 8 * fq;
#pragma unroll
        for (int ai = 0; ai < 2; ++ai)
#pragma unroll
            for (int m = 0; m < 4; ++m) {
                const accv g0 = acc[ai][0][m][0], g1 = acc[ai][0][m][1], u0 = acc[ai][1][m][0], u1 = acc[ai][1][m][1];
                v4u w;
                w.x = pk2(siluf_(g0[0]) * u0[0], siluf_(g0[1]) * u0[1]); w.y = pk2(siluf_(g0[2]) * u0[2], siluf_(g0[3]) * u0[3]);
                w.z = pk2(siluf_(g1[0]) * u1[0], siluf_(g1[1]) * u1[1]); w.w = pk2(siluf_(g1[2]) * u1[2], siluf_(g1[3]) * u1[3]);
                *(v4u*)(O + (size_t)(row0 + ai * 128 + m * 16) * FF + col0) = w;
            }
    }
};
struct EpiResid {
    static constexpr bool PERM = false, AFTER_DRAIN = false;
    const float* inL; const float* inC; float* outL; float* outC; const float* gate  ; float scale;
    DI void operator()(const accv (&acc)[2][2][4][2], const pg8::Unit& u, int wr, int wc, int fr, int fq) const {
        const bool lat = u.pm < 64;
        const int rloc = (lat ? u.pm * 256 : (u.pm - 64) * 256) + wr * 64 + fr, col0 = u.pn * 256 + wc * 32 + 4 * fq;
        const int bidx = lat ? (u.pm >> 4) : 4;
        const float* ib = lat ? inL : inC; float* ob = lat ? outL : outC;
        accv gv[2][2];
#pragma unroll
        for (int bj = 0; bj < 2; ++bj)
#pragma unroll
            for (int n = 0; n < 2; ++n) gv[bj][n] = *(const accv*)(gate + (size_t)bidx * MODW + col0 + bj * 128 + n * 16) * scale;
#pragma unroll
        for (int ai = 0; ai < 2; ++ai) {
            accv xi[4][2][2];
#pragma unroll
            for (int m = 0; m < 4; ++m) { const size_t ro = (size_t)(rloc + ai * 128 + m * 16) * DM + col0;
#pragma unroll
                for (int bj = 0; bj < 2; ++bj)
#pragma unroll
                    for (int n = 0; n < 2; ++n) xi[m][bj][n] = *(const accv*)(ib + ro + bj * 128 + n * 16); }
            asm volatile("" ::: "memory");
#pragma unroll
            for (int m = 0; m < 4; ++m) { const size_t ro = (size_t)(rloc + ai * 128 + m * 16) * DM + col0;
#pragma unroll
                for (int bj = 0; bj < 2; ++bj)
#pragma unroll
                    for (int n = 0; n < 2; ++n) *(accv*)(ob + ro + bj * 128 + n * 16) = xi[m][bj][n] + gv[bj][n] * acc[ai][bj][m][n]; }
            asm volatile("" ::: "memory");
        }
    }
};
struct EpiPlain {
    static constexpr bool PERM = true, AFTER_DRAIN = false;
    bf16* O; int ldc; int ngelu;
    DI void operator()(const accv (&acc)[2][2][4][2], const pg8::Unit& u, int wr, int wc, int fr, int fq) const {
        const int row0 = u.pm * 256 + wr * 64 + fr, col0 = u.pn * 256 + wc * 32 + 8 * fq; const bool act = u.pn < ngelu;
#pragma unroll
        for (int ai = 0; ai < 2; ++ai)
#pragma unroll
            for (int m = 0; m < 4; ++m)
#pragma unroll
                for (int bj = 0; bj < 2; ++bj) {
                    accv v0 = acc[ai][bj][m][0], v1 = acc[ai][bj][m][1];
                    if (act) {
#pragma unroll
                        for (int e = 0; e < 4; ++e) { v0[e] = gelu_tanh(v0[e]); v1[e] = gelu_tanh(v1[e]); } }
                    v4u w; w.x = pk2(v0[0], v0[1]); w.y = pk2(v0[2], v0[3]); w.z = pk2(v1[0], v1[1]); w.w = pk2(v1[2], v1[3]);
                    *(v4u*)(O + (size_t)(row0 + ai * 128 + m * 16) * ldc + col0 + bj * 128) = w;
                }
    }
};
struct EpiProjAB {
    static constexpr bool PERM = true, AFTER_DRAIN = false;
    bf16* O; float* gates; const float* gate_b; const float* ropec; const float* ropes;
    DI void operator()(const accv (&acc)[2][2][4][2], const pg8::Unit& u, int wr, int wc, int fr, int fq) const {
        const int pn = u.pn, row0 = u.pm * 256 + wr * 64 + fr; const bool lat = u.pm < 64;
        if (pn == 24) {
            if (wc == 0 && fq < 2) {
                const accv b0 = *(const accv*)(gate_b + 8 * fq), b1 = *(const accv*)(gate_b + 8 * fq + 4);
#pragma unroll
                for (int ai = 0; ai < 2; ++ai)
#pragma unroll
                    for (int m = 0; m < 4; ++m) { float* gp = gates + (size_t)(row0 + ai * 128 + m * 16) * 16 + 8 * fq;
                        *(accv*)gp = acc[ai][0][m][0] + b0; *(accv*)(gp + 4) = acc[ai][0][m][1] + b1; }
            }
            return;
        }
        const bool rope = (pn < 4) && lat;
        const float sc = (pn == 2 || pn == 3 || pn == 12 || pn == 13) ? 0.08838834764831845f : 1.f;
        const int actk = (pn >= 8 && pn < 12) ? 1 : ((pn >= 20 && pn < 24) ? 2 : 0);
        const int col0 = pn * 256 + wc * 32 + 8 * fq;
        accv csv[2][4], snv[2][4];
#pragma unroll
        for (int ai = 0; ai < 2; ++ai)
#pragma unroll
            for (int m = 0; m < 4; ++m) { csv[ai][m] = (accv){1.f, 1.f, 1.f, 1.f}; snv[ai][m] = (accv){0.f, 0.f, 0.f, 0.f};
                if (rope) { const int pos = (row0 + ai * 128 + m * 16) & (SEQ - 1); csv[ai][m] = *(const accv*)(ropec + pos * 64 + 16 * wc + 4 * fq); snv[ai][m] = *(const accv*)(ropes + pos * 64 + 16 * wc + 4 * fq); } }
        asm volatile("" ::: "memory");
#pragma unroll
        for (int ai = 0; ai < 2; ++ai)
#pragma unroll
            for (int m = 0; m < 4; ++m) {
                const int row = row0 + ai * 128 + m * 16;
                const accv cs = csv[ai][m], sn = snv[ai][m];
#pragma unroll
                for (int bj = 0; bj < 2; ++bj) {
                    accv v0 = acc[ai][bj][m][0], v1 = acc[ai][bj][m][1];
                    if (rope) { const accv x1 = v0, x2 = v1; v0 = x1 * cs - x2 * sn; v1 = x1 * sn + x2 * cs; }
                    v0 = v0 * sc; v1 = v1 * sc;
                    if (actk == 1) {
#pragma unroll
                        for (int e = 0; e < 4; ++e) { v0[e] = siluf_(v0[e]); v1[e] = siluf_(v1[e]); } }
                    if (actk == 2) {
#pragma unroll
                        for (int e = 0; e < 4; ++e) { v0[e] = sigmoidf_(v0[e]); v1[e] = sigmoidf_(v1[e]); } }
                    v4u w; w.x = pk2(v0[0], v0[1]); w.y = pk2(v0[2], v0[3]); w.z = pk2(v1[0], v1[1]); w.w = pk2(v1[2], v1[3]);
                    *(v4u*)(O + (size_t)row * AB_LD + col0 + bj * 128) = w;
                }
            }
    }
};

struct EpiPartial {
    static constexpr bool PERM = false, AFTER_DRAIN = false;
    float* P;
    DI void operator()(const accv (&acc)[2][2][4][2], const pg8::Unit& u, int wr, int wc, int fr, int fq) const {
        const int row0 = u.pm * 256 + wr * 64 + fr, col0 = u.pn * 256 + wc * 32 + 4 * fq;
#pragma unroll
        for (int ai = 0; ai < 2; ++ai)
#pragma unroll
            for (int m = 0; m < 4; ++m) { float* rp = P + (size_t)(row0 + ai * 128 + m * 16) * DM + col0;
#pragma unroll
                for (int bj = 0; bj < 2; ++bj)
#pragma unroll
                    for (int n = 0; n < 2; ++n) *(accv*)(rp + bj * 128 + n * 16) = acc[ai][bj][m][n]; }
    }
};

template <bool P> struct EpiNull {
    static constexpr bool PERM = P, AFTER_DRAIN = false;
    float* O;
    DI void operator()(const accv (&acc)[2][2][4][2], const pg8::Unit& u, int wr, int wc, int fr, int fq) const {
        accv s = {0.f, 0.f, 0.f, 0.f};
#pragma unroll
        for (int ai = 0; ai < 2; ++ai)
#pragma unroll
            for (int bj = 0; bj < 2; ++bj)
#pragma unroll
                for (int m = 0; m < 4; ++m)
#pragma unroll
                    for (int n = 0; n < 2; ++n) s = s + acc[ai][bj][m][n];
        *(accv*)(O + (size_t)((wr * 4 + wc) * 64 + fq * 16 + fr) * 4) = s;
    }
};

struct Frame {
    LAS unsigned char* lds;
    int wave, G;
    const Args* a;
};
#define WSP(T, off) ((T*)(A.ws + (off)))
#define TID(F) ((F).wave * 64 + lane_id())

DI void cvt_item(const float* W, int ldw, int K, bf16* WT, int k0, int n0, int srcc, LAS float* scr, int lane) {
    const float* wp = W + (size_t)k0 * ldw + (srcc >= 0 ? srcc : 0);
#pragma unroll
    for (int i = 0; i < 32; ++i) { const int kk = 2 * i + (lane >> 5); scr[kk * 33 + (lane & 31)] = (srcc >= 0) ? wp[(size_t)kk * ldw] : 0.f; }
    LDS_WAIT(); asm volatile("" ::: "memory");
    const int c = lane & 7;
#pragma unroll
    for (int j = 0; j < 4; ++j) { const int n = (lane >> 3) + 8 * j; const LAS float* s = scr + (8 * c) * 33 + n;
        v4u o; o.x = pk2(s[0 * 33], s[1 * 33]); o.y = pk2(s[2 * 33], s[3 * 33]); o.z = pk2(s[4 * 33], s[5 * 33]); o.w = pk2(s[6 * 33], s[7 * 33]);
        *(v4u*)(WT + (size_t)(n0 + n) * K + k0 + 8 * c) = o; }
    LDS_WAIT(); asm volatile("" ::: "memory");
}
DI void cvt_item4(const float* W, int ldw, int K, bf16* WT, int k0, int n0, int srcc0, LAS float* scr, int lane) {
    const int kk8 = lane >> 3, n4 = lane & 7;
    const float* wp = W + (size_t)(k0 + kk8) * ldw + (srcc0 >= 0 ? srcc0 : 0) + 4 * n4;
    f32x4 v[8];
#pragma unroll
    for (int i = 0; i < 8; ++i) v[i] = (srcc0 >= 0) ? *(const f32x4*)(wp + (size_t)(8 * i) * ldw) : (f32x4){0.f, 0.f, 0.f, 0.f};
#pragma unroll
    for (int i = 0; i < 8; ++i) { LAS float* d = scr + (8 * i + kk8) * 33 + 4 * n4; d[0] = v[i].x; d[1] = v[i].y; d[2] = v[i].z; d[3] = v[i].w; }
    LDS_WAIT(); asm volatile("" ::: "memory");
    const int c = lane & 7;
#pragma unroll
    for (int j = 0; j < 4; ++j) { const int n = (lane >> 3) + 8 * j; const LAS float* s = scr + (8 * c) * 33 + n;
        v4u o; o.x = pk2(s[0 * 33], s[1 * 33]); o.y = pk2(s[2 * 33], s[3 * 33]); o.z = pk2(s[4 * 33], s[5 * 33]); o.w = pk2(s[6 * 33], s[7 * 33]);
        *(v4u*)(WT + (size_t)(n0 + n) * K + k0 + 8 * c) = o; }
    LDS_WAIT(); asm volatile("" ::: "memory");
}
DI int rope_src(int p) { const int e = p & 7, hi = (p >> 3) * 4; return e < 4 ? hi + e : 64 + hi + (e - 4); }

DI void phase_pre(const Frame& F, const Args& A, bool do_adaln) {
    const int lane = lane_id(), wave = F.wave, tid = wave * 64 + lane, G = F.G;
    {
        float* rc = WSP(float, WS_ROPEC); float* rs = WSP(float, WS_ROPES); float* ac = WSP(float, WS_AXC); float* as = WSP(float, WS_AXS);
        for (int i = blockIdx.x * NTHR + tid; i < SEQ * 64 + 64 * 16; i += G * NTHR) {
            int pos, k; float fr_;
            if (i < SEQ * 64) { pos = i >> 6; k = i & 63; fr_ = exp2f(-(float)k * (13.287712379549449f / 64.f)); }
            else { const int i2 = i - SEQ * 64; pos = i2 >> 4; k = i2 & 15; fr_ = exp2f(-(float)k * (13.287712379549449f / 16.f)); }
            const float ang = (float)pos * fr_;
            const double rev = (double)ang * 0.15915494309189535; const float fr2 = (float)(rev - rint(rev));
            const float s = __builtin_amdgcn_sinf(fr2), c = __builtin_amdgcn_cosf(fr2);
            if (i < SEQ * 64) { rc[i] = c; rs[i] = s; } else { ac[i - SEQ * 64] = c; as[i - SEQ * 64] = s; }
        }
    }
    if (do_adaln) {
        LAS float* sc = (LAS float*)F.lds;
        LAS float* red = (LAS float*)(F.lds + 40960);
        const float* cc = A.in[I_C]; const float* cx = A.in[I_CCTX];
        for (int i = tid; i < 5 * DM; i += NTHR) { const int r = i / DM, k = i % DM; const float v = r < 4 ? cc[r * DM + k] : cx[k]; sc[i] = siluf_(v); }
        __syncthreads();
        float* MOD = WSP(float, WS_MOD);
        for (int unit = blockIdx.x; unit < 576; unit += G) {
            const int kh = unit & 1, u2 = unit >> 1, l = u2 / 144, n0 = (u2 % 144) * 128;
            const float* W = A.in[I_ADAW] + (size_t)l * DM * MODW + n0 + 2 * lane;
            float acc[5][2];
#pragma unroll
            for (int r = 0; r < 5; ++r) { acc[r][0] = 0.f; acc[r][1] = 0.f; }
            const int kb = kh * 1024 + wave * 128;
#pragma unroll 16
            for (int k = 0; k < 128; ++k) {
                const f32x2 w = *(const f32x2*)(W + (size_t)(kb + k) * MODW);
#pragma unroll
                for (int r = 0; r < 5; ++r) { const float s = sc[r * DM + kb + k]; acc[r][0] += s * w.x; acc[r][1] += s * w.y; }
            }
#pragma unroll
            for (int r = 0; r < 5; ++r) { red[(wave * 5 + r) * 128 + 2 * lane] = acc[r][0]; red[(wave * 5 + r) * 128 + 2 * lane + 1] = acc[r][1]; }
            __syncthreads();
            for (int i = tid; i < 640; i += NTHR) { const int r = i >> 7, c = i & 127; float s = kh ? 0.f : A.in[I_ADAB][l * MODW + n0 + c];
#pragma unroll
                for (int w = 0; w < 8; ++w) s += red[(w * 5 + r) * 128 + c];
                atomicAdd(&MOD[(size_t)(l * 5 + r) * MODW + n0 + c], s); }
            __syncthreads();
        }
    }
    {
        LAS float* scr = (LAS float*)(F.lds + wave * 8448);
        const int gw = blockIdx.x * NWAVES + wave, NGW = G * NWAVES;
        constexpr int I_GU = 32 * (NGU / 32), I_D = (FF / 64) * (DM / 32), I_ABI = 32 * (AB_N / 32), I_SQ = 32 * 64, I_CDI = 32 * (CD_N / 32), I_UQ = 8 * 48, I_UKV = 4 * 64, I_LW = 2 * 4;
        constexpr int NITEMS = 4 * I_GU + 4 * I_D + I_ABI + I_SQ + I_CDI + I_SQ + I_UQ + I_UKV + 32 * I_LW;
        for (int it = gw; it < NITEMS; it += NGW) {
            int r = it;
            if (r < 4 * I_GU) { const int q = r / I_GU; r -= q * I_GU; const int nbk = NGU / 32, kb = r / nbk, nb = r % nbk;
                const float* W = (((32 * nb) & 255) < 128 ? A.in[I_WG] : A.in[I_WU]) + (size_t)q * DM * FF;
                cvt_item4(W, FF, DM, WSP(bf16, WS_WGU) + (size_t)q * NGU * DM, 64 * kb, 32 * nb, (nb >> 3) * 128 + ((32 * nb) & 127), scr, lane); continue; }
            r -= 4 * I_GU;
            if (r < 4 * I_D) { const int q = r / I_D; r -= q * I_D; const int nbk = DM / 32, kb = r / nbk, nb = r % nbk;
                cvt_item4(A.in[I_WD] + (size_t)q * FF * DM, DM, FF, WSP(bf16, WS_WD) + (size_t)q * DM * FF, 64 * kb, 32 * nb, 32 * nb, scr, lane); continue; }
            r -= 4 * I_D;
            if (r < I_ABI) { const int nbk = AB_N / 32, kb = r / nbk, nb = r % nbk, R = 32 * nb + (lane & 31), tile = R >> 8;
                int src = R;
                if (tile < 4 || (tile >= 12 && tile < 16)) src = (R & ~127) + rope_src(R & 127);
                if (R >= 6160) src = -1;
                cvt_item(A.in[I_ABWIN], 6160, DM, WSP(bf16, WS_ABWIN), 64 * kb, 32 * nb, src, scr, lane); continue; }
            r -= I_ABI;
            if (r < I_SQ) { const int kb = r / 64, nb = r % 64; cvt_item4(A.in[I_ABWOUT], DM, DM, WSP(bf16, WS_ABWOUT), 64 * kb, 32 * nb, 32 * nb, scr, lane); continue; }
            r -= I_SQ;
            if (r < I_CDI) { const int nbk = CD_N / 32, kb = r / nbk, nb = r % nbk, R = 32 * nb + (lane & 31);
                cvt_item4(A.in[I_CDWIN], 2880, DM, WSP(bf16, WS_CDWIN), 64 * kb, 32 * nb, 32 * nb < 2880 ? 32 * nb : -1, scr, lane); continue; }
            r -= I_CDI;
            if (r < I_SQ) { const int kb = r / 64, nb = r % 64; cvt_item4(A.in[I_CDWOUT], DM, DM, WSP(bf16, WS_CDWOUT), 64 * kb, 32 * nb, 32 * nb, scr, lane); continue; }
            r -= I_SQ;
            if (r < I_UQ) { const int kb = r / 48, nb = r % 48; cvt_item4(A.in[I_WUQ], 1536, 512, WSP(bf16, WS_WUQ), 64 * kb, 32 * nb, 32 * nb, scr, lane); continue; }
            r -= I_UQ;
            if (r < I_UKV) { const int kb = r / 64, nb = r % 64, R = 32 * nb + (lane & 31);
                cvt_item4(nb < 32 ? A.in[I_WUK] : A.in[I_WUV], 1024, 256, WSP(bf16, WS_WUKV), 64 * kb, 32 * nb, (32 * nb) & 1023, scr, lane); continue; }
            r -= I_UKV;
            { const int mg = r / I_LW; r -= mg * I_LW; const int mat = mg >> 3, g = mg & 7, kb = r / 4, nb = r % 4;
              const float* W = ((mat & 1) ? A.in[I_LWX] : A.in[I_LWA]) + (size_t)((mat >> 1) * 8 + g) * 128 * 128;
              cvt_item4(W, 128, 128, WSP(bf16, WS_LWT) + (size_t)mg * 128 * 128, 64 * kb, 32 * nb, 32 * nb, scr, lane); }
        }
    }
}

struct CtxFix { const float* cin; const float* part; const float* gate; float scale; };
DI void phase_norm(const Frame& F, const Args& A, int l, int which, int nrows, bool first, const CtxFix cf) {
    const int lane = lane_id(), gw = blockIdx.x * NWAVES + F.wave, NGW = F.G * NWAVES;
    const f32x4* gn = (const f32x4*)(A.in[I_NORMG] + (size_t)(l * 3 + which) * DM);
    const float* XL = first ? A.in[I_X] : A.out; const float* XC = first ? A.in[I_CTX] : WSP(float, WS_XC);
    const float* MOD = WSP(float, WS_MOD); bf16* XN = WSP(bf16, WS_XN);
    f32x4 g[8];
#pragma unroll
    for (int j = 0; j < 4; ++j) { g[2 * j] = gn[2 * lane + 128 * j]; g[2 * j + 1] = gn[2 * lane + 128 * j + 1]; }
    f32x4 nv[8];
#define NORM_SIMPLE(r_) ((r_) < ML || cf.part == nullptr)
#define NORM_LOAD(r_) do { const f32x4* xr_ = (const f32x4*)((r_) < ML ? XL + (size_t)(r_) * DM : XC + (size_t)((r_) - ML) * DM) + 2 * lane; _Pragma("unroll") for (int j = 0; j < 4; ++j) { nv[2 * j] = xr_[128 * j]; nv[2 * j + 1] = xr_[128 * j + 1]; } } while (0)
    if (gw < nrows && NORM_SIMPLE(gw)) NORM_LOAD(gw);
    for (int row = gw; row < nrows; row += NGW) {
        const bool lat = row < ML;
        const int bidx = lat ? (row >> 12) : 4;
        const f32x4* shp = (const f32x4*)(MOD + (size_t)(l * 5 + bidx) * MODW + (3 * which) * DM) + 2 * lane; const f32x4* scp = shp + DM / 4;
        f32x4 v[8]; float ss = 0.f;
        if (NORM_SIMPLE(row)) {
#pragma unroll
            for (int j = 0; j < 8; ++j) v[j] = nv[j];
        } else {
            const size_t ro = (size_t)(row - ML) * DM; const f32x4* xr = (const f32x4*)(cf.cin + ro) + 2 * lane; const f32x4* gt = (const f32x4*)cf.gate + 2 * lane;
            f32x4* xo = (f32x4*)(WSP(float, WS_XC) + ro) + 2 * lane;
#pragma unroll
            for (int j = 0; j < 8; ++j) { const int o = 128 * (j >> 1) + (j & 1); f32x4 s = *((const f32x4*)(cf.part + ro) + 2 * lane + o);
#pragma unroll
                for (int k = 1; k < 8; ++k) s = s + *((const f32x4*)(cf.part + (size_t)k * MC * DM + ro) + 2 * lane + o);
                v[j] = xr[o] + gt[o] * s * cf.scale; xo[o] = v[j]; }
        }
        { const int nr = row + NGW; if (nr < nrows && NORM_SIMPLE(nr)) NORM_LOAD(nr); }
#pragma unroll
        for (int j = 0; j < 8; ++j) ss += (v[j].x * v[j].x + v[j].y * v[j].y) + (v[j].z * v[j].z + v[j].w * v[j].w);
        const float rs = __frsqrt_rn(wave_sum(ss) * (1.f / DM) + EPS);
        v4u* o16 = (v4u*)(XN + (size_t)row * DM) + lane;
        f32x4 cs_[8], ch_[8];
#pragma unroll
        for (int j = 0; j < 4; ++j) { cs_[2 * j] = scp[128 * j]; cs_[2 * j + 1] = scp[128 * j + 1]; ch_[2 * j] = shp[128 * j]; ch_[2 * j + 1] = shp[128 * j + 1]; }
        asm volatile("" ::: "memory");
#pragma unroll
        for (int j = 0; j < 4; ++j) { const f32x4 y0 = (v[2 * j] * rs) * g[2 * j] * (cs_[2 * j] + 1.f) + ch_[2 * j], y1 = (v[2 * j + 1] * rs) * g[2 * j + 1] * (cs_[2 * j + 1] + 1.f) + ch_[2 * j + 1];
            v4u w; w.x = pk2(y0.x, y0.y); w.y = pk2(y0.z, y0.w); w.z = pk2(y1.x, y1.y); w.w = pk2(y1.z, y1.w); o16[64 * j] = w; }
    }
#undef NORM_SIMPLE
#undef NORM_LOAD
}

DI int chunk_row0(int b, int j) { return j < 2 ? ML + b * CTXL + 128 * j : b * SEQ + 128 * (j - 2); }
DI int us_slot(int b, int h, int mx, int j, int d) { return ((((b * 4 + h) * 2 + mx) * NCH + j) * 2 + d); }
DI int sc_idx(int b, int h, int d, int j) { return ((b * 4 + h) * 2 + d) * NCH + j; }
constexpr int LV_STRIDE = 544, LK_STRIDE = 272, LKT_STRIDE = 288;
DI void mlstm_gate_scan(const float* gates, int R0, int h, int d, int lane, float (&Av)[2], float (&Bv)[2], int (&cpos)[2], float& blast) {
    float iv[2], lf[2];
#pragma unroll
    for (int t = 0; t < 2; ++t) { const int e = 2 * lane + t; cpos[t] = d ? 127 - e : e; const float* g = gates + (size_t)(R0 + cpos[t]) * 16 + d * 8 + h; iv[t] = g[0]; lf[t] = logsigf_(g[4]); }
    float s = lf[0] + lf[1], inc = s;
#pragma unroll
    for (int o = 1; o < 64; o <<= 1) { const float t = __shfl_up(inc, o); if (lane >= o) inc += t; }
    const float exc = inc - s;
    Bv[0] = exc + lf[0]; Bv[1] = exc + s; Av[0] = iv[0] - Bv[0]; Av[1] = iv[1] - Bv[1];
    blast = __shfl(inc, 63);
}

DI void phase_m1(const Frame& F, const Args& A) {
    const int lane = lane_id(), wave = F.wave, tid = wave * 64 + lane, r16 = lane & 15, q4 = lane >> 4;
    LAS unsigned char* LV = F.lds; LAS unsigned char* LKf = F.lds + 71680; LAS unsigned char* LKb = LKf + 36864;
    LAS float* TW = (LAS float*)(LKb + 36864);
    const bf16* PROJ = WSP(bf16, WS_BIG); const float* GATES = WSP(float, WS_GATES); bf16* U = WSP(bf16, WS_A); float* SCAL = WSP(float, WS_SCAL);
    for (int unit = blockIdx.x; unit < NB * 4 * 2 * NCH; unit += F.G) {
        const int j = unit % NCH, t_ = unit / NCH, mx = t_ & 1, h = (t_ >> 1) & 3, b = t_ >> 3;
        const int R0 = chunk_row0(b, j);
        const int kcol = mx ? 3584 + 128 * h : 512 + 128 * h, vcol = mx ? 4096 + 256 * h : 1024 + 256 * h;
        if (mx == 0) {
            if (tid < 128) { const float lgf = logsigf_(A.in[I_DECAY][h]), lgb = logsigf_(A.in[I_DECAY][4 + h]); TW[tid] = __expf((float)(127 - tid) * lgf); TW[128 + tid] = __expf((float)tid * lgb); }
        } else if (wave < 2) {
            const int d = wave; float Av[2], Bv[2], blast; int cp[2];
            mlstm_gate_scan(GATES, R0, h, d, lane, Av, Bv, cp, blast);
            const float mA = wave_max(fmaxf(Av[0], Av[1]));
            TW[d * 128 + cp[0]] = __expf(Av[0] - mA); TW[d * 128 + cp[1]] = __expf(Av[1] - mA);
            if (lane == 0) { SCAL[sc_idx(b, h, d, j)] = blast + mA; SCAL[2048 + sc_idx(b, h, d, j)] = blast; }
        }
        __syncthreads();
        for (int i = tid; i < 128 * 32; i += NTHR) { const int rr = i >> 5, c = i & 31; *(LAS v4u*)(LV + rr * LV_STRIDE + c * 16) = *(const v4u*)(PROJ + (size_t)(R0 + rr) * AB_LD + vcol + 8 * c); }
        if (tid < 128) { unsigned z0 = 0u; asm volatile("" : "+v"(z0)); v4u one = {z0 + 0x3F80u, z0, z0, z0}, zero = {z0, z0, z0, z0}; *(LAS v4u*)(LV + tid * LV_STRIDE + 512) = one; *(LAS v4u*)(LV + tid * LV_STRIDE + 528) = zero; }
        for (int i = tid; i < 128 * 16; i += NTHR) { const int rr = i >> 4, c = i & 15; const v4u kv = *(const v4u*)(PROJ + (size_t)(R0 + rr) * AB_LD + kcol + 8 * c);
            const float wf = TW[rr], wb = TW[128 + rr]; v4u of, ob;
            of.x = pk2(bflo(kv.x) * wf, bfhi(kv.x) * wf); of.y = pk2(bflo(kv.y) * wf, bfhi(kv.y) * wf); of.z = pk2(bflo(kv.z) * wf, bfhi(kv.z) * wf); of.w = pk2(bflo(kv.w) * wf, bfhi(kv.w) * wf);
            ob.x = pk2(bflo(kv.x) * wb, bfhi(kv.x) * wb); ob.y = pk2(bflo(kv.y) * wb, bfhi(kv.y) * wb); ob.z = pk2(bflo(kv.z) * wb, bfhi(kv.z) * wb); ob.w = pk2(bflo(kv.w) * wb, bfhi(kv.w) * wb);
            *(LAS v4u*)(LKf + rr * LKT_STRIDE + c * 16) = of; *(LAS v4u*)(LKb + rr * LKT_STRIDE + c * 16) = ob; }
        __syncthreads();
#pragma unroll 1
        for (int d = 0; d < 2; ++d) {
            const LAS unsigned char* LK = d ? LKb : LKf;
            f32x4 acc[17];
#pragma unroll
            for (int c = 0; c < 17; ++c) acc[c] = (f32x4){0.f, 0.f, 0.f, 0.f};
            bf16x8 ka[2], vb[2][17];
#define M1_LOAD(buf_, s_) do { ka[buf_] = frag_tr(LK, LKT_STRIDE, 32 * (s_) + 8 * q4, 32 * (s_) + 8 * q4 + 4, 16 * wave, lane); \
                _Pragma("unroll") for (int c = 0; c < 17; ++c) vb[buf_][c] = frag_tr(LV, LV_STRIDE, 32 * (s_) + 8 * q4, 32 * (s_) + 8 * q4 + 4, 16 * c, lane); } while (0)
            M1_LOAD(0, 0);
#pragma unroll
            for (int s = 0; s < 4; ++s) {
                if (s < 3) M1_LOAD((s + 1) & 1, s + 1);
#pragma unroll
                for (int c = 0; c < 17; ++c) acc[c] = mfma16(ka[s & 1], vb[s & 1][c], acc[c]);
                __builtin_amdgcn_sched_barrier(0);
            }
#undef M1_LOAD
            bf16* Ub = U + (size_t)us_slot(b, h, mx, j, d) * USLOT;
#pragma unroll
            for (int c = 0; c < 17; ++c) { v2u w; w.x = pk2(acc[c][0], acc[c][1]); w.y = pk2(acc[c][2], acc[c][3]); *(v2u*)(Ub + (16 * c + r16) * 128 + 16 * wave + 4 * q4) = w; }
        }
        __syncthreads();
    }
}

DI void phase_m2(const Frame& F, const Args& A) {
    const v4u* U = WSP(const v4u, WS_A); v4u* S = WSP(v4u, WS_B); float* SCAL = WSP(float, WS_SCAL);
    constexpr int V8 = USLOT / 8, NIT = 64 * V8, NI = 3;
    const int t0 = blockIdx.x * NTHR + TID(F), NT = F.G * NTHR;
    float st[NI][8], m[NI], aret[NI]; int seqb[NI], e8[NI], dd[NI], mxx[NI], scb[NI]; bool ok[NI];
#pragma unroll
    for (int ii = 0; ii < NI; ++ii) { const int it = t0 + ii * NT; ok[ii] = it < NIT; const int itc = ok[ii] ? it : 0;
        const int seq = itc / V8; e8[ii] = itc % V8; const int d = seq & 1, mx = (seq >> 1) & 1, h = (seq >> 2) & 3, b = seq >> 4;
        dd[ii] = d; mxx[ii] = mx; seqb[ii] = (((b * 4 + h) * 2 + mx) * NCH) * 2 + d; scb[ii] = ((b * 4 + h) * 2 + d) * NCH; m[ii] = -1e30f;
        aret[ii] = __expf(128.f * logsigf_(A.in[I_DECAY][d * 4 + h]));
#pragma unroll
        for (int e = 0; e < 8; ++e) st[ii][e] = 0.f; }
#define M2_J(dir_, k_) ((dir_) ? ((k_) == 0 ? 1 : ((k_) == 1 ? 0 : 35 - (k_))) : (k_))
    v4u un[NI]; float mln[NI], bln[NI];
#pragma unroll
    for (int ii = 0; ii < NI; ++ii) { mln[ii] = 0.f; bln[ii] = 0.f; if (ok[ii]) { const int j0 = M2_J(dd[ii], 0); un[ii] = U[(size_t)(seqb[ii] + 2 * j0) * V8 + e8[ii]]; if (mxx[ii]) { mln[ii] = SCAL[scb[ii] + j0]; bln[ii] = SCAL[2048 + scb[ii] + j0]; } } }
#pragma unroll 1
    for (int k = 0; k < NCH; ++k) {
        v4u u[NI]; float mlc[NI], blc[NI];
#pragma unroll
        for (int ii = 0; ii < NI; ++ii) { u[ii] = un[ii]; mlc[ii] = mln[ii]; blc[ii] = bln[ii];
            if (ok[ii] && k + 1 < NCH) { const int j1 = M2_J(dd[ii], k + 1); un[ii] = U[(size_t)(seqb[ii] + 2 * j1) * V8 + e8[ii]]; if (mxx[ii]) { mln[ii] = SCAL[scb[ii] + j1]; bln[ii] = SCAL[2048 + scb[ii] + j1]; } } }
#pragma unroll
        for (int ii = 0; ii < NI; ++ii) if (ok[ii]) {
            const int j = M2_J(dd[ii], k); const size_t slot = (size_t)(seqb[ii] + 2 * j) * V8 + e8[ii];
            float a = aret[ii], g = 1.f;
            if (mxx[ii]) { const int si = scb[ii] + j; const float ml = mlc[ii], bl = blc[ii]; const float mn = fmaxf(bl + m[ii], ml);
                a = __expf(bl + m[ii] - mn); g = __expf(ml - mn); if (e8[ii] == 0) SCAL[4096 + si] = m[ii]; m[ii] = mn; }
            v4u o; o.x = pk2(st[ii][0], st[ii][1]); o.y = pk2(st[ii][2], st[ii][3]); o.z = pk2(st[ii][4], st[ii][5]); o.w = pk2(st[ii][6], st[ii][7]); S[slot] = o;
            st[ii][0] = a * st[ii][0] + g * bflo(u[ii].x); st[ii][1] = a * st[ii][1] + g * bfhi(u[ii].x); st[ii][2] = a * st[ii][2] + g * bflo(u[ii].y); st[ii][3] = a * st[ii][3] + g * bfhi(u[ii].y);
            st[ii][4] = a * st[ii][4] + g * bflo(u[ii].z); st[ii][5] = a * st[ii][5] + g * bfhi(u[ii].z); st[ii][6] = a * st[ii][6] + g * bflo(u[ii].w); st[ii][7] = a * st[ii][7] + g * bfhi(u[ii].w);
        }
    }
#undef M2_J
}

template <int MX, int VAR = 0> DI void m3_unit(const Frame& F, const Args& A, int b, int h, int j, bf16* MRG) {
    const int tid = TID(F);
    const int lane = tid & 63, wave = F.wave, r16 = lane & 15, q4 = lane >> 4;
    LAS unsigned char* LV = F.lds; LAS unsigned char* LS = F.lds + 71680;
    LAS float* TB = (LAS float*)(F.lds + 71680 + 73984);
    const bf16* PROJ = WSP(bf16, WS_BIG); const v4u* S = WSP(const v4u, WS_B);
    constexpr int mx = MX;
    const int R0 = chunk_row0(b, j);
    const int qcol = mx ? 3072 + 128 * h : 128 * h, kcol = mx ? 3584 + 128 * h : 512 + 128 * h, vcol = mx ? 4096 + 256 * h : 1024 + 256 * h, gcol = mx ? 5120 + 256 * h : 2048 + 256 * h;
    const float lgf = logsigf_(A.in[I_DECAY][h]), lgb = logsigf_(A.in[I_DECAY][4 + h]);
    if (mx == 0) {
        if (tid < 128) { TB[3 * 128 + tid] = __expf((float)(tid + 1) * lgf); TB[(4 + 3) * 128 + tid] = __expf((float)(128 - tid) * lgb); }
    } else if (wave < 2) {
        const int d = wave; float Av[2], Bv[2], blast; int cp[2];
        mlstm_gate_scan(WSP(float, WS_GATES), R0, h, d, lane, Av, Bv, cp, blast);
        const float mprev = WSP(float, WS_SCAL)[4096 + sc_idx(b, h, d, j)];
        float inc = fmaxf(Av[0], Av[1]);
#pragma unroll
        for (int o = 1; o < 64; o <<= 1) { const float t = __shfl_up(inc, o); if (lane >= o) inc = fmaxf(inc, t); }
        float prev = __shfl_up(inc, 1); if (lane == 0) prev = -3.0e38f;
        const float rm0 = fmaxf(prev, Av[0]), rm1 = inc;
        const float M0 = fmaxf(mprev, rm0), M1 = fmaxf(mprev, rm1);
        LAS float* T = TB + d * 4 * 128;
        T[cp[0]] = Av[0]; T[cp[1]] = Av[1]; T[128 + cp[0]] = M0; T[128 + cp[1]] = M1; T[256 + cp[0]] = Bv[0]; T[256 + cp[1]] = Bv[1];
        T[384 + cp[0]] = __expf(mprev - M0); T[384 + cp[1]] = __expf(mprev - M1);
    }
    if (!(VAR & 4)) for (int i = tid; i < 128 * 16; i += NTHR) { const int rr = i >> 4, c = i & 15; *(LAS v4u*)(LS + rr * LK_STRIDE + c * 16) = *(const v4u*)(PROJ + (size_t)(R0 + rr) * AB_LD + kcol + 8 * c); }
    if (!(VAR & 4)) for (int i = tid; i < 128 * 32; i += NTHR) { const int rr = i >> 5, c = i & 31; *(LAS v4u*)(LV + rr * LV_STRIDE + c * 16) = *(const v4u*)(PROJ + (size_t)(R0 + rr) * AB_LD + vcol + 8 * c); }
    if (tid < 128) { unsigned z0 = 0u; asm volatile("" : "+v"(z0)); v4u one = {z0 + 0x3F80u, z0, z0, z0}, zero = {z0, z0, z0, z0}; *(LAS v4u*)(LV + tid * LV_STRIDE + 512) = one; *(LAS v4u*)(LV + tid * LV_STRIDE + 528) = zero; }
    const unsigned ls_lds = (unsigned)(size_t)LS;
#define M3_DMA_S(d_, hi_) do { const v4u* Sp_ = S + (size_t)us_slot(b, h, mx, j, (d_)) * (USLOT / 8); const int p0_ = (hi_) ? 2176 : 0, lim_ = (hi_) ? 4624 : 2176; \
        _Pragma("unroll 1") for (int ins = wave; ins < ((hi_) ? 39 : 34); ins += 8) { { const int p = p0_ + ins * 64 + lane; if (p < lim_) { const int rr = p / 17, c0_ = p - rr * 17, c = c0_ == 16 ? 0 : c0_; \
            glds16(Sp_ + rr * 16 + c, ls_lds + (unsigned)(p0_ + ins * 64) * 16u); } } } } while (0)
    const int myq = 16 * wave + r16;
    bf16x8 qf[4];
#pragma unroll
    for (int s = 0; s < 4; ++s) qf[s] = *(const bf16x8*)(PROJ + (size_t)(R0 + myq) * AB_LD + qcol + 32 * s + 8 * q4);
    __syncthreads();
    asm volatile("" : "+v"(qf[0]), "+v"(qf[1]), "+v"(qf[2]), "+v"(qf[3]));
    if (!(VAR & 1)) M3_DMA_S(0, 1);
    f32x4 sc[8];
#pragma unroll
    for (int c = 0; c < 8; ++c) { sc[c] = (f32x4){0.f, 0.f, 0.f, 0.f};
#pragma unroll
        for (int s = 0; s < 4; ++s) sc[c] = mfma16(frag_row(LS, LK_STRIDE, 16 * c, 32 * s, lane), qf[s], sc[c]); }
    f32x4 hs[16];
    { float z0 = 0.f; asm volatile("" : "+v"(z0), "+v"(sc[7][3]));
#pragma unroll
      for (int c = 0; c < 16; ++c) hs[c] = (f32x4){z0, z0, z0, z0}; }
    asm volatile("s_waitcnt vmcnt(0)" ::: "memory");
    __syncthreads();
#pragma unroll 1
    for (int d = 0; d < 2; ++d) {
        const LAS float* T = TB + d * 4 * 128;
        const float sdq = T[384 + myq], Mq = mx ? T[128 + myq] : 0.f, Bq = mx ? T[256 + myq] : 0.f;
        const float lg2 = (d ? lgb : lgf) * 1.4426950408889634f;
        float inv = 1.f;
#pragma unroll
        for (int half = 0; half < 2; ++half) {
            constexpr int NTL[2] = {9, 8}; const int c0 = half ? 0 : 8;
            if (!(VAR & 1)) { if (half == 0) M3_DMA_S(d, 0); else if (d == 0) M3_DMA_S(1, 1); }
            int myq_d = myq, q4_d = q4; float sdq_d = sdq; asm volatile("" : "+v"(myq_d), "+v"(q4_d), "+v"(sdq_d));
            f32x4 acc[9];
#pragma unroll
            for (int c = 0; c < 9; ++c) acc[c] = (f32x4){0.f, 0.f, 0.f, 0.f};
#pragma unroll
            for (int s = 0; s < ((VAR & 2) ? 0 : 4); ++s) {
                float pv[8];
#pragma unroll
                for (int jj = 0; jj < 8; ++jj) { const int c = 2 * s + (jj >> 2), i = jj & 3, key = 16 * c + 4 * q4_d + i;
                    const bool valid = d ? (key >= myq_d) : (key <= myq_d);
                    float w;
                    if (mx == 0) w = __builtin_amdgcn_exp2f((float)(d ? key - myq_d : myq_d - key) * lg2); else w = __expf(T[key] - Mq);
                    pv[jj] = valid ? sc[c][i] * w : 0.f; }
                v4u pw; pw.x = pk2(pv[0], pv[1]); pw.y = pk2(pv[2], pv[3]); pw.z = pk2(pv[4], pv[5]); pw.w = pk2(pv[6], pv[7]);
                const bf16x8 pf = __builtin_bit_cast(bf16x8, pw);
                const v4u qw = __builtin_bit_cast(v4u, qf[s]); v4u qs;
                qs.x = pk2(bflo(qw.x) * sdq_d, bfhi(qw.x) * sdq_d); qs.y = pk2(bflo(qw.y) * sdq_d, bfhi(qw.y) * sdq_d); qs.z = pk2(bflo(qw.z) * sdq_d, bfhi(qw.z) * sdq_d); qs.w = pk2(bflo(qw.w) * sdq_d, bfhi(qw.w) * sdq_d);
                const bf16x8 qd = __builtin_bit_cast(bf16x8, qs);
#pragma unroll
                for (int c = 0; c < NTL[half]; ++c) {
                    acc[c] = mfma16(frag_tr(LV, LV_STRIDE, 32 * s + 4 * q4, 32 * s + 16 + 4 * q4, 16 * (c0 + c), lane), pf, acc[c]);
                    acc[c] = mfma16(frag_row(LS, LK_STRIDE, 16 * (c0 + c), 32 * s, lane), qd, acc[c]);
                    if (c % 2 == 1) __builtin_amdgcn_sched_barrier(0);
                }
                __builtin_amdgcn_sched_barrier(0);
            }
            if (half == 0 && mx == 1) { const float den = __shfl(acc[8][0], r16);
                inv = 1.f / fmaxf(fabsf(den), __expf(-(Bq + Mq))); }
#pragma unroll
            for (int c = 0; c < 8; ++c) hs[c0 + c] = hs[c0 + c] + acc[c] * inv;
            asm volatile("s_waitcnt vmcnt(0)" ::: "memory");
            __syncthreads();
        }
    }
#undef M3_DMA_S
    float s1 = 0.f;
#pragma unroll
    for (int c = 0; c < 16; ++c) s1 += (hs[c][0] + hs[c][1]) + (hs[c][2] + hs[c][3]);
    s1 += __shfl_xor(s1, 16); s1 += __shfl_xor(s1, 32);
    const float mu = s1 * (1.f / 256.f); float s2 = 0.f;
#pragma unroll
    for (int c = 0; c < 16; ++c) { const f32x4 dd = hs[c] - mu; s2 += (dd[0] * dd[0] + dd[1] * dd[1]) + (dd[2] * dd[2] + dd[3] * dd[3]); }
    s2 += __shfl_xor(s2, 16); s2 += __shfl_xor(s2, 32);
    const float rstd = __frsqrt_rn(s2 * (1.f / 256.f) + EPS);
    const float* gn = (mx ? A.in[I_MLGN] : A.in[I_RETGN]) + h * 256;
    const size_t row = (size_t)(R0 + myq);
    v2u gwv[16];
#pragma unroll
    for (int c = 0; c < 16; ++c) gwv[c] = *(const v2u*)(PROJ + row * AB_LD + gcol + 16 * c + 4 * q4);
    asm volatile("" ::: "memory");
#pragma unroll
    for (int c = 0; c < ((VAR & 8) ? 1 : 16); ++c) { const int dv = 16 * c + 4 * q4;
        const f32x4 g4 = *(const f32x4*)(gn + dv); const v2u gw = gwv[c];
        const f32x4 y = (hs[c] - mu) * rstd * g4;
        v2u w; w.x = pk2(y[0] * bflo(gw.x), y[1] * bfhi(gw.x)); w.y = pk2(y[2] * bflo(gw.y), y[3] * bfhi(gw.y));
        *(v2u*)(MRG + row * DM + mx * 1024 + h * 256 + dv) = w; }
}
template <int VAR> DI void phase_m3(const Frame& F, const Args& A, bf16* MRG) {
    for (int unit = blockIdx.x; unit < NB * 4 * NCH; unit += F.G) { const int j = unit % NCH, t_ = unit / NCH; m3_unit<0, VAR>(F, A, t_ >> 2, t_ & 3, j, MRG); }
    for (int unit = blockIdx.x; unit < NB * 4 * NCH; unit += F.G) { const int j = unit % NCH, t_ = unit / NCH; m3_unit<1, VAR>(F, A, t_ >> 2, t_ & 3, j, MRG); }
}

template <bool FINAL> DI void phase_lru(const Frame& F, const Args& A) {
    LAS unsigned char* LXB = F.lds;
    LAS float* LXF = (LAS float*)(F.lds + 35904);
    LAS unsigned char* LXL = F.lds + 35904 + 67584;
    const bf16* P2 = WSP(bf16, WS_BIG); const bf16* LWT = WSP(bf16, WS_LWT); float* AGG = WSP(float, WS_AGG); bf16* MRG = WSP(bf16, WS_XN);
    for (int unit = blockIdx.x; unit < NB * NCH * 8; unit += F.G) {
        const int g = unit & 7, bj_ = unit >> 3, j = bj_ % NCH, b = bj_ / NCH;
        if (FINAL && j < 2) continue;
        const int tid = TID(F);
        const int lane = tid & 63, wave = F.wave, r16 = lane & 15, q4 = lane >> 4;
        const int R0 = chunk_row0(b, j), seq0 = j < 2 ? ML + b * CTXL : b * SEQ, seqlen = j < 2 ? CTXL : SEQ, t0 = R0 - seq0;
        for (int i = tid; i < 131 * 16; i += NTHR) { const int rr = i >> 4, c = i & 15, t = t0 - 2 + rr; v4u v = {0u, 0u, 0u, 0u};
            if (t >= 0 && t < seqlen) v = *(const v4u*)(P2 + (size_t)(seq0 + t) * CD_N + 1024 + 128 * g + 8 * c);
            *(LAS v4u*)(LXB + rr * 272 + c * 16) = v; }
        __syncthreads();
        { const int ch = tid & 127; const float* cw = A.in[I_CONVW] + 128 * g + ch; const float w0 = cw[0], w1 = cw[1024], w2 = cw[2048], w3 = cw[3072], cb = A.in[I_CONVB][128 * g + ch];
#pragma unroll 4
          for (int k = 0; k < 32; ++k) { const int row = (tid >> 7) + 4 * k; const LAS unsigned short* xp = (const LAS unsigned short*)(LXB + row * 272 + ch * 2);
              const float xl = cb + w0 * bf2f(xp[0]) + w1 * bf2f(xp[136]) + w2 * bf2f(xp[272]) + w3 * bf2f(xp[408]);
              LXF[row * 132 + ch] = xl; *(LAS unsigned short*)(LXL + row * 272 + ch * 2) = f2bf(xl); } }
        __syncthreads();
        const int chb = 16 * wave + r16, ch = 128 * g + chb;
        float hsum[8][4];
#pragma unroll
        for (int d = 0; d < 2; ++d) {
            bf16x8 wa[4], wx[4];
#pragma unroll
            for (int s = 0; s < 4; ++s) { wa[s] = *(const bf16x8*)(LWT + (size_t)((2 * d) * 8 + g) * 16384 + chb * 128 + 32 * s + 8 * q4);
                                          wx[s] = *(const bf16x8*)(LWT + (size_t)((2 * d + 1) * 8 + g) * 16384 + chb * 128 + 32 * s + 8 * q4); }
            const float ba = A.in[I_LBA][d * 1024 + ch], bx = A.in[I_LBX][d * 1024 + ch], lam = A.in[I_LAM][d * 1024 + ch];
            const float sp8 = -8.f * (fmaxf(-lam, 0.f) + log1pf(__expf(-fabsf(lam))));
            float carry = 0.f;
            if (FINAL) {
                const float* ag = AGG + ((size_t)(d * NB + b) * NCH) * 2048 + 2 * ch;
                for (int k = 0; k < NCH; ++k) { const int jj = d ? (k == 0 ? 1 : (k == 1 ? 0 : 35 - k)) : k; if (jj == j) break; const f32x2 ph = *(const f32x2*)(ag + (size_t)jj * 2048); carry = ph.y + ph.x * carry; }
            }
            float ptot = 1.f;
#pragma unroll
            for (int mm = 0; mm < 8; ++mm) {
                const int m = d ? 7 - mm : mm;
                f32x4 aa = {0.f, 0.f, 0.f, 0.f}, ax = {0.f, 0.f, 0.f, 0.f};
#pragma unroll
                for (int s = 0; s < 4; ++s) { const bf16x8 xf = frag_row(LXL, 272, 16 * m, 32 * s, lane); aa = mfma16(xf, wa[s], aa); ax = mfma16(xf, wx[s], ax); }
                float av[4], bv[4];
#pragma unroll
                for (int i = 0; i < 4; ++i) { const int row = 16 * m + 4 * q4 + i; const float rg = sigmoidf_(aa[i] + ba), ig = sigmoidf_(ax[i] + bx), la = sp8 * rg;
                    av[i] = __expf(la); bv[i] = __builtin_amdgcn_sqrtf(fmaxf(1.f - av[i] * av[i], 0.f)) * ig * LXF[row * 132 + chb]; }
                float P = 1.f, H = 0.f;
#pragma unroll
                for (int ii = 0; ii < 4; ++ii) { const int i = d ? 3 - ii : ii; H = av[i] * H + bv[i]; P *= av[i]; }
                float hstart = carry, cnext = carry;
#pragma unroll
                for (int qq_ = 0; qq_ < 4; ++qq_) { const int qq = d ? 3 - qq_ : qq_;
                    const float Pq = __shfl(P, r16 + 16 * qq), Hq = __shfl(H, r16 + 16 * qq);
                    const bool before = d ? (qq > q4) : (qq < q4);
                    if (before) hstart = Hq + Pq * hstart;
                    cnext = Hq + Pq * cnext; ptot *= Pq; }
                if (FINAL) { float hcur = hstart;
#pragma unroll
                    for (int ii = 0; ii < 4; ++ii) { const int i = d ? 3 - ii : ii; hcur = av[i] * hcur + bv[i]; if (d == 0) hsum[m][i] = hcur; else hsum[m][i] += hcur; } }
                carry = cnext;
                __builtin_amdgcn_sched_barrier(0);
            }
            if (!FINAL && q4 == 0) { f32x2 ph; ph.x = ptot; ph.y = carry; *(f32x2*)(AGG + ((size_t)(d * NB + b) * NCH + j) * 2048 + 2 * ch) = ph; }
        }
        if (FINAL) {
            unsigned short ybv[8][4];
#pragma unroll
            for (int m = 0; m < 8; ++m)
#pragma unroll
                for (int i = 0; i < 4; ++i) ybv[m][i] = P2[(size_t)(R0 + 16 * m + 4 * q4 + i) * CD_N + ch];
            asm volatile("" ::: "memory");
#pragma unroll
            for (int m = 0; m < 8; ++m)
#pragma unroll
                for (int i = 0; i < 4; ++i) { const size_t row = (size_t)(R0 + 16 * m + 4 * q4 + i); MRG[row * DM + ch] = f2bf(bf2f(ybv[m][i]) * hsum[m][i]); }
        }
        __syncthreads();
    }
}
DI void phase_mla_norm(const Frame& F, const Args& A) {
    const int lane = lane_id(), gw = blockIdx.x * NWAVES + F.wave, NGW = F.G * NWAVES;
    const bf16* P2 = WSP(bf16, WS_BIG); bf16* CQN = WSP(bf16, WS_CQN); bf16* CKVN = WSP(bf16, WS_CKVN);
    for (int row = gw; row < MT; row += NGW) {
        const v4u q = *(const v4u*)(P2 + (size_t)row * CD_N + 2048 + 8 * lane); const v2u k = *(const v2u*)(P2 + (size_t)row * CD_N + 2560 + 4 * lane);
        float qv[8] = {bflo(q.x), bfhi(q.x), bflo(q.y), bfhi(q.y), bflo(q.z), bfhi(q.z), bflo(q.w), bfhi(q.w)}, kv[4] = {bflo(k.x), bfhi(k.x), bflo(k.y), bfhi(k.y)};
        float sq = 0.f, sk = 0.f;
#pragma unroll
        for (int e = 0; e < 8; ++e) sq += qv[e] * qv[e];
#pragma unroll
        for (int e = 0; e < 4; ++e) sk += kv[e] * kv[e];
        const float rq = __frsqrt_rn(wave_sum(sq) * (1.f / 512.f) + EPS), rk = __frsqrt_rn(wave_sum(sk) * (1.f / 256.f) + EPS);
        const float* gq = A.in[I_QNG] + 8 * lane; const float* gk = A.in[I_KVNG] + 4 * lane;
        v4u oq; oq.x = pk2(qv[0] * rq * gq[0], qv[1] * rq * gq[1]); oq.y = pk2(qv[2] * rq * gq[2], qv[3] * rq * gq[3]); oq.z = pk2(qv[4] * rq * gq[4], qv[5] * rq * gq[5]); oq.w = pk2(qv[6] * rq * gq[6], qv[7] * rq * gq[7]);
        v2u ok; ok.x = pk2(kv[0] * rk * gk[0], kv[1] * rk * gk[1]); ok.y = pk2(kv[2] * rk * gk[2], kv[3] * rk * gk[3]);
        *(v4u*)(CQN + (size_t)row * 512 + 8 * lane) = oq; *(v2u*)(CKVN + (size_t)row * 256 + 4 * lane) = ok;
    }
}
DI void qk_head_norm(const v4u (&x)[3], const float (&g)[24], float scale, bool rot, const f32x4 (&cs)[2], const f32x4 (&sn)[2], int sub, bf16* op) {
    float v[24];
#pragma unroll
    for (int i = 0; i < 3; ++i) { v[8 * i] = bflo(x[i].x); v[8 * i + 1] = bfhi(x[i].x); v[8 * i + 2] = bflo(x[i].y); v[8 * i + 3] = bfhi(x[i].y); v[8 * i + 4] = bflo(x[i].z); v[8 * i + 5] = bfhi(x[i].z); v[8 * i + 6] = bflo(x[i].w); v[8 * i + 7] = bfhi(x[i].w); }
    float ss = 0.f;
#pragma unroll
    for (int i = 0; i < 24; ++i) ss += v[i] * v[i];
    ss += __shfl_xor(ss, 1); ss += __shfl_xor(ss, 2); ss += __shfl_xor(ss, 4);
    const float rs = __frsqrt_rn(ss * (1.f / 192.f) + EPS) * scale;
#pragma unroll
    for (int i = 0; i < 24; ++i) v[i] = v[i] * rs * g[i];
#pragma unroll
    for (int i = 0; i < 8; ++i) { const float own = v[16 + i], pr = __shfl_xor(own, 2); const float c = cs[i >> 2][i & 3], s_ = sn[i >> 2][i & 3];
        if (rot) v[16 + i] = (sub & 2) ? pr * s_ + own * c : own * c - pr * s_; }
    v4u o0, o1, o2;
    o0.x = pk2(v[0], v[1]); o0.y = pk2(v[2], v[3]); o0.z = pk2(v[4], v[5]); o0.w = pk2(v[6], v[7]);
    o1.x = pk2(v[8], v[9]); o1.y = pk2(v[10], v[11]); o1.z = pk2(v[12], v[13]); o1.w = pk2(v[14], v[15]);
    o2.x = pk2(v[16], v[17]); o2.y = pk2(v[18], v[19]); o2.z = pk2(v[20], v[21]); o2.w = pk2(v[22], v[23]);
    *(v4u*)(op + sub * 16) = o0; *(v4u*)(op + sub * 16 + 8) = o1; *(v4u*)(op + 128 + sub * 8) = o2;
}
DI void phase_qk_norm(const Frame& F, const Args& A) {
    const int lane = lane_id(), gw = blockIdx.x * NWAVES + F.wave, NGW = F.G * NWAVES, h = lane >> 3, sub = lane & 7;
    const bf16* P2 = WSP(bf16, WS_BIG); const bf16* QRAW = WSP(bf16, WS_A); const bf16* KVRAW = WSP(bf16, WS_KVRAW); bf16* QF = WSP(bf16, WS_QF); bf16* KF = WSP(bf16, WS_KF);
    const float* axc = WSP(float, WS_AXC); const float* axs = WSP(float, WS_AXS);
    const float* g0 = A.in[I_QKNG]; const float* g1 = g0 + 192;
    float gq[24], gk[24];
#pragma unroll
    for (int i = 0; i < 16; ++i) { gq[i] = g0[sub * 16 + i]; gk[i] = g1[sub * 16 + i]; }
#pragma unroll
    for (int i = 0; i < 8; ++i) { gq[16 + i] = g0[128 + sub * 8 + i]; gk[16 + i] = g1[128 + sub * 8 + i]; }
    constexpr float QS = 0.07216878364870323f * 1.4426950408889634f;
    for (int row = gw; row < MT; row += NGW) {
        const bool lat = row < ML;
        f32x4 cs[2] = {{1.f, 1.f, 1.f, 1.f}, {1.f, 1.f, 1.f, 1.f}}, sn[2] = {{0.f, 0.f, 0.f, 0.f}, {0.f, 0.f, 0.f, 0.f}};
        if (lat) { const int t = row & (SEQ - 1), pos = sub < 4 ? (t >> 6) : (t & 63); const f32x4* cp = (const f32x4*)(axc + pos * 16 + (sub & 1) * 8); const f32x4* sp = (const f32x4*)(axs + pos * 16 + (sub & 1) * 8);
            cs[0] = cp[0]; cs[1] = cp[1]; sn[0] = sp[0]; sn[1] = sp[1]; }
        v4u kx[3]; kx[0] = *(const v4u*)(KVRAW + (size_t)row * 2048 + h * 128 + sub * 16); kx[1] = *(const v4u*)(KVRAW + (size_t)row * 2048 + h * 128 + sub * 16 + 8); kx[2] = *(const v4u*)(P2 + (size_t)row * CD_N + 2816 + sub * 8);
        v4u qx[3];
        if (lat) { const bf16* qp = QRAW + (size_t)row * 1536 + h * 192; qx[0] = *(const v4u*)(qp + sub * 16); qx[1] = *(const v4u*)(qp + sub * 16 + 8); qx[2] = *(const v4u*)(qp + 128 + sub * 8); }
        else { qx[0] = kx[0]; qx[1] = kx[1]; qx[2] = kx[2]; }
        qk_head_norm(kx, gk, 1.f, lat, cs, sn, sub, KF + (size_t)row * 1536 + h * 192);
        if (lat) qk_head_norm(qx, gq, QS, true, cs, sn, sub, QF + (size_t)row * 1536 + h * 192);
    }
}
constexpr int AK_STRIDE = 400, AV_STRIDE = 288, AK_BYTES = 64 * AK_STRIDE, AV_BYTES = 64 * AV_STRIDE, ABUF = AK_BYTES + AV_BYTES;
DI int key_row(int b, int n) { return n < CTXL ? ML + b * CTXL + n : b * SEQ + (n - CTXL); }
constexpr int AKB = AK_BYTES, AVB = 64 * AV_STRIDE;
template <int VAR> DI void phase_attn(const Frame& F, const Args& A, bf16* MRG) {
    const bf16* QF = WSP(bf16, WS_QF); const bf16* KF = WSP(bf16, WS_KF); const bf16* KVRAW = WSP(bf16, WS_KVRAW);
    constexpr int NT = (CTXL + SEQ) / 64;
    LAS unsigned char* KB0 = F.lds; LAS unsigned char* VB0 = F.lds + 2 * AKB;
    const unsigned kb_lds = (unsigned)(size_t)KB0, vb_lds = (unsigned)(size_t)VB0;
    for (int unit = blockIdx.x; unit < NB * 8 * 16; unit += F.G) {
        const int tid = TID(F);
        const int lane = tid & 63, wave = F.wave, r16 = lane & 15, q4 = lane >> 4;
        const int qb = unit & 15, h = (unit >> 4) & 7, b = unit >> 7;
        const size_t qrow0 = (size_t)b * SEQ + qb * 256 + 32 * wave + r16;
        bf16x8 qf[2][6];
#pragma unroll
        for (int qt = 0; qt < 2; ++qt)
#pragma unroll
            for (int s = 0; s < 6; ++s) qf[qt][s] = *(const bf16x8*)(QF + (qrow0 + 16 * qt) * 1536 + h * 192 + 32 * s + 8 * q4);
#define ATT_DMA_K(t, buf) do { _Pragma("unroll") for (int x = 0; x < 4; ++x) { const int ins = wave + 8 * x; if (ins < 25) { const int p = ins * 64 + lane, rr = p / 25, c0_ = p - rr * 25, c = c0_ == 24 ? 0 : c0_; \
            glds16(KF + (size_t)key_row(b, 64 * (t) + rr) * 1536 + h * 192 + 8 * c, kb_lds + (buf) * AKB + ins * 1024); } } } while (0)
#define ATT_DMA_V(t, buf) do { _Pragma("unroll") for (int x = 0; x < 3; ++x) { const int ins = wave + 8 * x; if (ins < 18) { const int p = ins * 64 + lane, rr = p / 18, c0_ = p - rr * 18, c = c0_ >= 16 ? 0 : c0_; \
            glds16(KVRAW + (size_t)key_row(b, 64 * (t) + rr) * 2048 + 1024 + h * 128 + 8 * c, vb_lds + (buf) * AVB + ins * 1024); } } } while (0)
        ATT_DMA_K(0, 0); ATT_DMA_V(0, 0);
        asm volatile("s_waitcnt vmcnt(0)" ::: "memory");
        __syncthreads();
        f32x4 o[2][8];
#pragma unroll
        for (int qt = 0; qt < 2; ++qt)
#pragma unroll
            for (int c = 0; c < 8; ++c) o[qt][c] = (f32x4){0.f, 0.f, 0.f, 0.f};
        float mrun[2] = {-1e30f, -1e30f}, lrun[2] = {0.f, 0.f};
#pragma unroll 1
        for (int t = 0; t < NT; ++t) {
            if (t + 1 < NT) { ATT_DMA_K(t + 1, (t + 1) & 1); ATT_DMA_V(t + 1, (t + 1) & 1); }
            const LAS unsigned char* kb = KB0 + (t & 1) * AKB; const LAS unsigned char* vb = VB0 + (t & 1) * AVB;
            f32x4 sc[2][4]; bf16x8 kf[2][6];
#pragma unroll
            for (int s = 0; s < 6; ++s) kf[0][s] = frag_row(kb, AK_STRIDE, 0, 32 * s, lane);
#pragma unroll
            for (int c = 0; c < 4; ++c) {
                if (c < 3) {
#pragma unroll
                    for (int s = 0; s < 6; ++s) kf[(c + 1) & 1][s] = frag_row(kb, AK_STRIDE, 16 * (c + 1), 32 * s, lane); }
                sc[0][c] = (f32x4){0.f, 0.f, 0.f, 0.f}; sc[1][c] = (f32x4){0.f, 0.f, 0.f, 0.f};
#pragma unroll
                for (int s = 0; s < ((VAR & 1) ? 1 : 6); ++s) { sc[0][c] = mfma16(kf[c & 1][s], qf[0][s], sc[0][c]); sc[1][c] = mfma16(kf[c & 1][s], qf[1][s], sc[1][c]); }
                __builtin_amdgcn_sched_barrier(0);
            }
            bf16x8 vf[2][4];
#define ATT_LOADV_GRP(dst, g_) do { _Pragma("unroll") for (int j = 0; j < 4; ++j) dst[j] = frag_tr(vb, AV_STRIDE, 32 * ((g_) >> 1) + 4 * q4, 32 * ((g_) >> 1) + 16 + 4 * q4, 16 * (4 * ((g_) & 1) + j), lane); } while (0)
            ATT_LOADV_GRP(vf[0], 0);
            bf16x8 pf[2][2];
#pragma unroll
            for (int qt = 0; qt < 2; ++qt) {
                float mx = fmaxf(fmaxf(fmaxf(sc[qt][0][0], sc[qt][0][1]), fmaxf(sc[qt][0][2], sc[qt][0][3])), fmaxf(fmaxf(sc[qt][1][0], sc[qt][1][1]), fmaxf(sc[qt][1][2], sc[qt][1][3])));
                mx = fmaxf(mx, fmaxf(fmaxf(fmaxf(sc[qt][2][0], sc[qt][2][1]), fmaxf(sc[qt][2][2], sc[qt][2][3])), fmaxf(fmaxf(sc[qt][3][0], sc[qt][3][1]), fmaxf(sc[qt][3][2], sc[qt][3][3]))));
                mx = fmaxf(mx, __shfl_xor(mx, 16)); mx = fmaxf(mx, __shfl_xor(mx, 32));
                float mnew = mrun[qt];
                if (__any(mx > mrun[qt] + 10.f)) {
                    mnew = fmaxf(mrun[qt], mx); const float alpha = __builtin_amdgcn_exp2f(mrun[qt] - mnew); mrun[qt] = mnew; lrun[qt] *= alpha;
#pragma unroll
                    for (int c = 0; c < 8; ++c) o[qt][c] = o[qt][c] * alpha;
                }
                float ps = 0.f;
#pragma unroll
                for (int c = 0; c < 4; ++c)
#pragma unroll
                    for (int i = 0; i < 4; ++i) { sc[qt][c][i] = __builtin_amdgcn_exp2f(sc[qt][c][i] - mnew); ps += sc[qt][c][i]; }
                lrun[qt] += ps;
#pragma unroll
                for (int s = 0; s < 2; ++s) { v4u pw; pw.x = pk2(sc[qt][2 * s][0], sc[qt][2 * s][1]); pw.y = pk2(sc[qt][2 * s][2], sc[qt][2 * s][3]); pw.z = pk2(sc[qt][2 * s + 1][0], sc[qt][2 * s + 1][1]); pw.w = pk2(sc[qt][2 * s + 1][2], sc[qt][2 * s + 1][3]);
                    pf[qt][s] = __builtin_bit_cast(bf16x8, pw); }
            }
            __builtin_amdgcn_sched_barrier(0);
#pragma unroll
            for (int g = 0; g < ((VAR & 4) ? 1 : 4); ++g) {
                if (g < 3) ATT_LOADV_GRP(vf[(g + 1) & 1], g + 1);
#pragma unroll
                for (int j = 0; j < 4; ++j) { const int c = 4 * (g & 1) + j; o[0][c] = mfma16(vf[g & 1][j], pf[0][g >> 1], o[0][c]); o[1][c] = mfma16(vf[g & 1][j], pf[1][g >> 1], o[1][c]); }
                __builtin_amdgcn_sched_barrier(0);
            }
#undef ATT_LOADV_GRP
            asm volatile("s_waitcnt vmcnt(0)" ::: "memory");
            __syncthreads();
        }
#undef ATT_DMA_K
#undef ATT_DMA_V
#pragma unroll
        for (int qt = 0; qt < 2; ++qt) {
            float l = lrun[qt]; l += __shfl_xor(l, 16); l += __shfl_xor(l, 32);
            const float inv = 1.f / l;
#pragma unroll
            for (int c = 0; c < 8; ++c) { v2u w; w.x = pk2(o[qt][c][0] * inv, o[qt][c][1] * inv); w.y = pk2(o[qt][c][2] * inv, o[qt][c][3] * inv); *(v2u*)(MRG + (qrow0 + 16 * qt) * DM + 1024 + h * 128 + 16 * c + 4 * q4) = w; }
        }
    }
}

#ifndef MK_KROT
#define MK_KROT 0
#endif
#define GEMM_PHASE(EPI, Aptr, Bptr, M_, N_, K_, Eobj) do { pg8::Gemm g_{(const pg8::bf16_t*)(Aptr), (const pg8::bf16_t*)(Bptr), (M_), (N_), (K_), (K_)}; pg8::StaticOrder S_; S_.init((M_), (N_), F.G, vcu, (MK_KROT) && (K_) >= 1024); \
        pg8::gemm_phase<EPI, pg8::StaticOrder, true, true>(F.lds, g_, S_, (Eobj)); } while (0)
#define GEMM_CTX_SPLIT(Aptr, Bptr, KP, LDK) do { const int c_ = vcu, ks_ = c_ >> 5; int p0_, np_; \
        if ((KP) == 43) { np_ = ks_ < 3 ? 6 : 5; p0_ = ks_ < 3 ? 6 * ks_ : 18 + 5 * (ks_ - 3); } else { np_ = (KP) / 8; p0_ = np_ * ks_; } \
        pg8::Gemm g_{(const pg8::bf16_t*)(Aptr), (const pg8::bf16_t*)(Bptr), MC, DM, np_ * 128, (LDK)}; pg8::SplitOrder S_{c_, p0_ * 128}; EpiPartial E_{PART + (size_t)ks_ * MC * DM}; \
        pg8::gemm_phase<EpiPartial, pg8::SplitOrder, true, true>(F.lds, g_, S_, E_); } while (0)

DI void xcd_or_nothing(const XcdBarrier& bar, bool multi) { if (multi) xcd_barrier(bar); }
__global__ void __launch_bounds__(NTHR, 2) mk_fwd(Args A) {
    extern __shared__ __attribute__((aligned(16))) unsigned char lds_raw[];
    Frame F; F.lds = (LAS unsigned char*)lds_raw; F.wave = __builtin_amdgcn_readfirstlane((int)threadIdx.x >> 6); F.G = gridDim.x; F.a = &A;
    volatile LAS unsigned* MISC = (volatile LAS unsigned*)(F.lds + MISC_OFF);
    if (threadIdx.x < 64) MISC[threadIdx.x] = 0u;
    __syncthreads();
    const int lo = A.ph_lo, hi = A.ph_hi < MK_STOP_AFTER + 1 ? A.ph_hi : MK_STOP_AFTER + 1;
    const bool multi = (hi - lo) > 1;
    XcdBarrier bar; bar.bar = (unsigned*)(A.ws + WS_CTL) + CW_BAR; bar.x = 0; bar.st = nullptr; bar.w = F.wave;
    if (multi) bar = xcd_barrier_post((unsigned*)(A.ws + WS_CTL) + CW_BAR, MISC + 8);
    int vcu = (int)blockIdx.x;
    if (multi && F.G <= 256) { if (threadIdx.x == 0) { unsigned* ctl = (unsigned*)(A.ws + WS_CTL); const unsigned x = xb_xcc_id() & 7u; const unsigned rk = atomicAdd(&ctl[8192 + 64 * x], 1u);
            __hip_atomic_store(&ctl[16384 + blockIdx.x], rk * 8u + x + 1u, RLX_AGENT); } }
#ifndef MK_PHASE_MASK
#define MK_PHASE_MASK 0xFFFFFFFFull
#endif
#define IN(k) ((((MK_PHASE_MASK) >> (k)) & 1ull) && lo <= (k) && (k) < hi)
#if defined(MK_DOUBLE_BAR)
#define SEAM(k) do { if (IN((k) + 1)) { xcd_barrier(bar); xcd_barrier(bar); } } while (0)
#else
#define SEAM(k) do { if (IN((k) + 1)) xcd_barrier(bar); } while (0)
#endif
#ifndef MK_REPEAT_MASK
#define MK_REPEAT_MASK 0ull
#endif
#define REPK(k) ((int)(((MK_REPEAT_MASK) >> (k)) & 1ull))
    float* XL = A.out; float* XC = WSP(float, WS_XC); float* SCRL = WSP(float, WS_B); float* SCRC = WSP(float, WS_B + 128 * MiB); float* PART = WSP(float, WS_A); const CtxFix NOFIX{nullptr, nullptr, nullptr, 0.f}; const float* MOD = WSP(float, WS_MOD);
    bf16* XN = WSP(bf16, WS_XN); bf16* BIG = WSP(bf16, WS_BIG);

    if (IN(0)) { _Pragma("unroll") for (int rep = 0; rep < 1 + REPK(0); ++rep) { if (rep) xcd_or_nothing(bar, multi); phase_pre(F, A, rep == 0); } SEAM(0); }
    if (multi && F.G <= 256) {
        const unsigned* ctl = (const unsigned*)(A.ws + WS_CTL); LAS unsigned* cnt = (LAS unsigned*)(F.lds + MISC_OFF + 64);
        const int tid_ = TID(F);
        if (tid_ == 0) *cnt = 0u;
        __syncthreads();
        const unsigned mine = __hip_atomic_load(&ctl[16384 + blockIdx.x], RLX_AGENT);
        if (tid_ < F.G) { const unsigned kj = __hip_atomic_load(&ctl[16384 + tid_], RLX_AGENT); if (kj < mine) atomicAdd((unsigned*)cnt, 1u); }
        __syncthreads();
        vcu = (int)*cnt;
        __syncthreads();
    }
    if (IN(1)) { _Pragma("unroll") for (int rep = 0; rep < 1 + REPK(1); ++rep) { if (rep) xcd_or_nothing(bar, multi); phase_norm(F, A, 0, 0, MT, true, NOFIX); } SEAM(1); }
    if (IN(2)) { { EpiUp E{BIG}; GEMM_PHASE(EpiUp, XN, WSP(bf16, WS_WGU), MT, NGU, DM, E); }
#if defined(MK_PROBE_SAMETILE)
        { xcd_or_nothing(bar, multi); EpiUp E{(bf16*)SCRL}; pg8::Gemm g_{(const pg8::bf16_t*)XN, (const pg8::bf16_t*)WSP(bf16, WS_WGU), MT, NGU, DM, DM}; pg8::SameTileOrder S_; S_.init(MT, NGU, F.G, (int)blockIdx.x);
          pg8::gemm_phase<EpiUp, pg8::SameTileOrder, true, true>(F.lds, g_, S_, E); }
#endif
#if defined(MK_PROBE_NULLEPI)
        { xcd_or_nothing(bar, multi); EpiNull<true> E{SCRL + (size_t)blockIdx.x * 4096}; pg8::Gemm g_{(const pg8::bf16_t*)XN, (const pg8::bf16_t*)WSP(bf16, WS_WGU), MT, NGU, DM, DM}; pg8::StaticOrder S_; S_.init(MT, NGU, F.G, vcu);
          pg8::gemm_phase<EpiNull<true>, pg8::StaticOrder, true, true>(F.lds, g_, S_, E); }
#endif
#if defined(MK_PROBE_FEW)
        { xcd_or_nothing(bar, multi); EpiUp E{(bf16*)SCRL}; pg8::Gemm g_{(const pg8::bf16_t*)XN, (const pg8::bf16_t*)WSP(bf16, WS_WGU), MT, NGU, DM, DM}; pg8::FewTileOrder S_; S_.init(MT, NGU, F.G, vcu);
          pg8::gemm_phase<EpiUp, pg8::FewTileOrder, true, true>(F.lds, g_, S_, E); }
#endif
#if defined(MK_PROBE_FIX)
        { xcd_or_nothing(bar, multi); EpiUp E{(bf16*)SCRL}; pg8::Gemm g_{(const pg8::bf16_t*)XN, (const pg8::bf16_t*)WSP(bf16, WS_WGU), MT, NGU, DM, DM}; pg8::ProbeOrder<(MK_PROBE_FIX & 1) != 0, (MK_PROBE_FIX & 2) != 0> S_; S_.init(MT, NGU, F.G, vcu);
          pg8::gemm_phase<EpiUp, pg8::ProbeOrder<(MK_PROBE_FIX & 1) != 0, (MK_PROBE_FIX & 2) != 0>, true, true>(F.lds, g_, S_, E); }
#endif
        SEAM(2); }
    if (IN(3)) { _Pragma("unroll") for (int rep = 0; rep < 1 + REPK(3); ++rep) { if (rep) xcd_or_nothing(bar, multi); EpiResid E{A.in[I_X], A.in[I_CTX], rep ? SCRL : XL, rep ? SCRC : XC, MOD + 2 * DM, 0.5f}; GEMM_PHASE(EpiResid, BIG, WSP(bf16, WS_WD), ML, DM, FF, E); if (!rep) GEMM_CTX_SPLIT(BIG + (size_t)ML * FF, WSP(bf16, WS_WD), 43, FF); }
#if defined(MK_PROBE_NULLEPI_DOWN)
        { xcd_or_nothing(bar, multi); EpiNull<false> E{SCRL + (size_t)blockIdx.x * 4096}; pg8::Gemm g_{(const pg8::bf16_t*)BIG, (const pg8::bf16_t*)WSP(bf16, WS_WD), ML, DM, FF, FF}; pg8::StaticOrder S_; S_.init(ML, DM, F.G, vcu);
          pg8::gemm_phase<EpiNull<false>, pg8::StaticOrder, true, true>(F.lds, g_, S_, E); }
#endif
#if defined(MK_PROBE_SAMETILE_DOWN)
        { xcd_or_nothing(bar, multi); EpiResid E{A.in[I_X], A.in[I_CTX], SCRL, SCRC, MOD + 2 * DM, 0.5f}; pg8::Gemm g_{(const pg8::bf16_t*)BIG, (const pg8::bf16_t*)WSP(bf16, WS_WD), ML, DM, FF, FF}; pg8::SameTileOrder S_; S_.init(ML, DM, F.G, (int)blockIdx.x);
          pg8::gemm_phase<EpiResid, pg8::SameTileOrder, true, true>(F.lds, g_, S_, E); }
#endif
        SEAM(3); }
    if (IN(4)) { _Pragma("unroll") for (int rep = 0; rep < 1 + REPK(4); ++rep) { if (rep) xcd_or_nothing(bar, multi); phase_norm(F, A, 0, 1, MT, false, CtxFix{A.in[I_CTX], PART, MOD + 4 * MODW + 2 * DM, 0.5f}); } SEAM(4); }
    if (IN(5)) { _Pragma("unroll") for (int rep = 0; rep < 1 + REPK(5); ++rep) { if (rep) xcd_or_nothing(bar, multi); EpiProjAB E{BIG, WSP(float, WS_GATES), A.in[I_GATEB], WSP(float, WS_ROPEC), WSP(float, WS_ROPES)}; GEMM_PHASE(EpiProjAB, XN, WSP(bf16, WS_ABWIN), MT, AB_N, DM, E); } SEAM(5); }
    if (IN(6)) { _Pragma("unroll") for (int rep = 0; rep < 1 + REPK(6); ++rep) { if (rep) xcd_or_nothing(bar, multi); phase_m1(F, A); } SEAM(6); }
    if (IN(7)) { _Pragma("unroll") for (int rep = 0; rep < 1 + REPK(7); ++rep) { if (rep) xcd_or_nothing(bar, multi); phase_m2(F, A); } SEAM(7); }
    if (IN(8)) { phase_m3<0>(F, A, XN);
#if defined(MK_PROBE_M3)
        xcd_or_nothing(bar, multi); phase_m3<MK_PROBE_M3>(F, A, (bf16*)SCRL);
#endif
        SEAM(8); }
    if (IN(9)) { _Pragma("unroll") for (int rep = 0; rep < 1 + REPK(9); ++rep) { if (rep) xcd_or_nothing(bar, multi); EpiResid E{XL, XC, rep ? SCRL : XL, rep ? SCRC : XC, MOD + 5 * DM, 1.f}; GEMM_PHASE(EpiResid, XN, WSP(bf16, WS_ABWOUT), ML, DM, DM, E); if (!rep) GEMM_CTX_SPLIT(XN + (size_t)ML * DM, WSP(bf16, WS_ABWOUT), 16, DM); } SEAM(9); }
    if (IN(10)) { _Pragma("unroll") for (int rep = 0; rep < 1 + REPK(10); ++rep) { if (rep) xcd_or_nothing(bar, multi); phase_norm(F, A, 0, 2, MT, false, CtxFix{XC, PART, MOD + 4 * MODW + 5 * DM, 1.f}); } SEAM(10); }
    if (IN(11)) { _Pragma("unroll") for (int rep = 0; rep < 1 + REPK(11); ++rep) { if (rep) xcd_or_nothing(bar, multi); EpiUp E{BIG}; GEMM_PHASE(EpiUp, XN, WSP(bf16, WS_WGU) + (size_t)1 * NGU * DM, MT, NGU, DM, E); } SEAM(11); }
    if (IN(12)) { _Pragma("unroll") for (int rep = 0; rep < 1 + REPK(12); ++rep) { if (rep) xcd_or_nothing(bar, multi); EpiResid E{XL, XC, rep ? SCRL : XL, rep ? SCRC : XC, MOD + 8 * DM, 0.5f}; GEMM_PHASE(EpiResid, BIG, WSP(bf16, WS_WD) + (size_t)1 * DM * FF, ML, DM, FF, E); if (!rep) GEMM_CTX_SPLIT(BIG + (size_t)ML * FF, WSP(bf16, WS_WD) + (size_t)1 * DM * FF, 43, FF); } SEAM(12); }
    const float* MOD1 = MOD + 5 * MODW;
    if (IN(13)) { _Pragma("unroll") for (int rep = 0; rep < 1 + REPK(13); ++rep) { if (rep) xcd_or_nothing(bar, multi); phase_norm(F, A, 1, 0, MT, false, CtxFix{XC, PART, MOD + 4 * MODW + 8 * DM, 0.5f}); } SEAM(13); }
    if (IN(14)) { _Pragma("unroll") for (int rep = 0; rep < 1 + REPK(14); ++rep) { if (rep) xcd_or_nothing(bar, multi); EpiUp E{BIG}; GEMM_PHASE(EpiUp, XN, WSP(bf16, WS_WGU) + (size_t)2 * NGU * DM, MT, NGU, DM, E); } SEAM(14); }
    if (IN(15)) { _Pragma("unroll") for (int rep = 0; rep < 1 + REPK(15); ++rep) { if (rep) xcd_or_nothing(bar, multi); EpiResid E{XL, XC, rep ? SCRL : XL, rep ? SCRC : XC, MOD1 + 2 * DM, 0.5f}; GEMM_PHASE(EpiResid, BIG, WSP(bf16, WS_WD) + (size_t)2 * DM * FF, ML, DM, FF, E); if (!rep) GEMM_CTX_SPLIT(BIG + (size_t)ML * FF, WSP(bf16, WS_WD) + (size_t)2 * DM * FF, 43, FF); } SEAM(15); }
    if (IN(16)) { _Pragma("unroll") for (int rep = 0; rep < 1 + REPK(16); ++rep) { if (rep) xcd_or_nothing(bar, multi); phase_norm(F, A, 1, 1, MT, false, CtxFix{XC, PART, MOD1 + 4 * MODW + 2 * DM, 0.5f}); } SEAM(16); }
    if (IN(17)) { _Pragma("unroll") for (int rep = 0; rep < 1 + REPK(17); ++rep) { if (rep) xcd_or_nothing(bar, multi); EpiPlain E{BIG, CD_N, 4}; GEMM_PHASE(EpiPlain, XN, WSP(bf16, WS_CDWIN), MT, CD_N, DM, E); } SEAM(17); }
    if (IN(18)) { _Pragma("unroll") for (int rep = 0; rep < 1 + REPK(18); ++rep) { if (rep) xcd_or_nothing(bar, multi); phase_mla_norm(F, A); phase_lru<false>(F, A); } SEAM(18); }
    if (IN(19)) { _Pragma("unroll") for (int rep = 0; rep < 1 + REPK(19); ++rep) { if (rep) xcd_or_nothing(bar, multi); { EpiPlain E{WSP(bf16, WS_A), 1536, 0}; GEMM_PHASE(EpiPlain, WSP(bf16, WS_CQN), WSP(bf16, WS_WUQ), ML, 1536, 512, E); }
                  { EpiPlain E{WSP(bf16, WS_KVRAW), 2048, 0}; GEMM_PHASE(EpiPlain, WSP(bf16, WS_CKVN), WSP(bf16, WS_WUKV), MT, 2048, 256, E); }
                  phase_lru<true>(F, A); } SEAM(19); }
    if (IN(20)) { _Pragma("unroll") for (int rep = 0; rep < 1 + REPK(20); ++rep) { if (rep) xcd_or_nothing(bar, multi); phase_qk_norm(F, A); } SEAM(20); }
    if (IN(21)) { phase_attn<0>(F, A, XN);
#if defined(MK_PROBE_ATT)
        xcd_or_nothing(bar, multi); phase_attn<MK_PROBE_ATT>(F, A, (bf16*)SCRL);
#endif
        SEAM(21); }
    if (IN(22)) { _Pragma("unroll") for (int rep = 0; rep < 1 + REPK(22); ++rep) { if (rep) xcd_or_nothing(bar, multi); EpiResid E{XL, XC, rep ? SCRL : XL, rep ? SCRC : XC, MOD1 + 5 * DM, 1.f}; GEMM_PHASE(EpiResid, XN, WSP(bf16, WS_CDWOUT), ML, DM, DM, E); } SEAM(22); }
    if (IN(23)) { _Pragma("unroll") for (int rep = 0; rep < 1 + REPK(23); ++rep) { if (rep) xcd_or_nothing(bar, multi); phase_norm(F, A, 1, 2, ML, false, NOFIX); } SEAM(23); }
    if (IN(24)) { _Pragma("unroll") for (int rep = 0; rep < 1 + REPK(24); ++rep) { if (rep) xcd_or_nothing(bar, multi); EpiUp E{BIG}; GEMM_PHASE(EpiUp, XN, WSP(bf16, WS_WGU) + (size_t)3 * NGU * DM, ML, NGU, DM, E); } SEAM(24); }
    if (IN(25)) { _Pragma("unroll") for (int rep = 0; rep < 1 + REPK(25); ++rep) { if (rep) xcd_or_nothing(bar, multi); EpiResid E{XL, XC, rep ? SCRL : XL, rep ? SCRC : XC, MOD1 + 8 * DM, 0.5f}; GEMM_PHASE(EpiResid, BIG, WSP(bf16, WS_WD) + (size_t)3 * DM * FF, ML, DM, FF, E); } }
#undef IN
#undef SEAM
}

extern "C" void kernel_launch(void* const* d_in, const int* in_sizes, int n_in, void* d_out, int out_size, void* d_ws, size_t ws_size, hipStream_t stream) {
    static int grid = 0;
    if (grid == 0) {
        if (n_in != 31 || out_size != ML * DM || ws_size < WS_END) { fprintf(stderr, "kernel_launch: unexpected problem (n_in %d, out %d, ws %zu < %zu); nothing launched\n", n_in, out_size, ws_size, (size_t)WS_END); grid = -1; return; }
        int dev = 0, cus = 0, per_cu = 0;
        if (hipGetDevice(&dev) != hipSuccess || hipDeviceGetAttribute(&cus, hipDeviceAttributeMultiprocessorCount, dev) != hipSuccess) { grid = -1; return; }
        if (hipFuncSetAttribute((const void*)mk_fwd, hipFuncAttributeMaxDynamicSharedMemorySize, LDS_BYTES) != hipSuccess) { fprintf(stderr, "kernel_launch: hipFuncSetAttribute failed\n"); grid = -1; return; }
        if (hipOccupancyMaxActiveBlocksPerMultiprocessor(&per_cu, (const void*)mk_fwd, NTHR, LDS_BYTES) != hipSuccess || per_cu < 1 || cus < 256) {
            fprintf(stderr, "kernel_launch: the occupancy query reports %d workgroups per CU on %d CUs; the grid barrier needs 256 resident workgroups; nothing launched\n", per_cu, cus); (void)hipGetLastError(); grid = -1; return; }
        (void)hipGetLastError();
        grid = 256;
    }
    if (grid < 0) return;
    if (hipMemsetAsync((char*)d_ws + WS_CTL, 0, CTL_ZERO_BYTES, stream) != hipSuccess) return;
    Args a{};
    for (int i = 0; i < 31; ++i) a.in[i] = (const float*)d_in[i];
    a.out = (float*)d_out; a.ws = (unsigned char*)d_ws;
#if MK_ONE_LAUNCH
    a.ph_lo = 0; a.ph_hi = NPHASE;
    hipLaunchKernelGGL(mk_fwd, dim3(grid), dim3(NTHR), LDS_BYTES, stream, a);
#else
    for (int ph = 0; ph < NPHASE && ph <= MK_STOP_AFTER; ++ph) { a.ph_lo = ph; a.ph_hi = ph + 1; hipLaunchKernelGGL(mk_fwd, dim3(grid), dim3(NTHR), LDS_BYTES, stream, a); }
#endif
#if defined(MK_DEBUG_HASH)
    hipLaunchKernelGGL(dbg_hash, dim3(2048), dim3(256), 0, stream, a);
    hipLaunchKernelGGL(dbg_hash_apply, dim3(1024), dim3(256), 0, stream, a);
#endif
#if defined(MK_DEBUG_CHECKS)
    hipLaunchKernelGGL(dbg_checks, dim3(1), dim3(256), 0, stream, a);
    hipLaunchKernelGGL(dbg_apply, dim3(1024), dim3(256), 0, stream, a);
#endif
}
```

```cpp
#include <hip/hip_runtime.h>
#include <cstdio>
#include <cstdint>
#define MK_ONE_LAUNCH 1
namespace pg8 {
#define PG8_LAS __attribute__((address_space(3)))
typedef unsigned short bf16_t;
typedef short bf16x8 __attribute__((ext_vector_type(8)));
typedef float f32x4 __attribute__((ext_vector_type(4)));
typedef unsigned u32x4 __attribute__((ext_vector_type(4)));
constexpr int BM = 256, BK = 64, HALF = 128, HTB = HALF * BK * 2  , STAGE_BYTES = 8 * HTB, NXCD = 8, WGM = 8;

__host__ __device__ __forceinline__ int lds_byte(int r, int c) { const int st = (r >> 4) * 2 + (c >> 5), rr = r & 15, cc = c & 31, ob = rr * 64 + cc * 2; return st * 1024 + (ob ^ (((ob >> 9) & 1) << 5)); }
__host__ __device__ __forceinline__ void stage_rc(int b, int& R, int& C) { const int st = b / 1024, sb = b % 1024, swz = sb ^ (((sb >> 9) & 1) << 5); R = (st >> 1) * 16 + swz / 64; C = (st & 1) * 32 + (swz % 64) / 2; }
__host__ __device__ __forceinline__ int perm32(int rho) { const int n = rho >> 4, i = rho & 15; return 8 * (i >> 2) + 4 * n + (i & 3); }

struct Unit { int pm, pn, koff, rot; };
struct Gemm { const bf16_t* A; const bf16_t* Bt; int M, N, K, ldk; };

struct SplitOrder {
    int c, koff;
    __host__ __device__ bool next(int i, Unit& u) const { if (i > 0 || c >= 256) return false; u.pm = c & 3; u.pn = (c >> 2) & 7; u.koff = koff; u.rot = 0; return true; }
    __device__ __forceinline__ void a_ready(const Unit&) const {}
    __device__ __forceinline__ void done(const Unit&) const {}
};
template <bool FIXA, bool FIXB> struct ProbeOrder;
struct SameTileOrder {
    int nwg, G, c;
    __host__ __device__ void init(int M, int N, int G_, int c_) { nwg = (M / BM) * (N / BM); G = G_; c = c_; }
    __host__ __device__ bool next(int i, Unit& u) const { const long L = (long)i * G + c; if (L >= nwg) return false; u.pm = 0; u.pn = 0; u.koff = 0; u.rot = 0; return true; }
    __device__ __forceinline__ void a_ready(const Unit&) const {}
    __device__ __forceinline__ void done(const Unit&) const {}
};
struct StaticOrder {
    int nM, nN, nwg, G, c, rot_en;
    __host__ __device__ void init(int M, int N, int G_, int c_, int rot_en_ = 0) { nM = M / BM; nN = N / BM; nwg = nM * nN; G = G_; c = c_; rot_en = rot_en_; }
    __host__ __device__ bool next(int i, Unit& u) const {
        const long L = (long)i * G + c; if (L >= nwg) return false;
        int wgid = (int)L; { const int q = nwg / NXCD, r = nwg % NXCD, xcd = wgid % NXCD, off = wgid / NXCD; wgid = (xcd < r ? xcd * (q + 1) : r * (q + 1) + (xcd - r) * q) + off; }
        const int nig = WGM * nN, gid = wgid / nig, fm = gid * WGM, gsz = (nM - fm) < WGM ? (nM - fm) : WGM;
        u.pm = fm + ((wgid % nig) % gsz); u.pn = (wgid % nig) / gsz; u.koff = 0; u.rot = rot_en ? 2 * (((u.pm & 3) + (u.pn & 3) + i) & 3) : 0; return true;
    }
    __device__ __forceinline__ void a_ready(const Unit&) const {}
    __device__ __forceinline__ void done(const Unit&) const {}
};
typedef __bf16 bf16x2_t __attribute__((ext_vector_type(2)));
__device__ __forceinline__ unsigned cvt_pk_bf16(float lo, float hi) { bf16x2_t v = {(__bf16)lo, (__bf16)hi}; return __builtin_bit_cast(unsigned, v); }
template <class Epi, class Sched, bool ALIGN_EPI = false, bool SP2 = false>
__device__ __forceinline__ void gemm_phase(PG8_LAS unsigned char* lds, const Gemm g, const Sched& S, const Epi& E) {
    const int tid = threadIdx.x, wid = __builtin_amdgcn_readfirstlane(tid >> 6), lane = tid & 63, wr = wid >> 2, wc = wid & 3, fr = lane & 15, fq = lane >> 4;
    const int K = g.ldk, nt = g.K / BK;
    unsigned voffA[2], voffB[2];
#pragma unroll
    for (int i = 0; i < 2; ++i) { int R, C; stage_rc(tid * 16 + i * 8192, R, C); const int Rb = Epi::PERM ? ((R & ~31) + perm32(R & 31)) : R;
        voffA[i] = (unsigned)(R * K + C) * 2u; voffB[i] = (unsigned)(Rb * K + C) * 2u; }
    const size_t kstep = (size_t)(BK * 2);
    const size_t hstep = (size_t)HALF * K * 2;
    const size_t tstep = 2 * hstep;
    const unsigned ldsw = (unsigned)wid * 1024u;
    const int aoff = lds_byte(wr * 64 + fr, fq * 8), boff = lds_byte(wc * 32 + fr, fq * 8);
#define PG8_SA(b, h) (((b) * 2 + (h)) * HTB)
#define PG8_SB(b, h) ((4 + (b) * 2 + (h)) * HTB)
#define PG8_STAGE(bufoff, gbase, voff) do { _Pragma("unroll") for (int _i = 0; _i < 2; ++_i) \
        __builtin_amdgcn_global_load_lds((const unsigned*)((const char*)(gbase) + (voff)[_i]), (PG8_LAS unsigned*)(lds + (bufoff) + ldsw + _i * 8192), 16, 0, 0); } while (0)
#define PG8_LDA(dst, b, h) do { _Pragma("unroll") for (int m = 0; m < 4; ++m) _Pragma("unroll") for (int k = 0; k < 2; ++k) dst[m][k] = *(const PG8_LAS bf16x8*)(lds + PG8_SA(b, h) + aoff + m * 2048 + k * 1024); } while (0)
#define PG8_LDB(dst, b, h) do { _Pragma("unroll") for (int n = 0; n < 2; ++n) _Pragma("unroll") for (int k = 0; k < 2; ++k) dst[n][k] = *(const PG8_LAS bf16x8*)(lds + PG8_SB(b, h) + boff + n * 2048 + k * 1024); } while (0)
#define PG8_MMA(ai, bj, At, Bt) do { __builtin_amdgcn_s_setprio(1); _Pragma("unroll") for (int m = 0; m < 4; ++m) _Pragma("unroll") for (int n = 0; n < 2; ++n) _Pragma("unroll") for (int k = 0; k < 2; ++k) \
        acc[ai][bj][m][n] = __builtin_amdgcn_mfma_f32_16x16x32_bf16(Bt[n][k], At[m][k], acc[ai][bj][m][n], 0, 0, 0); __builtin_amdgcn_s_setprio(0); } while (0)
#define PG8_WAIT_V(n) asm volatile("s_waitcnt vmcnt(" #n ")" ::: "memory")
#define PG8_WAIT_L(n) asm volatile("s_waitcnt lgkmcnt(" #n ")" ::: "memory")
#define PG8_BAR __builtin_amdgcn_s_barrier()
#define PG8_SCHED __builtin_amdgcn_sched_barrier(0)
    Unit cur, nxt; int ui = 0;
    if (!S.next(0, cur)) return;
    f32x4 acc[2][2][4][2];
#pragma unroll
    for (int a = 0; a < 2; ++a)
#pragma unroll
        for (int b = 0; b < 2; ++b)
#pragma unroll
            for (int m = 0; m < 4; ++m)
#pragma unroll
                for (int n = 0; n < 2; ++n) acc[a][b][m][n] = (f32x4){0.f, 0.f, 0.f, 0.f};
    bf16x8 At[4][2], B0[2][2], B1[2][2];
    const char* cA = (const char*)g.A + (size_t)cur.pm * tstep + (size_t)cur.koff * 2; const char* cB = (const char*)g.Bt + (size_t)cur.pn * tstep + (size_t)cur.koff * 2;
    size_t kc = (size_t)cur.rot * kstep; const size_t kwrap = (size_t)nt * kstep;
    const char* pA = cA + kc; const char* pB = cB + kc;
    S.a_ready(cur);
    if constexpr (SP2) {
        PG8_STAGE(PG8_SB(0, 0), pB, voffB); PG8_STAGE(PG8_SB(0, 1), pB + hstep, voffB); PG8_STAGE(PG8_SA(0, 0), pA, voffA); PG8_STAGE(PG8_SA(0, 1), pA + hstep, voffA);
        if (wr == 1) PG8_BAR;
        PG8_WAIT_V(2); PG8_BAR;
        PG8_STAGE(PG8_SB(1, 0), pB + kstep, voffB); PG8_STAGE(PG8_SA(1, 0), pA + kstep, voffA); PG8_STAGE(PG8_SB(1, 1), pB + hstep + kstep, voffB);
        PG8_WAIT_V(6); PG8_BAR;
    } else {
        PG8_STAGE(PG8_SB(0, 0), pB, voffB); PG8_STAGE(PG8_SA(0, 0), pA, voffA); PG8_STAGE(PG8_SB(0, 1), pB + hstep, voffB); PG8_STAGE(PG8_SA(0, 1), pA + hstep, voffA);
        if (wr == 1) PG8_BAR;
        PG8_WAIT_V(4); PG8_BAR;
        PG8_STAGE(PG8_SB(1, 0), pB + kstep, voffB); PG8_STAGE(PG8_SA(1, 0), pA + kstep, voffA); PG8_STAGE(PG8_SB(1, 1), pB + hstep + kstep, voffB);
        PG8_WAIT_V(6); PG8_BAR;
    }
    for (;;) {
        const bool has_next = S.next(ui + 1, nxt);
        const char* nA = has_next ? (const char*)g.A + (size_t)nxt.pm * tstep + (size_t)nxt.koff * 2 : cA; const char* nB = has_next ? (const char*)g.Bt + (size_t)nxt.pn * tstep + (size_t)nxt.koff * 2 : cB;
        const size_t nk = (size_t)(has_next ? nxt.rot : cur.rot) * kstep;
        for (int t = 0; t < nt; t += 2) {
            const bool last = (t == nt - 2);
            const char* a1 = cA + kc + kstep;
            size_t k2 = kc + 2 * kstep; if (k2 >= kwrap) k2 -= kwrap;
            const char* a2 = last ? nA + nk : cA + k2; const char* b2 = last ? nB + nk : cB + k2;
            kc = k2;
            const char* a3 = a2 + kstep; const char* b3 = b2 + kstep;
            if (last && has_next) S.a_ready(nxt);
            if constexpr (SP2) {
            PG8_LDB(B0, 0, 0); PG8_LDB(B1, 0, 1); PG8_SCHED; PG8_LDA(At, 0, 0); PG8_STAGE(PG8_SA(1, 1), a1 + hstep, voffA);
            PG8_WAIT_V(8); PG8_WAIT_L(0); PG8_BAR; PG8_MMA(0, 0, At, B0); PG8_MMA(0, 1, At, B1); PG8_BAR; PG8_SCHED;
            PG8_LDA(At, 0, 1); PG8_STAGE(PG8_SB(0, 0), b2, voffB); PG8_STAGE(PG8_SB(0, 1), b2 + hstep, voffB); PG8_STAGE(PG8_SA(0, 0), a2, voffA);
            PG8_WAIT_V(8); PG8_WAIT_L(0); PG8_BAR; PG8_MMA(1, 0, At, B0); PG8_MMA(1, 1, At, B1); PG8_BAR; PG8_SCHED;
            PG8_LDB(B0, 1, 0); PG8_LDB(B1, 1, 1); PG8_SCHED; PG8_LDA(At, 1, 0); PG8_STAGE(PG8_SA(0, 1), a2 + hstep, voffA);
            PG8_WAIT_V(8); PG8_WAIT_L(0); PG8_BAR; PG8_MMA(0, 0, At, B0); PG8_MMA(0, 1, At, B1); PG8_BAR; PG8_SCHED;
            PG8_LDA(At, 1, 1); PG8_STAGE(PG8_SB(1, 0), b3, voffB); PG8_STAGE(PG8_SB(1, 1), b3 + hstep, voffB); PG8_STAGE(PG8_SA(1, 0), a3, voffA);
            PG8_WAIT_V(8); PG8_WAIT_L(0); PG8_BAR; PG8_MMA(1, 0, At, B0); PG8_MMA(1, 1, At, B1); PG8_BAR; PG8_SCHED;
            } else {
            PG8_LDB(B0, 0, 0); PG8_SCHED; PG8_LDA(At, 0, 0); PG8_STAGE(PG8_SA(1, 1), a1 + hstep, voffA);
            PG8_WAIT_L(8); PG8_BAR; PG8_WAIT_L(0); PG8_MMA(0, 0, At, B0); PG8_BAR; PG8_SCHED;
            PG8_LDB(B1, 0, 1); PG8_STAGE(PG8_SB(0, 0), b2, voffB);
            PG8_BAR; PG8_WAIT_L(0); PG8_MMA(0, 1, At, B1); PG8_BAR;
            PG8_LDA(At, 0, 1); PG8_STAGE(PG8_SA(0, 0), a2, voffA);
            PG8_BAR; PG8_WAIT_L(0); PG8_MMA(1, 0, At, B0); PG8_BAR; PG8_SCHED;
            PG8_STAGE(PG8_SB(0, 1), b2 + hstep, voffB);
            PG8_WAIT_V(6); PG8_BAR; PG8_MMA(1, 1, At, B1); PG8_BAR;
            PG8_LDB(B0, 1, 0); PG8_SCHED; PG8_LDA(At, 1, 0); PG8_STAGE(PG8_SA(0, 1), a2 + hstep, voffA);
            PG8_WAIT_L(8); PG8_BAR; PG8_WAIT_L(0); PG8_MMA(0, 0, At, B0); PG8_BAR; PG8_SCHED;
            PG8_LDB(B1, 1, 1); PG8_STAGE(PG8_SB(1, 0), b3, voffB);
            PG8_BAR; PG8_WAIT_L(0); PG8_MMA(0, 1, At, B1); PG8_BAR;
            PG8_LDA(At, 1, 1); PG8_STAGE(PG8_SA(1, 0), a3, voffA);
            PG8_BAR; PG8_WAIT_L(0); PG8_MMA(1, 0, At, B0); PG8_BAR; PG8_SCHED;
            PG8_STAGE(PG8_SB(1, 1), b3 + hstep, voffB);
            PG8_WAIT_V(6); PG8_BAR; PG8_MMA(1, 1, At, B1); PG8_BAR;
            }
        }
        if constexpr (ALIGN_EPI) { if (wr == 0) PG8_BAR; }
        if constexpr (!Epi::AFTER_DRAIN) { E(acc, cur, wr, wc, fr, fq); S.done(cur); }
        if (!has_next) break;
#pragma unroll
        for (int a = 0; a < 2; ++a)
#pragma unroll
            for (int b = 0; b < 2; ++b)
#pragma unroll
                for (int m = 0; m < 4; ++m)
#pragma unroll
                    for (int n = 0; n < 2; ++n) acc[a][b][m][n] = (f32x4){0.f, 0.f, 0.f, 0.f};
        cur = nxt; cA = nA; cB = nB; kc = (size_t)cur.rot * kstep; ++ui;
        if constexpr (ALIGN_EPI) { if (wr == 1) PG8_BAR; }
    }
    PG8_WAIT_V(0);
    if constexpr (!ALIGN_EPI) { if (wr == 0) PG8_BAR; }
    PG8_BAR;
    if constexpr (Epi::AFTER_DRAIN) { E.fused(acc, cur, wr, wc, fr, fq, lds, wid, lane); S.done(cur); }
#undef PG8_SA
#undef PG8_SB
#undef PG8_STAGE
#undef PG8_LDA
#undef PG8_LDB
#undef PG8_MMA
#undef PG8_WAIT_V
#undef PG8_WAIT_L
#undef PG8_BAR
#undef PG8_SCHED
}
struct FewTileOrder : StaticOrder {
    __host__ __device__ bool next(int i, Unit& u) const { if (!StaticOrder::next(i, u)) return false; u.pm = c & 3; u.pn = (c >> 2) & 7; return true; }
};
template <bool FIXA, bool FIXB> struct ProbeOrder : StaticOrder {
    __host__ __device__ bool next(int i, Unit& u) const { if (!StaticOrder::next(i, u)) return false; if (FIXA) u.pm = 0; if (FIXB) u.pn = 0; return true; }
};
}

#ifndef MK_ONE_LAUNCH
#define MK_ONE_LAUNCH 0
#endif
#ifndef MK_STOP_AFTER
#define MK_STOP_AFTER 99
#endif
constexpr int NWAVES = 8, NTHR = 512;
constexpr int DM = 2048, NB = 4, SEQ = 4096, CTXL = 256, FF = 5504, MODW = 9 * DM;
constexpr int ML = NB * SEQ, MC = NB * CTXL, MT = ML + MC;
constexpr int NGU = 2 * FF;
constexpr int AB_N = 6400, AB_LD = 6144, CD_N = 3072;
constexpr int NCH = 34;
constexpr int USLOT = 272 * 128;
constexpr float EPS = 1e-6f;
constexpr int NPHASE = 26;

constexpr size_t MiB = 1u << 20;
constexpr size_t WS_CTL = 0, CTL_ZERO_BYTES = 2 * MiB;
constexpr size_t WS_MOD = 1 * MiB;
constexpr size_t WS_ROPEC = 2 * MiB, WS_ROPES = 3 * MiB;
constexpr size_t WS_AXC = 4 * MiB, WS_AXS = 4 * MiB + 8192;
constexpr size_t WS_GATES = 5 * MiB;
constexpr size_t WS_SCAL = 7 * MiB;
constexpr size_t WS_AGG = 8 * MiB;
constexpr size_t WS_XC = 16 * MiB;
constexpr size_t WS_WGU = 32 * MiB;
constexpr size_t WS_WD = 204 * MiB;
constexpr size_t WS_ABWIN = 290 * MiB;
constexpr size_t WS_ABWOUT = 315 * MiB;
constexpr size_t WS_CDWIN = 323 * MiB;
constexpr size_t WS_CDWOUT = 335 * MiB;
constexpr size_t WS_WUQ = 343 * MiB;
constexpr size_t WS_WUKV = 345 * MiB;
constexpr size_t WS_LWT = 346 * MiB;
constexpr size_t WS_XN = 348 * MiB;
constexpr size_t WS_BIG = 416 * MiB;
constexpr size_t WS_A = 620 * MiB;
constexpr size_t WS_KVRAW = 668 * MiB;
constexpr size_t WS_B = 765 * MiB;
constexpr size_t WS_CQN = 765 * MiB, WS_CKVN = 782 * MiB, WS_QF = 791 * MiB, WS_KF = 839 * MiB;
constexpr size_t WS_END = 910 * MiB;
constexpr int CW_BAR = 4096;

constexpr int RING_BYTES = 131072;
constexpr int LDS_BYTES = 159744;
constexpr int MISC_OFF = LDS_BYTES - 256;

#define GAS __attribute__((address_space(1)))
#define LAS __attribute__((address_space(3)))
#define DI __device__ __forceinline__
typedef unsigned short bf16;
typedef unsigned v4u __attribute__((ext_vector_type(4)));
typedef unsigned v2u __attribute__((ext_vector_type(2)));
typedef float f32x4 __attribute__((ext_vector_type(4)));
typedef float f32x2 __attribute__((ext_vector_type(2)));
typedef short bf16x8 __attribute__((ext_vector_type(8)));
typedef short s16x4 __attribute__((ext_vector_type(4)));
typedef GAS unsigned gu32;
#define RLX_AGENT __ATOMIC_RELAXED, __HIP_MEMORY_SCOPE_AGENT
#define LDS_WAIT() asm volatile("s_waitcnt lgkmcnt(0)" ::: "memory")
#define VM_WAIT() asm volatile("s_waitcnt vmcnt(0)" ::: "memory")
DI int lane_id() { int l; asm volatile("v_mbcnt_lo_u32_b32 %0, -1, 0\n\tv_mbcnt_hi_u32_b32 %0, -1, %0" : "=v"(l)); return l; }
DI float bf2f(unsigned h) { return __builtin_bit_cast(float, h << 16); }
DI float bflo(unsigned w) { return __builtin_bit_cast(float, w << 16); }
DI float bfhi(unsigned w) { return __builtin_bit_cast(float, w & 0xffff0000u); }
DI unsigned pk2(float lo, float hi) { return pg8::cvt_pk_bf16(lo, hi); }
DI unsigned short f2bf(float f) { return (unsigned short)(pk2(f, 0.f) & 0xffffu); }
DI float wave_sum(float v) {
#pragma unroll
    for (int o = 1; o < 64; o <<= 1) v += __shfl_xor(v, o);
    return v;
}
DI float wave_max(float v) {
#pragma unroll
    for (int o = 1; o < 64; o <<= 1) v = fmaxf(v, __shfl_xor(v, o));
    return v;
}
DI float sigmoidf_(float x) { return __builtin_amdgcn_rcpf(1.f + __expf(-x)); }
DI float siluf_(float x) { return x * sigmoidf_(x); }
DI float logsigf_(float x) { return fminf(x, 0.f) - log1pf(__expf(-fabsf(x))); }
DI float gelu_tanh(float x) { const float z = 0.7978845608028654f * (x + 0.044715f * x * x * x); const float t = 1.f - 2.f * __builtin_amdgcn_rcpf(1.f + __expf(2.f * z)); return 0.5f * x * (1.f + t); }
DI f32x4 mfma16(bf16x8 a, bf16x8 b, f32x4 c) { return __builtin_amdgcn_mfma_f32_16x16x32_bf16(a, b, c, 0, 0, 0); }
DI bf16x8 frag_row(const LAS unsigned char* base, int stride_b, int row0, int k0, int lane) {
    return *(const LAS bf16x8*)(base + (row0 + (lane & 15)) * stride_b + (k0 + 8 * (lane >> 4)) * 2);
}
DI bf16x8 frag_tr(const LAS unsigned char* base, int stride_b, int ka, int kb, int c0, int lane) {
    const int idx = lane & 15, qq = idx >> 2, p = idx & 3;
    const s16x4 lo = __builtin_amdgcn_ds_read_tr16_b64_v4i16((LAS s16x4*)(base + (ka + qq) * stride_b + (c0 + 4 * p) * 2));
    const s16x4 hi = __builtin_amdgcn_ds_read_tr16_b64_v4i16((LAS s16x4*)(base + (kb + qq) * stride_b + (c0 + 4 * p) * 2));
    bf16x8 o; o[0] = lo[0]; o[1] = lo[1]; o[2] = lo[2]; o[3] = lo[3]; o[4] = hi[0]; o[5] = hi[1]; o[6] = hi[2]; o[7] = hi[3]; return o;
}

DI void glds16(const void* gsrc, unsigned lds_dst) {
    unsigned keep; asm volatile("s_mov_b32 %0, m0\n\ts_mov_b32 m0, %2\n\ts_nop 0\n\tglobal_load_lds_dwordx4 %1, off\n\ts_mov_b32 m0, %0" : "=&s"(keep) : "v"(gsrc), "s"(lds_dst) : "memory");
}
#define XB_TMO      128
#define XB_XCNT(j)  (256  + 64 * (j))
#define XB_XSUB(j)  (1280 + 64 * (j))
#define XB_XGEN(j)  (2304 + 64 * (j))
#define XB_TOP      3328
#define XB_TOPGEN   3392
#define XCD_BAR_WORDS 3456
#define XB_SPIN_CAP (1u << 18)

__device__ __forceinline__ unsigned xb_ld(unsigned* p)              { return __hip_atomic_load(p, __ATOMIC_RELAXED, __HIP_MEMORY_SCOPE_AGENT); }
__device__ __forceinline__ unsigned xb_add(unsigned* p, unsigned v) { return __hip_atomic_fetch_add(p, v, __ATOMIC_RELAXED, __HIP_MEMORY_SCOPE_AGENT); }
__device__ __forceinline__ unsigned xb_xcc_id() { return (unsigned)__builtin_amdgcn_s_getreg((3 << 11) | 20) & 0xFu; }
#define XB_SPIN(cond, bar) do { unsigned _sp = 0; while (cond) { __builtin_amdgcn_s_sleep(1); \
    if ((++_sp & 255u) == 0u) { if (xb_ld(&(bar)[XB_TMO])) break; if (_sp > XB_SPIN_CAP) { atomicAdd(&(bar)[XB_TMO], 1u); break; } } } } while (0)

struct XcdBarrier {
    unsigned* bar; unsigned x; int w;
    volatile LAS unsigned* st;
};

__device__ __forceinline__ XcdBarrier xcd_barrier_post(unsigned* bar, volatile LAS unsigned* st) {
    XcdBarrier b; b.bar = bar; b.x = xb_xcc_id(); b.st = st;
    b.w = __builtin_amdgcn_readfirstlane((int)threadIdx.x >> 6);
    if (threadIdx.x == 0) (void)xb_add(&bar[XB_XCNT(b.x)], 1u);
    return b;
}
__device__ __forceinline__ void xcd_barrier_complete(unsigned* bar, unsigned x, unsigned& nloc, unsigned& nx) {
    const unsigned G = gridDim.x * gridDim.y * gridDim.z;
    unsigned sum, cnt, mine, sp = 0u;
    for (;;) {
        sum = 0u; cnt = 0u; mine = 0u;
#pragma unroll
        for (unsigned j = 0; j < 16; ++j) { const unsigned c = xb_ld(&bar[XB_XCNT(j)]); sum += c; cnt += (c > 0u) ? 1u : 0u; mine = (j == x) ? c : mine; }
        if (sum == G) break;
        __builtin_amdgcn_s_sleep(1);
        if ((++sp & 255u) == 0u) { if (xb_ld(&bar[XB_TMO])) break; if (sp > XB_SPIN_CAP) { atomicAdd(&bar[XB_TMO], 1u); break; } }
    }
    nloc = mine > 0u ? mine : 1u; nx = cnt > 0u ? cnt : 1u;
}

__device__ __forceinline__ void xcd_barrier(const XcdBarrier& b) {
    asm volatile("s_waitcnt vmcnt(0)" ::: "memory");
    __syncthreads();
    if (b.w == 0 && lane_id() == 0) {
        unsigned* bar = b.bar;
        __builtin_amdgcn_s_waitcnt(0);
        unsigned nloc = b.st[0], nx = b.st[1];
        if (nloc == 0u) { xcd_barrier_complete(bar, b.x, nloc, nx); b.st[0] = nloc; b.st[1] = nx; }
        const unsigned old = xb_add(&bar[XB_XSUB(b.x)], 1u);
        const unsigned gen = old / nloc;
        if (old + 1u == (gen + 1u) * nloc) {
            __builtin_amdgcn_fence(__ATOMIC_RELEASE, "agent");
            asm volatile("s_waitcnt vmcnt(0)" ::: "memory");
            const unsigned og = xb_add(&bar[XB_TOP], 1u);
            const unsigned tg = og / nx;
            if (og + 1u == (tg + 1u) * nx) xb_add(&bar[XB_TOPGEN], 1u);
            else XB_SPIN(xb_ld(&bar[XB_TOPGEN]) == tg, bar);
            __builtin_amdgcn_fence(__ATOMIC_ACQUIRE, "agent");
            xb_add(&bar[XB_XGEN(b.x)], 1u);
            asm volatile("s_waitcnt vmcnt(0)" ::: "memory");
        } else {
            XB_SPIN(xb_ld(&bar[XB_XGEN(b.x)]) == gen, bar);
            __builtin_amdgcn_fence(__ATOMIC_ACQUIRE, "agent");
            asm volatile("s_waitcnt vmcnt(0)" ::: "memory");
        }
    }
    __syncthreads();
}


struct Args { const float* in[31]; float* out; unsigned char* ws; int ph_lo, ph_hi; };
enum { I_X = 0, I_C, I_CTX, I_CCTX, I_ADAW, I_ADAB, I_NORMG, I_WG, I_WU, I_WD, I_ABWIN, I_ABWOUT, I_DECAY, I_RETGN, I_GATEB, I_MLGN, I_CDWIN, I_CDWOUT,
       I_CONVW, I_CONVB, I_LWA, I_LBA, I_LWX, I_LBX, I_LAM, I_QNG, I_KVNG, I_WUQ, I_WUK, I_WUV, I_QKNG };

typedef pg8::f32x4 accv;
struct EpiUp {
    static constexpr bool PERM = true, AFTER_DRAIN = false;
    bf16* O;
    DI void operator()(const accv (&acc)[2][2][4][2], const pg8::Unit& u, int wr, int wc, int fr, int fq) const {
        const int row0 = u.pm * 256 + wr * 64 + fr, col0 = u.pn * 128 + wc * 32 + 8 * fq;
#pragma unroll
        for (int ai = 0; ai < 2; ++ai)
#pragma unroll
            for (int m = 0; m < 4; ++m) {
                const accv g0 = acc[ai][0][m][0], g1 = acc[ai][0][m][1], u0 = acc[ai][1][m][0], u1 = acc[ai][1][m][1];
                v4u w;
                w.x = pk2(siluf_(g0[0]) * u0[0], siluf_(g0[1]) * u0[1]); w.y = pk2(siluf_(g0[2]) * u0[2], siluf_(g0[3]) * u0[3]);
                w.z = pk2(siluf_(g1[0]) * u1[0], siluf_(g1[1]) * u1[1]); w.w = pk2(siluf_(g1[2]) * u1[2], siluf_(g1[3]) * u1[3]);
                *(v4u*)(O + (size_t)(row0 + ai * 128 + m * 16) * FF + col0) = w;
            }
    }
};
struct EpiResid {
    static constexpr bool PERM = false, AFTER_DRAIN = false;
    const float* inL; const float* inC; float* outL; float* outC; const float* gate  ; float scale;
    DI void operator()(const accv (&acc)[2][2][4][2], const pg8::Unit& u, int wr, int wc, int fr, int fq) const {
        const bool lat = u.pm < 64;
        const int rloc = (lat ? u.pm * 256 : (u.pm - 64) * 256) + wr * 64 + fr, col0 = u.pn * 256 + wc * 32 + 4 * fq;
        const int bidx = lat ? (u.pm >> 4) : 4;
        const float* ib = lat ? inL : inC; float* ob = lat ? outL : outC;
        accv gv[2][2];
#pragma unroll
        for (int bj = 0; bj < 2; ++bj)
#pragma unroll
            for (int n = 0; n < 2; ++n) gv[bj][n] = *(const accv*)(gate + (size_t)bidx * MODW + col0 + bj * 128 + n * 16) * scale;
#pragma unroll
        for (int ai = 0; ai < 2; ++ai) {
            accv xi[4][2][2];
#pragma unroll
            for (int m = 0; m < 4; ++m) { const size_t ro = (size_t)(rloc + ai * 128 + m * 16) * DM + col0;
#pragma unroll
                for (int bj = 0; bj < 2; ++bj)
#pragma unroll
                    for (int n = 0; n < 2; ++n) xi[m][bj][n] = *(const accv*)(ib + ro + bj * 128 + n * 16); }
            asm volatile("" ::: "memory");
#pragma unroll
            for (int m = 0; m < 4; ++m) { const size_t ro = (size_t)(rloc + ai * 128 + m * 16) * DM + col0;
#pragma unroll
                for (int bj = 0; bj < 2; ++bj)
#pragma unroll
                    for (int n = 0; n < 2; ++n) *(accv*)(ob + ro + bj * 128 + n * 16) = xi[m][bj][n] + gv[bj][n] * acc[ai][bj][m][n]; }
            asm volatile("" ::: "memory");
        }
    }
};
struct EpiPlain {
    static constexpr bool PERM = true, AFTER_DRAIN = false;
    bf16* O; int ldc; int ngelu;
    DI void operator()(const accv (&acc)[2][2][4][2], const pg8::Unit& u, int wr, int wc, int fr, int fq) const {
        const int row0 = u.pm * 256 + wr * 64 + fr, col0 = u.pn * 256 + wc * 32 + 8 * fq; const bool act = u.pn < ngelu;
#pragma unroll
        for (int ai = 0; ai < 2; ++ai)
#pragma unroll
            for (int m = 0; m < 4; ++m)
#pragma unroll
                for (int bj = 0; bj < 2; ++bj) {
                    accv v0 = acc[ai][bj][m][0], v1 = acc[ai][bj][m][1];
                    if (act) {
#pragma unroll
                        for (int e = 0; e < 4; ++e) { v0[e] = gelu_tanh(v0[e]); v1[e] = gelu_tanh(v1[e]); } }
                    v4u w; w.x = pk2(v0[0], v0[1]); w.y = pk2(v0[2], v0[3]); w.z = pk2(v1[0], v1[1]); w.w = pk2(v1[2], v1[3]);
                    *(v4u*)(O + (size_t)(row0 + ai * 128 + m * 16) * ldc + col0 + bj * 128) = w;
                }
    }
};
struct EpiProjAB {
    static constexpr bool PERM = true, AFTER_DRAIN = false;
    bf16* O; float* gates; const float* gate_b; const float* ropec; const float* ropes;
    DI void operator()(const accv (&acc)[2][2][4][2], const pg8::Unit& u, int wr, int wc, int fr, int fq) const {
        const int pn = u.pn, row0 = u.pm * 256 + wr * 64 + fr; const bool lat = u.pm < 64;
        if (pn == 24) {
            if (wc == 0 && fq < 2) {
                const accv b0 = *(const accv*)(gate_b + 8 * fq), b1 = *(const accv*)(gate_b + 8 * fq + 4);
#pragma unroll
                for (int ai = 0; ai < 2; ++ai)
#pragma unroll
                    for (int m = 0; m < 4; ++m) { float* gp = gates + (size_t)(row0 + ai * 128 + m * 16) * 16 + 8 * fq;
                        *(accv*)gp = acc[ai][0][m][0] + b0; *(accv*)(gp + 4) = acc[ai][0][m][1] + b1; }
            }
            return;
        }
        const bool rope = (pn < 4) && lat;
        const float sc = (pn == 2 || pn == 3 || pn == 12 || pn == 13) ? 0.08838834764831845f : 1.f;
        const int actk = (pn >= 8 && pn < 12) ? 1 : ((pn >= 20 && pn < 24) ? 2 : 0);
        const int col0 = pn * 256 + wc * 32 + 8 * fq;
        accv csv[2][4], snv[2][4];
#pragma unroll
        for (int ai = 0; ai < 2; ++ai)
#pragma unroll
            for (int m = 0; m < 4; ++m) { csv[ai][m] = (accv){1.f, 1.f, 1.f, 1.f}; snv[ai][m] = (accv){0.f, 0.f, 0.f, 0.f};
                if (rope) { const int pos = (row0 + ai * 128 + m * 16) & (SEQ - 1); csv[ai][m] = *(const accv*)(ropec + pos * 64 + 16 * wc + 4 * fq); snv[ai][m] = *(const accv*)(ropes + pos * 64 + 16 * wc + 4 * fq); } }
        asm volatile("" ::: "memory");
#pragma unroll
        for (int ai = 0; ai < 2; ++ai)
#pragma unroll
            for (int m = 0; m < 4; ++m) {
                const int row = row0 + ai * 128 + m * 16;
                const accv cs = csv[ai][m], sn = snv[ai][m];
#pragma unroll
                for (int bj = 0; bj < 2; ++bj) {
                    accv v0 = acc[ai][bj][m][0], v1 = acc[ai][bj][m][1];
                    if (rope) { const accv x1 = v0, x2 = v1; v0 = x1 * cs - x2 * sn; v1 = x1 * sn + x2 * cs; }
                    v0 = v0 * sc; v1 = v1 * sc;
                    if (actk == 1) {
#pragma unroll
                        for (int e = 0; e < 4; ++e) { v0[e] = siluf_(v0[e]); v1[e] = siluf_(v1[e]); } }
                    if (actk == 2) {
#pragma unroll
                        for (int e = 0; e < 4; ++e) { v0[e] = sigmoidf_(v0[e]); v1[e] = sigmoidf_(v1[e]); } }
                    v4u w; w.x = pk2(v0[0], v0[1]); w.y = pk2(v0[2], v0[3]); w.z = pk2(v1[0], v1[1]); w.w = pk2(v1[2], v1[3]);
                    *(v4u*)(O + (size_t)row * AB_LD + col0 + bj * 128) = w;
                }
            }
    }
};

struct EpiPartial {
    static constexpr bool PERM = false, AFTER_DRAIN = false;
    float* P;
    DI void operator()(const accv (&acc)[2][2][4][2], const pg8::Unit& u, int wr, int wc, int fr, int fq) const {
        const int row0 = u.pm * 256 + wr * 64 + fr, col0 = u.pn * 256 + wc * 32 + 4 * fq;
#pragma unroll
        for (int ai = 0; ai < 2; ++ai)
#pragma unroll
            for (int m = 0; m < 4; ++m) { float* rp = P + (size_t)(row0 + ai * 128 + m * 16) * DM + col0;
#pragma unroll
                for (int bj = 0; bj < 2; ++bj)
#pragma unroll
                    for (int n = 0; n < 2; ++n) *(accv*)(rp + bj * 128 + n * 16) = acc[ai][bj][m][n]; }
    }
};

template <bool P> struct EpiNull {
    static constexpr bool PERM = P, AFTER_DRAIN = false;
    float* O;
    DI void operator()(const accv (&acc)[2][2][4][2], const pg8::Unit& u, int wr, int wc, int fr, int fq) const {
        accv s = {0.f, 0.f, 0.f, 0.f};
#pragma unroll
        for (int ai = 0; ai < 2; ++ai)
#pragma unroll
            for (int bj = 0; bj < 2; ++bj)
#pragma unroll
                for (int m = 0; m < 4; ++m)
#pragma unroll
                    for (int n = 0; n < 2; ++n) s = s + acc[ai][bj][m][n];
        *(accv*)(O + (size_t)((wr * 4 + wc) * 64 + fq * 16 + fr) * 4) = s;
    }
};

struct Frame {
    LAS unsigned char* lds;
    int wave, G;
    const Args* a;
};
#define WSP(T, off) ((T*)(A.ws + (off)))
#define TID(F) ((F).wave * 64 + lane_id())

DI void cvt_item(const float* W, int ldw, int K, bf16* WT, int k0, int n0, int srcc, LAS float* scr, int lane) {
    const float* wp = W + (size_t)k0 * ldw + (srcc >= 0 ? srcc : 0);
#pragma unroll
    for (int i = 0; i < 32; ++i) { const int kk = 2 * i + (lane >> 5); scr[kk * 33 + (lane & 31)] = (srcc >= 0) ? wp[(size_t)kk * ldw] : 0.f; }
    LDS_WAIT(); asm volatile("" ::: "memory");
    const int c = lane & 7;
#pragma unroll
    for (int j = 0; j < 4; ++j) { const int n = (lane >> 3) + 8 * j; const LAS float* s = scr + (8 * c) * 33 + n;
        v4u o; o.x = pk2(s[0 * 33], s[1 * 33]); o.y = pk2(s[2 * 33], s[3 * 33]); o.z = pk2(s[4 * 33], s[5 * 33]); o.w = pk2(s[6 * 33], s[7 * 33]);
        *(v4u*)(WT + (size_t)(n0 + n) * K + k0 + 8 * c) = o; }
    LDS_WAIT(); asm volatile("" ::: "memory");
}
DI void cvt_item4(const float* W, int ldw, int K, bf16* WT, int k0, int n0, int srcc0, LAS float* scr, int lane) {
    const int kk8 = lane >> 3, n4 = lane & 7;
    const float* wp = W + (size_t)(k0 + kk8) * ldw + (srcc0 >= 0 ? srcc0 : 0) + 4 * n4;
    f32x4 v[8];
#pragma unroll
    for (int i = 0; i < 8; ++i) v[i] = (srcc0 >= 0) ? *(const f32x4*)(wp + (size_t)(8 * i) * ldw) : (f32x4){0.f, 0.f, 0.f, 0.f};
#pragma unroll
    for (int i = 0; i < 8; ++i) { LAS float* d = scr + (8 * i + kk8) * 33 + 4 * n4; d[0] = v[i].x; d[1] = v[i].y; d[2] = v[i].z; d[3] = v[i].w; }
    LDS_WAIT(); asm volatile("" ::: "memory");
    const int c = lane & 7;
#pragma unroll
    for (int j = 0; j < 4; ++j) { const int n = (lane >> 3) + 8 * j; const LAS float* s = scr + (8 * c) * 33 + n;
        v4u o; o.x = pk2(s[0 * 33], s[1 * 33]); o.y = pk2(s[2 * 33], s[3 * 33]); o.z = pk2(s[4 * 33], s[5 * 33]); o.w = pk2(s[6 * 33], s[7 * 33]);
        *(v4u*)(WT + (size_t)(n0 + n) * K + k0 + 8 * c) = o; }
    LDS_WAIT(); asm volatile("" ::: "memory");
}
DI int rope_src(int p) { const int e = p & 7, hi = (p >> 3) * 4; return e < 4 ? hi + e : 64 + hi + (e - 4); }

DI void phase_pre(const Frame& F, const Args& A, bool do_adaln) {
    const int lane = lane_id(), wave = F.wave, tid = wave * 64 + lane, G = F.G;
    {
        float* rc = WSP(float, WS_ROPEC); float* rs = WSP(float, WS_ROPES); float* ac = WSP(float, WS_AXC); float* as = WSP(float, WS_AXS);
        for (int i = blockIdx.x * NTHR + tid; i < SEQ * 64 + 64 * 16; i += G * NTHR) {
            int pos, k; float fr_;
            if (i < SEQ * 64) { pos = i >> 6; k = i & 63; fr_ = exp2f(-(float)k * (13.287712379549449f / 64.f)); }
            else { const int i2 = i - SEQ * 64; pos = i2 >> 4; k = i2 & 15; fr_ = exp2f(-(float)k * (13.287712379549449f / 16.f)); }
            const float ang = (float)pos * fr_;
            const double rev = (double)ang * 0.15915494309189535; const float fr2 = (float)(rev - rint(rev));
            const float s = __builtin_amdgcn_sinf(fr2), c = __builtin_amdgcn_cosf(fr2);
            if (i < SEQ * 64) { rc[i] = c; rs[i] = s; } else { ac[i - SEQ * 64] = c; as[i - SEQ * 64] = s; }
        }
    }
    if (do_adaln) {
        LAS float* sc = (LAS float*)F.lds;
        LAS float* red = (LAS float*)(F.lds + 40960);
        const float* cc = A.in[I_C]; const float* cx = A.in[I_CCTX];
        for (int i = tid; i < 5 * DM; i += NTHR) { const int r = i / DM, k = i % DM; const float v = r < 4 ? cc[r * DM + k] : cx[k]; sc[i] = siluf_(v); }
        __syncthreads();
        float* MOD = WSP(float, WS_MOD);
        for (int unit = blockIdx.x; unit < 576; unit += G) {
            const int kh = unit & 1, u2 = unit >> 1, l = u2 / 144, n0 = (u2 % 144) * 128;
            const float* W = A.in[I_ADAW] + (size_t)l * DM * MODW + n0 + 2 * lane;
            float acc[5][2];
#pragma unroll
            for (int r = 0; r < 5; ++r) { acc[r][0] = 0.f; acc[r][1] = 0.f; }
            const int kb = kh * 1024 + wave * 128;
#pragma unroll 16
            for (int k = 0; k < 128; ++k) {
                const f32x2 w = *(const f32x2*)(W + (size_t)(kb + k) * MODW);
#pragma unroll
                for (int r = 0; r < 5; ++r) { const float s = sc[r * DM + kb + k]; acc[r][0] += s * w.x; acc[r][1] += s * w.y; }
            }
#pragma unroll
            for (int r = 0; r < 5; ++r) { red[(wave * 5 + r) * 128 + 2 * lane] = acc[r][0]; red[(wave * 5 + r) * 128 + 2 * lane + 1] = acc[r][1]; }
            __syncthreads();
            for (int i = tid; i < 640; i += NTHR) { const int r = i >> 7, c = i & 127; float s = kh ? 0.f : A.in[I_ADAB][l * MODW + n0 + c];
#pragma unroll
                for (int w = 0; w < 8; ++w) s += red[(w * 5 + r) * 128 + c];
                atomicAdd(&MOD[(size_t)(l * 5 + r) * MODW + n0 + c], s); }
            __syncthreads();
        }
    }
    {
        LAS float* scr = (LAS float*)(F.lds + wave * 8448);
        const int gw = blockIdx.x * NWAVES + wave, NGW = G * NWAVES;
        constexpr int I_GU = 32 * (NGU / 32), I_D = (FF / 64) * (DM / 32), I_ABI = 32 * (AB_N / 32), I_SQ = 32 * 64, I_CDI = 32 * (CD_N / 32), I_UQ = 8 * 48, I_UKV = 4 * 64, I_LW = 2 * 4;
        constexpr int NITEMS = 4 * I_GU + 4 * I_D + I_ABI + I_SQ + I_CDI + I_SQ + I_UQ + I_UKV + 32 * I_LW;
        for (int it = gw; it < NITEMS; it += NGW) {
            int r = it;
            if (r < 4 * I_GU) { const int q = r / I_GU; r -= q * I_GU; const int nbk = NGU / 32, kb = r / nbk, nb = r % nbk;
                const float* W = (((32 * nb) & 255) < 128 ? A.in[I_WG] : A.in[I_WU]) + (size_t)q * DM * FF;
                cvt_item4(W, FF, DM, WSP(bf16, WS_WGU) + (size_t)q * NGU * DM, 64 * kb, 32 * nb, (nb >> 3) * 128 + ((32 * nb) & 127), scr, lane); continue; }
            r -= 4 * I_GU;
            if (r < 4 * I_D) { const int q = r / I_D; r -= q * I_D; const int nbk = DM / 32, kb = r / nbk, nb = r % nbk;
                cvt_item4(A.in[I_WD] + (size_t)q * FF * DM, DM, FF, WSP(bf16, WS_WD) + (size_t)q * DM * FF, 64 * kb, 32 * nb, 32 * nb, scr, lane); continue; }
            r -= 4 * I_D;
            if (r < I_ABI) { const int nbk = AB_N / 32, kb = r / nbk, nb = r % nbk, R = 32 * nb + (lane & 31), tile = R >> 8;
                int src = R;
                if (tile < 4 || (tile >= 12 && tile < 16)) src = (R & ~127) + rope_src(R & 127);
                if (R >= 6160) src = -1;
                cvt_item(A.in[I_ABWIN], 6160, DM, WSP(bf16, WS_ABWIN), 64 * kb, 32 * nb, src, scr, lane); continue; }
            r -= I_ABI;
            if (r < I_SQ) { const int kb = r / 64, nb = r % 64; cvt_item4(A.in[I_ABWOUT], DM, DM, WSP(bf16, WS_ABWOUT), 64 * kb, 32 * nb, 32 * nb, scr, lane); continue; }
            r -= I_SQ;
            if (r < I_CDI) { const int nbk = CD_N / 32, kb = r / nbk, nb = r % nbk, R = 32 * nb + (lane & 31);
                cvt_item4(A.in[I_CDWIN], 2880, DM, WSP(bf16, WS_CDWIN), 64 * kb, 32 * nb, 32 * nb < 2880 ? 32 * nb : -1, scr, lane); continue; }
            r -= I_CDI;
            if (r < I_SQ) { const int kb = r / 64, nb = r % 64; cvt_item4(A.in[I_CDWOUT], DM, DM, WSP(bf16, WS_CDWOUT), 64 * kb, 32 * nb, 32 * nb, scr, lane); continue; }
            r -= I_SQ;
            if (r < I_UQ) { const int kb = r / 48, nb = r % 48; cvt_item4(A.in[I_WUQ], 1536, 512, WSP(bf16, WS_WUQ), 64 * kb, 32 * nb, 32 * nb, scr, lane); continue; }
            r -= I_UQ;
            if (r < I_UKV) { const int kb = r / 64, nb = r % 64, R = 32 * nb + (lane & 31);
                cvt_item4(nb < 32 ? A.in[I_WUK] : A.in[I_WUV], 1024, 256, WSP(bf16, WS_WUKV), 64 * kb, 32 * nb, (32 * nb) & 1023, scr, lane); continue; }
            r -= I_UKV;
            { const int mg = r / I_LW; r -= mg * I_LW; const int mat = mg >> 3, g = mg & 7, kb = r / 4, nb = r % 4;
              const float* W = ((mat & 1) ? A.in[I_LWX] : A.in[I_LWA]) + (size_t)((mat >> 1) * 8 + g) * 128 * 128;
              cvt_item4(W, 128, 128, WSP(bf16, WS_LWT) + (size_t)mg * 128 * 128, 64 * kb, 32 * nb, 32 * nb, scr, lane); }
        }
    }
}

struct CtxFix { const float* cin; const float* part; const float* gate; float scale; };
DI void phase_norm(const Frame& F, const Args& A, int l, int which, int nrows, bool first, const CtxFix cf) {
    const int lane = lane_id(), gw = blockIdx.x * NWAVES + F.wave, NGW = F.G * NWAVES;
    const f32x4* gn = (const f32x4*)(A.in[I_NORMG] + (size_t)(l * 3 + which) * DM);
    const float* XL = first ? A.in[I_X] : A.out; const float* XC = first ? A.in[I_CTX] : WSP(float, WS_XC);
    const float* MOD = WSP(float, WS_MOD); bf16* XN = WSP(bf16, WS_XN);
    f32x4 g[8];
#pragma unroll
    for (int j = 0; j < 4; ++j) { g[2 * j] = gn[2 * lane + 128 * j]; g[2 * j + 1] = gn[2 * lane + 128 * j + 1]; }
    f32x4 nv[8];
#define NORM_SIMPLE(r_) ((r_) < ML || cf.part == nullptr)
#define NORM_LOAD(r_) do { const f32x4* xr_ = (const f32x4*)((r_) < ML ? XL + (size_t)(r_) * DM : XC + (size_t)((r_) - ML) * DM) + 2 * lane; _Pragma("unroll") for (int j = 0; j < 4; ++j) { nv[2 * j] = xr_[128 * j]; nv[2 * j + 1] = xr_[128 * j + 1]; } } while (0)
    if (gw < nrows && NORM_SIMPLE(gw)) NORM_LOAD(gw);
    for (int row = gw; row < nrows; row += NGW) {
        const bool lat = row < ML;
        const int bidx = lat ? (row >> 12) : 4;
        const f32x4* shp = (const f32x4*)(MOD + (size_t)(l * 5 + bidx) * MODW + (3 * which) * DM) + 2 * lane; const f32x4* scp = shp + DM / 4;
        f32x4 v[8]; float ss = 0.f;
        if (NORM_SIMPLE(row)) {
#pragma unroll
            for (int j = 0; j < 8; ++j) v[j] = nv[j];
        } else {
            const size_t ro = (size_t)(row - ML) * DM; const f32x4* xr = (const f32x4*)(cf.cin + ro) + 2 * lane; const f32x4* gt = (const f32x4*)cf.gate + 2 * lane;
            f32x4* xo = (f32x4*)(WSP(float, WS_XC) + ro) + 2 * lane;
#pragma unroll
            for (int j = 0; j < 8; ++j) { const int o = 128 * (j >> 1) + (j & 1); f32x4 s = *((const f32x4*)(cf.part + ro) + 2 * lane + o);
#pragma unroll
                for (int k = 1; k < 8; ++k) s = s + *((const f32x4*)(cf.part + (size_t)k * MC * DM + ro) + 2 * lane + o);
                v[j] = xr[o] + gt[o] * s * cf.scale; }
            asm volatile("" ::: "memory");
#pragma unroll
            for (int j = 0; j < 8; ++j) xo[128 * (j >> 1) + (j & 1)] = v[j];
        }
        { const int nr = row + NGW; if (nr < nrows && NORM_SIMPLE(nr)) NORM_LOAD(nr); }
#pragma unroll
        for (int j = 0; j < 8; ++j) ss += (v[j].x * v[j].x + v[j].y * v[j].y) + (v[j].z * v[j].z + v[j].w * v[j].w);
        const float rs = __frsqrt_rn(wave_sum(ss) * (1.f / DM) + EPS);
        v4u* o16 = (v4u*)(XN + (size_t)row * DM) + lane;
        f32x4 cs_[8], ch_[8];
#pragma unroll
        for (int j = 0; j < 4; ++j) { cs_[2 * j] = scp[128 * j]; cs_[2 * j + 1] = scp[128 * j + 1]; ch_[2 * j] = shp[128 * j]; ch_[2 * j + 1] = shp[128 * j + 1]; }
        asm volatile("" ::: "memory");
#pragma unroll
        for (int j = 0; j < 4; ++j) { const f32x4 y0 = (v[2 * j] * rs) * g[2 * j] * (cs_[2 * j] + 1.f) + ch_[2 * j], y1 = (v[2 * j + 1] * rs) * g[2 * j + 1] * (cs_[2 * j + 1] + 1.f) + ch_[2 * j + 1];
            v4u w; w.x = pk2(y0.x, y0.y); w.y = pk2(y0.z, y0.w); w.z = pk2(y1.x, y1.y); w.w = pk2(y1.z, y1.w); o16[64 * j] = w; }
    }
#undef NORM_SIMPLE
#undef NORM_LOAD
}

DI int chunk_row0(int b, int j) { return j < 2 ? ML + b * CTXL + 128 * j : b * SEQ + 128 * (j - 2); }
DI int us_slot(int b, int h, int mx, int j, int d) { return ((((b * 4 + h) * 2 + mx) * NCH + j) * 2 + d); }
DI int sc_idx(int b, int h, int d, int j) { return ((b * 4 + h) * 2 + d) * NCH + j; }
constexpr int LV_STRIDE = 544, LK_STRIDE = 272, LKT_STRIDE = 288;
DI void mlstm_gate_scan(const float* gates, int R0, int h, int d, int lane, float (&Av)[2], float (&Bv)[2], int (&cpos)[2], float& blast) {
    float iv[2], lf[2];
#pragma unroll
    for (int t = 0; t < 2; ++t) { const int e = 2 * lane + t; cpos[t] = d ? 127 - e : e; const float* g = gates + (size_t)(R0 + cpos[t]) * 16 + d * 8 + h; iv[t] = g[0]; lf[t] = logsigf_(g[4]); }
    float s = lf[0] + lf[1], inc = s;
#pragma unroll
    for (int o = 1; o < 64; o <<= 1) { const float t = __shfl_up(inc, o); if (lane >= o) inc += t; }
    const float exc = inc - s;
    Bv[0] = exc + lf[0]; Bv[1] = exc + s; Av[0] = iv[0] - Bv[0]; Av[1] = iv[1] - Bv[1];
    blast = __shfl(inc, 63);
}

DI void phase_m1(const Frame& F, const Args& A) {
    const int lane = lane_id(), wave = F.wave, tid = wave * 64 + lane, r16 = lane & 15, q4 = lane >> 4;
    LAS unsigned char* LV = F.lds; LAS unsigned char* LKf = F.lds + 71680; LAS unsigned char* LKb = LKf + 36864;
    LAS float* TW = (LAS float*)(LKb + 36864);
    const bf16* PROJ = WSP(bf16, WS_BIG); const float* GATES = WSP(float, WS_GATES); bf16* U = WSP(bf16, WS_A); float* SCAL = WSP(float, WS_SCAL);
    for (int unit = blockIdx.x; unit < NB * 4 * 2 * NCH; unit += F.G) {
        const int j = unit % NCH, t_ = unit / NCH, mx = t_ & 1, h = (t_ >> 1) & 3, b = t_ >> 3;
        const int R0 = chunk_row0(b, j);
        const int kcol = mx ? 3584 + 128 * h : 512 + 128 * h, vcol = mx ? 4096 + 256 * h : 1024 + 256 * h;
        if (mx == 0) {
            if (tid < 128) { const float lgf = logsigf_(A.in[I_DECAY][h]), lgb = logsigf_(A.in[I_DECAY][4 + h]); TW[tid] = __expf((float)(127 - tid) * lgf); TW[128 + tid] = __expf((float)tid * lgb); }
        } else if (wave < 2) {
            const int d = wave; float Av[2], Bv[2], blast; int cp[2];
            mlstm_gate_scan(GATES, R0, h, d, lane, Av, Bv, cp, blast);
            const float mA = wave_max(fmaxf(Av[0], Av[1]));
            TW[d * 128 + cp[0]] = __expf(Av[0] - mA); TW[d * 128 + cp[1]] = __expf(Av[1] - mA);
            if (lane == 0) { SCAL[sc_idx(b, h, d, j)] = blast + mA; SCAL[2048 + sc_idx(b, h, d, j)] = blast; }
        }
        __syncthreads();
        for (int i = tid; i < 128 * 32; i += NTHR) { const int rr = i >> 5, c = i & 31; *(LAS v4u*)(LV + rr * LV_STRIDE + c * 16) = *(const v4u*)(PROJ + (size_t)(R0 + rr) * AB_LD + vcol + 8 * c); }
        if (tid < 128) { unsigned z0 = 0u; asm volatile("" : "+v"(z0)); v4u one = {z0 + 0x3F80u, z0, z0, z0}, zero = {z0, z0, z0, z0}; *(LAS v4u*)(LV + tid * LV_STRIDE + 512) = one; *(LAS v4u*)(LV + tid * LV_STRIDE + 528) = zero; }
        for (int i = tid; i < 128 * 16; i += NTHR) { const int rr = i >> 4, c = i & 15; const v4u kv = *(const v4u*)(PROJ + (size_t)(R0 + rr) * AB_LD + kcol + 8 * c);
            const float wf = TW[rr], wb = TW[128 + rr]; v4u of, ob;
            of.x = pk2(bflo(kv.x) * wf, bfhi(kv.x) * wf); of.y = pk2(bflo(kv.y) * wf, bfhi(kv.y) * wf); of.z = pk2(bflo(kv.z) * wf, bfhi(kv.z) * wf); of.w = pk2(bflo(kv.w) * wf, bfhi(kv.w) * wf);
            ob.x = pk2(bflo(kv.x) * wb, bfhi(kv.x) * wb); ob.y = pk2(bflo(kv.y) * wb, bfhi(kv.y) * wb); ob.z = pk2(bflo(kv.z) * wb, bfhi(kv.z) * wb); ob.w = pk2(bflo(kv.w) * wb, bfhi(kv.w) * wb);
            *(LAS v4u*)(LKf + rr * LKT_STRIDE + c * 16) = of; *(LAS v4u*)(LKb + rr * LKT_STRIDE + c * 16) = ob; }
        __syncthreads();
#pragma unroll 1
        for (int d = 0; d < 2; ++d) {
            const LAS unsigned char* LK = d ? LKb : LKf;
            f32x4 acc[17];
#pragma unroll
            for (int c = 0; c < 17; ++c) acc[c] = (f32x4){0.f, 0.f, 0.f, 0.f};
            bf16x8 ka[2], vb[2][17];
#define M1_LOAD(buf_, s_) do { ka[buf_] = frag_tr(LK, LKT_STRIDE, 32 * (s_) + 8 * q4, 32 * (s_) + 8 * q4 + 4, 16 * wave, lane); \
                _Pragma("unroll") for (int c = 0; c < 17; ++c) vb[buf_][c] = frag_tr(LV, LV_STRIDE, 32 * (s_) + 8 * q4, 32 * (s_) + 8 * q4 + 4, 16 * c, lane); } while (0)
            M1_LOAD(0, 0);
#pragma unroll
            for (int s = 0; s < 4; ++s) {
                if (s < 3) M1_LOAD((s + 1) & 1, s + 1);
#pragma unroll
                for (int c = 0; c < 17; ++c) acc[c] = mfma16(ka[s & 1], vb[s & 1][c], acc[c]);
                __builtin_amdgcn_sched_barrier(0);
            }
#undef M1_LOAD
            bf16* Ub = U + (size_t)us_slot(b, h, mx, j, d) * USLOT;
#pragma unroll
            for (int c = 0; c < 17; ++c) { v2u w; w.x = pk2(acc[c][0], acc[c][1]); w.y = pk2(acc[c][2], acc[c][3]); *(v2u*)(Ub + (16 * c + r16) * 128 + 16 * wave + 4 * q4) = w; }
        }
        __syncthreads();
    }
}

DI void phase_m2(const Frame& F, const Args& A) {
    const v4u* U = WSP(const v4u, WS_A); v4u* S = WSP(v4u, WS_B); float* SCAL = WSP(float, WS_SCAL);
    constexpr int V8 = USLOT / 8, NIT = 64 * V8, NI = 3;
    const int t0 = blockIdx.x * NTHR + TID(F), NT = F.G * NTHR;
    float st[NI][8], m[NI], aret[NI]; int seqb[NI], e8[NI], dd[NI], mxx[NI], scb[NI]; bool ok[NI];
#pragma unroll
    for (int ii = 0; ii < NI; ++ii) { const int it = t0 + ii * NT; ok[ii] = it < NIT; const int itc = ok[ii] ? it : 0;
        const int seq = itc / V8; e8[ii] = itc % V8; const int d = seq & 1, mx = (seq >> 1) & 1, h = (seq >> 2) & 3, b = seq >> 4;
        dd[ii] = d; mxx[ii] = mx; seqb[ii] = (((b * 4 + h) * 2 + mx) * NCH) * 2 + d; scb[ii] = ((b * 4 + h) * 2 + d) * NCH; m[ii] = -1e30f;
        aret[ii] = __expf(128.f * logsigf_(A.in[I_DECAY][d * 4 + h]));
#pragma unroll
        for (int e = 0; e < 8; ++e) st[ii][e] = 0.f; }
#define M2_J(dir_, k_) ((dir_) ? ((k_) == 0 ? 1 : ((k_) == 1 ? 0 : 35 - (k_))) : (k_))
    v4u un[NI]; float mln[NI], bln[NI];
#pragma unroll
    for (int ii = 0; ii < NI; ++ii) { mln[ii] = 0.f; bln[ii] = 0.f; if (ok[ii]) { const int j0 = M2_J(dd[ii], 0); un[ii] = U[(size_t)(seqb[ii] + 2 * j0) * V8 + e8[ii]]; if (mxx[ii]) { mln[ii] = SCAL[scb[ii] + j0]; bln[ii] = SCAL[2048 + scb[ii] + j0]; } } }
#pragma unroll 1
    for (int k = 0; k < NCH; ++k) {
        v4u u[NI]; float mlc[NI], blc[NI];
#pragma unroll
        for (int ii = 0; ii < NI; ++ii) { u[ii] = un[ii]; mlc[ii] = mln[ii]; blc[ii] = bln[ii];
            if (ok[ii] && k + 1 < NCH) { const int j1 = M2_J(dd[ii], k + 1); un[ii] = U[(size_t)(seqb[ii] + 2 * j1) * V8 + e8[ii]]; if (mxx[ii]) { mln[ii] = SCAL[scb[ii] + j1]; bln[ii] = SCAL[2048 + scb[ii] + j1]; } } }
#pragma unroll
        for (int ii = 0; ii < NI; ++ii) if (ok[ii]) {
            const int j = M2_J(dd[ii], k); const size_t slot = (size_t)(seqb[ii] + 2 * j) * V8 + e8[ii];
            float a = aret[ii], g = 1.f;
            if (mxx[ii]) { const int si = scb[ii] + j; const float ml = mlc[ii], bl = blc[ii]; const float mn = fmaxf(bl + m[ii], ml);
                a = __expf(bl + m[ii] - mn); g = __expf(ml - mn); if (e8[ii] == 0) SCAL[4096 + si] = m[ii]; m[ii] = mn; }
            v4u o; o.x = pk2(st[ii][0], st[ii][1]); o.y = pk2(st[ii][2], st[ii][3]); o.z = pk2(st[ii][4], st[ii][5]); o.w = pk2(st[ii][6], st[ii][7]); S[slot] = o;
            st[ii][0] = a * st[ii][0] + g * bflo(u[ii].x); st[ii][1] = a * st[ii][1] + g * bfhi(u[ii].x); st[ii][2] = a * st[ii][2] + g * bflo(u[ii].y); st[ii][3] = a * st[ii][3] + g * bfhi(u[ii].y);
            st[ii][4] = a * st[ii][4] + g * bflo(u[ii].z); st[ii][5] = a * st[ii][5] + g * bfhi(u[ii].z); st[ii][6] = a * st[ii][6] + g * bflo(u[ii].w); st[ii][7] = a * st[ii][7] + g * bfhi(u[ii].w);
        }
    }
#undef M2_J
}

template <int MX, int VAR = 0> DI void m3_unit(const Frame& F, const Args& A, int b, int h, int j, bf16* MRG) {
    const int tid = TID(F);
    const int lane = tid & 63, wave = F.wave, r16 = lane & 15, q4 = lane >> 4;
    LAS unsigned char* LV = F.lds; LAS unsigned char* LS = F.lds + 71680;
    LAS float* TB = (LAS float*)(F.lds + 71680 + 73984);
    const bf16* PROJ = WSP(bf16, WS_BIG); const v4u* S = WSP(const v4u, WS_B);
    constexpr int mx = MX;
    const int R0 = chunk_row0(b, j);
    const int qcol = mx ? 3072 + 128 * h : 128 * h, kcol = mx ? 3584 + 128 * h : 512 + 128 * h, vcol = mx ? 4096 + 256 * h : 1024 + 256 * h, gcol = mx ? 5120 + 256 * h : 2048 + 256 * h;
    const float lgf = logsigf_(A.in[I_DECAY][h]), lgb = logsigf_(A.in[I_DECAY][4 + h]);
    if (mx == 0) {
        if (tid < 128) { TB[3 * 128 + tid] = __expf((float)(tid + 1) * lgf); TB[(4 + 3) * 128 + tid] = __expf((float)(128 - tid) * lgb); }
    } else if (wave < 2) {
        const int d = wave; float Av[2], Bv[2], blast; int cp[2];
        mlstm_gate_scan(WSP(float, WS_GATES), R0, h, d, lane, Av, Bv, cp, blast);
        const float mprev = WSP(float, WS_SCAL)[4096 + sc_idx(b, h, d, j)];
        float inc = fmaxf(Av[0], Av[1]);
#pragma unroll
        for (int o = 1; o < 64; o <<= 1) { const float t = __shfl_up(inc, o); if (lane >= o) inc = fmaxf(inc, t); }
        float prev = __shfl_up(inc, 1); if (lane == 0) prev = -3.0e38f;
        const float rm0 = fmaxf(prev, Av[0]), rm1 = inc;
        const float M0 = fmaxf(mprev, rm0), M1 = fmaxf(mprev, rm1);
        LAS float* T = TB + d * 4 * 128;
        T[cp[0]] = Av[0]; T[cp[1]] = Av[1]; T[128 + cp[0]] = M0; T[128 + cp[1]] = M1; T[256 + cp[0]] = Bv[0]; T[256 + cp[1]] = Bv[1];
        T[384 + cp[0]] = __expf(mprev - M0); T[384 + cp[1]] = __expf(mprev - M1);
    }
    if (!(VAR & 4)) for (int i = tid; i < 128 * 16; i += NTHR) { const int rr = i >> 4, c = i & 15; *(LAS v4u*)(LS + rr * LK_STRIDE + c * 16) = *(const v4u*)(PROJ + (size_t)(R0 + rr) * AB_LD + kcol + 8 * c); }
    if (!(VAR & 4)) for (int i = tid; i < 128 * 32; i += NTHR) { const int rr = i >> 5, c = i & 31; *(LAS v4u*)(LV + rr * LV_STRIDE + c * 16) = *(const v4u*)(PROJ + (size_t)(R0 + rr) * AB_LD + vcol + 8 * c); }
    if (tid < 128) { unsigned z0 = 0u; asm volatile("" : "+v"(z0)); v4u one = {z0 + 0x3F80u, z0, z0, z0}, zero = {z0, z0, z0, z0}; *(LAS v4u*)(LV + tid * LV_STRIDE + 512) = one; *(LAS v4u*)(LV + tid * LV_STRIDE + 528) = zero; }
    const unsigned ls_lds = (unsigned)(size_t)LS;
#define M3_DMA_S(d_, hi_) do { const v4u* Sp_ = S + (size_t)us_slot(b, h, mx, j, (d_)) * (USLOT / 8); const int p0_ = (hi_) ? 2176 : 0, lim_ = (hi_) ? 4624 : 2176; \
        _Pragma("unroll 1") for (int ins = wave; ins < ((hi_) ? 39 : 34); ins += 8) { { const int p = p0_ + ins * 64 + lane; if (p < lim_) { const int rr = p / 17, c0_ = p - rr * 17, c = c0_ == 16 ? 0 : c0_; \
            glds16(Sp_ + rr * 16 + c, ls_lds + (unsigned)(p0_ + ins * 64) * 16u); } } } } while (0)
    const int myq = 16 * wave + r16;
    bf16x8 qf[4];
#pragma unroll
    for (int s = 0; s < 4; ++s) qf[s] = *(const bf16x8*)(PROJ + (size_t)(R0 + myq) * AB_LD + qcol + 32 * s + 8 * q4);
    __syncthreads();
    asm volatile("" : "+v"(qf[0]), "+v"(qf[1]), "+v"(qf[2]), "+v"(qf[3]));
    if (!(VAR & 1)) M3_DMA_S(0, 1);
    f32x4 sc[8];
#pragma unroll
    for (int c = 0; c < 8; ++c) { sc[c] = (f32x4){0.f, 0.f, 0.f, 0.f};
#pragma unroll
        for (int s = 0; s < 4; ++s) sc[c] = mfma16(frag_row(LS, LK_STRIDE, 16 * c, 32 * s, lane), qf[s], sc[c]); }
    f32x4 hs[16];
    { float z0 = 0.f; asm volatile("" : "+v"(z0), "+v"(sc[7][3]));
#pragma unroll
      for (int c = 0; c < 16; ++c) hs[c] = (f32x4){z0, z0, z0, z0}; }
    asm volatile("s_waitcnt vmcnt(0)" ::: "memory");
    __syncthreads();
#pragma unroll 1
    for (int d = 0; d < 2; ++d) {
        const LAS float* T = TB + d * 4 * 128;
        const float sdq = T[384 + myq], Mq = mx ? T[128 + myq] : 0.f, Bq = mx ? T[256 + myq] : 0.f;
        const float lg2 = (d ? lgb : lgf) * 1.4426950408889634f;
        float inv = 1.f;
#pragma unroll
        for (int half = 0; half < 2; ++half) {
            constexpr int NTL[2] = {9, 8}; const int c0 = half ? 0 : 8;
            if (!(VAR & 1)) { if (half == 0) M3_DMA_S(d, 0); else if (d == 0) M3_DMA_S(1, 1); }
            int myq_d = myq, q4_d = q4; float sdq_d = sdq; asm volatile("" : "+v"(myq_d), "+v"(q4_d), "+v"(sdq_d));
            f32x4 acc[9];
#pragma unroll
            for (int c = 0; c < 9; ++c) acc[c] = (f32x4){0.f, 0.f, 0.f, 0.f};
#pragma unroll
            for (int s = 0; s < ((VAR & 2) ? 0 : 4); ++s) {
                float pv[8];
#pragma unroll
                for (int jj = 0; jj < 8; ++jj) { const int c = 2 * s + (jj >> 2), i = jj & 3, key = 16 * c + 4 * q4_d + i;
                    const bool valid = d ? (key >= myq_d) : (key <= myq_d);
                    float w;
                    if (mx == 0) w = __builtin_amdgcn_exp2f((float)(d ? key - myq_d : myq_d - key) * lg2); else w = __expf(T[key] - Mq);
                    pv[jj] = valid ? sc[c][i] * w : 0.f; }
                v4u pw; pw.x = pk2(pv[0], pv[1]); pw.y = pk2(pv[2], pv[3]); pw.z = pk2(pv[4], pv[5]); pw.w = pk2(pv[6], pv[7]);
                const bf16x8 pf = __builtin_bit_cast(bf16x8, pw);
                const v4u qw = __builtin_bit_cast(v4u, qf[s]); v4u qs;
                qs.x = pk2(bflo(qw.x) * sdq_d, bfhi(qw.x) * sdq_d); qs.y = pk2(bflo(qw.y) * sdq_d, bfhi(qw.y) * sdq_d); qs.z = pk2(bflo(qw.z) * sdq_d, bfhi(qw.z) * sdq_d); qs.w = pk2(bflo(qw.w) * sdq_d, bfhi(qw.w) * sdq_d);
                const bf16x8 qd = __builtin_bit_cast(bf16x8, qs);
#pragma unroll
                for (int c = 0; c < NTL[half]; ++c) {
                    acc[c] = mfma16(frag_tr(LV, LV_STRIDE, 32 * s + 4 * q4, 32 * s + 16 + 4 * q4, 16 * (c0 + c), lane), pf, acc[c]);
                    acc[c] = mfma16(frag_row(LS, LK_STRIDE, 16 * (c0 + c), 32 * s, lane), qd, acc[c]);
                    if (c % 2 == 1) __builtin_amdgcn_sched_barrier(0);
                }
                __builtin_amdgcn_sched_barrier(0);
            }
            if (half == 0 && mx == 1) { const float den = __shfl(acc[8][0], r16);
                inv = 1.f / fmaxf(fabsf(den), __expf(-(Bq + Mq))); }
#pragma unroll
            for (int c = 0; c < 8; ++c) hs[c0 + c] = hs[c0 + c] + acc[c] * inv;
            asm volatile("s_waitcnt vmcnt(0)" ::: "memory");
            __syncthreads();
        }
    }
#undef M3_DMA_S
    float s1 = 0.f;
#pragma unroll
    for (int c = 0; c < 16; ++c) s1 += (hs[c][0] + hs[c][1]) + (hs[c][2] + hs[c][3]);
    s1 += __shfl_xor(s1, 16); s1 += __shfl_xor(s1, 32);
    const float mu = s1 * (1.f / 256.f); float s2 = 0.f;
#pragma unroll
    for (int c = 0; c < 16; ++c) { const f32x4 dd = hs[c] - mu; s2 += (dd[0] * dd[0] + dd[1] * dd[1]) + (dd[2] * dd[2] + dd[3] * dd[3]); }
    s2 += __shfl_xor(s2, 16); s2 += __shfl_xor(s2, 32);
    const float rstd = __frsqrt_rn(s2 * (1.f / 256.f) + EPS);
    const float* gn = (mx ? A.in[I_MLGN] : A.in[I_RETGN]) + h * 256;
    const size_t row = (size_t)(R0 + myq);
    v2u gwv[16]; f32x4 gnv[16];
#pragma unroll
    for (int c = 0; c < 16; ++c) { gwv[c] = *(const v2u*)(PROJ + row * AB_LD + gcol + 16 * c + 4 * q4); gnv[c] = *(const f32x4*)(gn + 16 * c + 4 * q4); }
    asm volatile("" ::: "memory");
#pragma unroll
    for (int c = 0; c < ((VAR & 8) ? 1 : 16); ++c) { const int dv = 16 * c + 4 * q4;
        const f32x4 g4 = gnv[c]; const v2u gw = gwv[c];
        const f32x4 y = (hs[c] - mu) * rstd * g4;
        v2u w; w.x = pk2(y[0] * bflo(gw.x), y[1] * bfhi(gw.x)); w.y = pk2(y[2] * bflo(gw.y), y[3] * bfhi(gw.y));
        *(v2u*)(MRG + row * DM + mx * 1024 + h * 256 + dv) = w; }
}
template <int VAR> DI void phase_m3(const Frame& F, const Args& A, bf16* MRG) {
    for (int unit = blockIdx.x; unit < NB * 4 * NCH; unit += F.G) { const int j = unit % NCH, t_ = unit / NCH; m3_unit<0, VAR>(F, A, t_ >> 2, t_ & 3, j, MRG); }
    for (int unit = blockIdx.x; unit < NB * 4 * NCH; unit += F.G) { const int j = unit % NCH, t_ = unit / NCH; m3_unit<1, VAR>(F, A, t_ >> 2, t_ & 3, j, MRG); }
}

template <bool FINAL> DI void phase_lru(const Frame& F, const Args& A) {
    LAS unsigned char* LXB = F.lds;
    LAS float* LXF = (LAS float*)(F.lds + 35904);
    LAS unsigned char* LXL = F.lds + 35904 + 67584;
    const bf16* P2 = WSP(bf16, WS_BIG); const bf16* LWT = WSP(bf16, WS_LWT); float* AGG = WSP(float, WS_AGG); bf16* MRG = WSP(bf16, WS_XN);
    for (int unit = blockIdx.x; unit < NB * NCH * 8; unit += F.G) {
        const int g = unit & 7, bj_ = unit >> 3, j = bj_ % NCH, b = bj_ / NCH;
        if (FINAL && j < 2) continue;
        const int tid = TID(F);
        const int lane = tid & 63, wave = F.wave, r16 = lane & 15, q4 = lane >> 4;
        const int R0 = chunk_row0(b, j), seq0 = j < 2 ? ML + b * CTXL : b * SEQ, seqlen = j < 2 ? CTXL : SEQ, t0 = R0 - seq0;
        for (int i = tid; i < 131 * 16; i += NTHR) { const int rr = i >> 4, c = i & 15, t = t0 - 2 + rr; v4u v = {0u, 0u, 0u, 0u};
            if (t >= 0 && t < seqlen) v = *(const v4u*)(P2 + (size_t)(seq0 + t) * CD_N + 1024 + 128 * g + 8 * c);
            *(LAS v4u*)(LXB + rr * 272 + c * 16) = v; }
        __syncthreads();
        { const int ch = tid & 127; const float* cw = A.in[I_CONVW] + 128 * g + ch; const float w0 = cw[0], w1 = cw[1024], w2 = cw[2048], w3 = cw[3072], cb = A.in[I_CONVB][128 * g + ch];
#pragma unroll 4
          for (int k = 0; k < 32; ++k) { const int row = (tid >> 7) + 4 * k; const LAS unsigned short* xp = (const LAS unsigned short*)(LXB + row * 272 + ch * 2);
              const float xl = cb + w0 * bf2f(xp[0]) + w1 * bf2f(xp[136]) + w2 * bf2f(xp[272]) + w3 * bf2f(xp[408]);
              LXF[row * 132 + ch] = xl; *(LAS unsigned short*)(LXL + row * 272 + ch * 2) = f2bf(xl); } }
        __syncthreads();
        const int chb = 16 * wave + r16, ch = 128 * g + chb;
        float hsum[8][4];
#pragma unroll
        for (int d = 0; d < 2; ++d) {
            bf16x8 wa[4], wx[4];
#pragma unroll
            for (int s = 0; s < 4; ++s) { wa[s] = *(const bf16x8*)(LWT + (size_t)((2 * d) * 8 + g) * 16384 + chb * 128 + 32 * s + 8 * q4);
                                          wx[s] = *(const bf16x8*)(LWT + (size_t)((2 * d + 1) * 8 + g) * 16384 + chb * 128 + 32 * s + 8 * q4); }
            const float ba = A.in[I_LBA][d * 1024 + ch], bx = A.in[I_LBX][d * 1024 + ch], lam = A.in[I_LAM][d * 1024 + ch];
            const float sp8 = -8.f * (fmaxf(-lam, 0.f) + log1pf(__expf(-fabsf(lam))));
            float carry = 0.f;
            if (FINAL) {
                const float* ag = AGG + ((size_t)(d * NB + b) * NCH) * 2048 + 2 * ch;
                for (int k = 0; k < NCH; ++k) { const int jj = d ? (k == 0 ? 1 : (k == 1 ? 0 : 35 - k)) : k; if (jj == j) break; const f32x2 ph = *(const f32x2*)(ag + (size_t)jj * 2048); carry = ph.y + ph.x * carry; }
            }
            float ptot = 1.f;
#pragma unroll
            for (int mm = 0; mm < 8; ++mm) {
                const int m = d ? 7 - mm : mm;
                f32x4 aa = {0.f, 0.f, 0.f, 0.f}, ax = {0.f, 0.f, 0.f, 0.f};
#pragma unroll
                for (int s = 0; s < 4; ++s) { const bf16x8 xf = frag_row(LXL, 272, 16 * m, 32 * s, lane); aa = mfma16(xf, wa[s], aa); ax = mfma16(xf, wx[s], ax); }
                float av[4], bv[4];
#pragma unroll
                for (int i = 0; i < 4; ++i) { const int row = 16 * m + 4 * q4 + i; const float rg = sigmoidf_(aa[i] + ba), ig = sigmoidf_(ax[i] + bx), la = sp8 * rg;
                    av[i] = __expf(la); bv[i] = __builtin_amdgcn_sqrtf(fmaxf(1.f - av[i] * av[i], 0.f)) * ig * LXF[row * 132 + chb]; }
                float P = 1.f, H = 0.f;
#pragma unroll
                for (int ii = 0; ii < 4; ++ii) { const int i = d ? 3 - ii : ii; H = av[i] * H + bv[i]; P *= av[i]; }
                float hstart = carry, cnext = carry;
#pragma unroll
                for (int qq_ = 0; qq_ < 4; ++qq_) { const int qq = d ? 3 - qq_ : qq_;
                    const float Pq = __shfl(P, r16 + 16 * qq), Hq = __shfl(H, r16 + 16 * qq);
                    const bool before = d ? (qq > q4) : (qq < q4);
                    if (before) hstart = Hq + Pq * hstart;
                    cnext = Hq + Pq * cnext; ptot *= Pq; }
                if (FINAL) { float hcur = hstart;
#pragma unroll
                    for (int ii = 0; ii < 4; ++ii) { const int i = d ? 3 - ii : ii; hcur = av[i] * hcur + bv[i]; if (d == 0) hsum[m][i] = hcur; else hsum[m][i] += hcur; } }
                carry = cnext;
                __builtin_amdgcn_sched_barrier(0);
            }
            if (!FINAL && q4 == 0) { f32x2 ph; ph.x = ptot; ph.y = carry; *(f32x2*)(AGG + ((size_t)(d * NB + b) * NCH + j) * 2048 + 2 * ch) = ph; }
        }
        if (FINAL) {
            unsigned short ybv[8][4];
#pragma unroll
            for (int m = 0; m < 8; ++m)
#pragma unroll
                for (int i = 0; i < 4; ++i) ybv[m][i] = P2[(size_t)(R0 + 16 * m + 4 * q4 + i) * CD_N + ch];
            asm volatile("" ::: "memory");
#pragma unroll
            for (int m = 0; m < 8; ++m)
#pragma unroll
                for (int i = 0; i < 4; ++i) { const size_t row = (size_t)(R0 + 16 * m + 4 * q4 + i); MRG[row * DM + ch] = f2bf(bf2f(ybv[m][i]) * hsum[m][i]); }
        }
        __syncthreads();
    }
}
DI void phase_mla_norm(const Frame& F, const Args& A) {
    const int lane = lane_id(), gw = blockIdx.x * NWAVES + F.wave, NGW = F.G * NWAVES;
    const bf16* P2 = WSP(bf16, WS_BIG); bf16* CQN = WSP(bf16, WS_CQN); bf16* CKVN = WSP(bf16, WS_CKVN);
    for (int row = gw; row < MT; row += NGW) {
        const v4u q = *(const v4u*)(P2 + (size_t)row * CD_N + 2048 + 8 * lane); const v2u k = *(const v2u*)(P2 + (size_t)row * CD_N + 2560 + 4 * lane);
        float qv[8] = {bflo(q.x), bfhi(q.x), bflo(q.y), bfhi(q.y), bflo(q.z), bfhi(q.z), bflo(q.w), bfhi(q.w)}, kv[4] = {bflo(k.x), bfhi(k.x), bflo(k.y), bfhi(k.y)};
        float sq = 0.f, sk = 0.f;
#pragma unroll
        for (int e = 0; e < 8; ++e) sq += qv[e] * qv[e];
#pragma unroll
        for (int e = 0; e < 4; ++e) sk += kv[e] * kv[e];
        const float rq = __frsqrt_rn(wave_sum(sq) * (1.f / 512.f) + EPS), rk = __frsqrt_rn(wave_sum(sk) * (1.f / 256.f) + EPS);
        const float* gq = A.in[I_QNG] + 8 * lane; const float* gk = A.in[I_KVNG] + 4 * lane;
        v4u oq; oq.x = pk2(qv[0] * rq * gq[0], qv[1] * rq * gq[1]); oq.y = pk2(qv[2] * rq * gq[2], qv[3] * rq * gq[3]); oq.z = pk2(qv[4] * rq * gq[4], qv[5] * rq * gq[5]); oq.w = pk2(qv[6] * rq * gq[6], qv[7] * rq * gq[7]);
        v2u ok; ok.x = pk2(kv[0] * rk * gk[0], kv[1] * rk * gk[1]); ok.y = pk2(kv[2] * rk * gk[2], kv[3] * rk * gk[3]);
        *(v4u*)(CQN + (size_t)row * 512 + 8 * lane) = oq; *(v2u*)(CKVN + (size_t)row * 256 + 4 * lane) = ok;
    }
}
DI void qk_head_norm(const v4u (&x)[3], const float (&g)[24], float scale, bool rot, const f32x4 (&cs)[2], const f32x4 (&sn)[2], int sub, bf16* op) {
    float v[24];
#pragma unroll
    for (int i = 0; i < 3; ++i) { v[8 * i] = bflo(x[i].x); v[8 * i + 1] = bfhi(x[i].x); v[8 * i + 2] = bflo(x[i].y); v[8 * i + 3] = bfhi(x[i].y); v[8 * i + 4] = bflo(x[i].z); v[8 * i + 5] = bfhi(x[i].z); v[8 * i + 6] = bflo(x[i].w); v[8 * i + 7] = bfhi(x[i].w); }
    float ss = 0.f;
#pragma unroll
    for (int i = 0; i < 24; ++i) ss += v[i] * v[i];
    ss += __shfl_xor(ss, 1); ss += __shfl_xor(ss, 2); ss += __shfl_xor(ss, 4);
    const float rs = __frsqrt_rn(ss * (1.f / 192.f) + EPS) * scale;
#pragma unroll
    for (int i = 0; i < 24; ++i) v[i] = v[i] * rs * g[i];
#pragma unroll
    for (int i = 0; i < 8; ++i) { const float own = v[16 + i], pr = __shfl_xor(own, 2); const float c = cs[i >> 2][i & 3], s_ = sn[i >> 2][i & 3];
        if (rot) v[16 + i] = (sub & 2) ? pr * s_ + own * c : own * c - pr * s_; }
    v4u o0, o1, o2;
    o0.x = pk2(v[0], v[1]); o0.y = pk2(v[2], v[3]); o0.z = pk2(v[4], v[5]); o0.w = pk2(v[6], v[7]);
    o1.x = pk2(v[8], v[9]); o1.y = pk2(v[10], v[11]); o1.z = pk2(v[12], v[13]); o1.w = pk2(v[14], v[15]);
    o2.x = pk2(v[16], v[17]); o2.y = pk2(v[18], v[19]); o2.z = pk2(v[20], v[21]); o2.w = pk2(v[22], v[23]);
    *(v4u*)(op + sub * 16) = o0; *(v4u*)(op + sub * 16 + 8) = o1; *(v4u*)(op + 128 + sub * 8) = o2;
}
DI void phase_qk_norm(const Frame& F, const Args& A) {
    const int lane = lane_id(), gw = blockIdx.x * NWAVES + F.wave, NGW = F.G * NWAVES, h = lane >> 3, sub = lane & 7;
    const bf16* P2 = WSP(bf16, WS_BIG); const bf16* QRAW = WSP(bf16, WS_A); const bf16* KVRAW = WSP(bf16, WS_KVRAW); bf16* QF = WSP(bf16, WS_QF); bf16* KF = WSP(bf16, WS_KF);
    const float* axc = WSP(float, WS_AXC); const float* axs = WSP(float, WS_AXS);
    const float* g0 = A.in[I_QKNG]; const float* g1 = g0 + 192;
    float gq[24], gk[24];
#pragma unroll
    for (int i = 0; i < 16; ++i) { gq[i] = g0[sub * 16 + i]; gk[i] = g1[sub * 16 + i]; }
#pragma unroll
    for (int i = 0; i < 8; ++i) { gq[16 + i] = g0[128 + sub * 8 + i]; gk[16 + i] = g1[128 + sub * 8 + i]; }
    constexpr float QS = 0.07216878364870323f * 1.4426950408889634f;
    for (int row = gw; row < MT; row += NGW) {
        const bool lat = row < ML;
        f32x4 cs[2] = {{1.f, 1.f, 1.f, 1.f}, {1.f, 1.f, 1.f, 1.f}}, sn[2] = {{0.f, 0.f, 0.f, 0.f}, {0.f, 0.f, 0.f, 0.f}};
        if (lat) { const int t = row & (SEQ - 1), pos = sub < 4 ? (t >> 6) : (t & 63); const f32x4* cp = (const f32x4*)(axc + pos * 16 + (sub & 1) * 8); const f32x4* sp = (const f32x4*)(axs + pos * 16 + (sub & 1) * 8);
            cs[0] = cp[0]; cs[1] = cp[1]; sn[0] = sp[0]; sn[1] = sp[1]; }
        v4u kx[3]; kx[0] = *(const v4u*)(KVRAW + (size_t)row * 2048 + h * 128 + sub * 16); kx[1] = *(const v4u*)(KVRAW + (size_t)row * 2048 + h * 128 + sub * 16 + 8); kx[2] = *(const v4u*)(P2 + (size_t)row * CD_N + 2816 + sub * 8);
        v4u qx[3];
        if (lat) { const bf16* qp = QRAW + (size_t)row * 1536 + h * 192; qx[0] = *(const v4u*)(qp + sub * 16); qx[1] = *(const v4u*)(qp + sub * 16 + 8); qx[2] = *(const v4u*)(qp + 128 + sub * 8); }
        else { qx[0] = kx[0]; qx[1] = kx[1]; qx[2] = kx[2]; }
        qk_head_norm(kx, gk, 1.f, lat, cs, sn, sub, KF + (size_t)row * 1536 + h * 192);
        if (lat) qk_head_norm(qx, gq, QS, true, cs, sn, sub, QF + (size_t)row * 1536 + h * 192);
    }
}
constexpr int AK_STRIDE = 400, AV_STRIDE = 288, AK_BYTES = 64 * AK_STRIDE, AV_BYTES = 64 * AV_STRIDE, ABUF = AK_BYTES + AV_BYTES;
DI int key_row(int b, int n) { return n < CTXL ? ML + b * CTXL + n : b * SEQ + (n - CTXL); }
constexpr int AKB = AK_BYTES, AVB = 64 * AV_STRIDE;
template <int VAR> DI void phase_attn(const Frame& F, const Args& A, bf16* MRG) {
    const bf16* QF = WSP(bf16, WS_QF); const bf16* KF = WSP(bf16, WS_KF); const bf16* KVRAW = WSP(bf16, WS_KVRAW);
    constexpr int NT = (CTXL + SEQ) / 64;
    LAS unsigned char* KB0 = F.lds; LAS unsigned char* VB0 = F.lds + 2 * AKB;
    const unsigned kb_lds = (unsigned)(size_t)KB0, vb_lds = (unsigned)(size_t)VB0;
    for (int unit = blockIdx.x; unit < NB * 8 * 16; unit += F.G) {
        const int tid = TID(F);
        const int lane = tid & 63, wave = F.wave, r16 = lane & 15, q4 = lane >> 4;
        const int qb = unit & 15, h = (unit >> 4) & 7, b = unit >> 7;
        const size_t qrow0 = (size_t)b * SEQ + qb * 256 + 32 * wave + r16;
        bf16x8 qf[2][6];
#pragma unroll
        for (int qt = 0; qt < 2; ++qt)
#pragma unroll
            for (int s = 0; s < 6; ++s) qf[qt][s] = *(const bf16x8*)(QF + (qrow0 + 16 * qt) * 1536 + h * 192 + 32 * s + 8 * q4);
#define ATT_DMA_K(t, buf) do { _Pragma("unroll") for (int x = 0; x < 4; ++x) { const int ins = wave + 8 * x; if (ins < 25) { const int p = ins * 64 + lane, rr = p / 25, c0_ = p - rr * 25, c = c0_ == 24 ? 0 : c0_; \
            glds16(KF + (size_t)key_row(b, 64 * (t) + rr) * 1536 + h * 192 + 8 * c, kb_lds + (buf) * AKB + ins * 1024); } } } while (0)
#define ATT_DMA_V(t, buf) do { _Pragma("unroll") for (int x = 0; x < 3; ++x) { const int ins = wave + 8 * x; if (ins < 18) { const int p = ins * 64 + lane, rr = p / 18, c0_ = p - rr * 18, c = c0_ >= 16 ? 0 : c0_; \
            glds16(KVRAW + (size_t)key_row(b, 64 * (t) + rr) * 2048 + 1024 + h * 128 + 8 * c, vb_lds + (buf) * AVB + ins * 1024); } } } while (0)
        ATT_DMA_K(0, 0); ATT_DMA_V(0, 0);
        asm volatile("s_waitcnt vmcnt(0)" ::: "memory");
        __syncthreads();
        f32x4 o[2][8];
#pragma unroll
        for (int qt = 0; qt < 2; ++qt)
#pragma unroll
            for (int c = 0; c < 8; ++c) o[qt][c] = (f32x4){0.f, 0.f, 0.f, 0.f};
        float mrun[2] = {-1e30f, -1e30f}, lrun[2] = {0.f, 0.f};
#pragma unroll 1
        for (int t = 0; t < NT; ++t) {
            if (t + 1 < NT) { ATT_DMA_K(t + 1, (t + 1) & 1); ATT_DMA_V(t + 1, (t + 1) & 1); }
            const LAS unsigned char* kb = KB0 + (t & 1) * AKB; const LAS unsigned char* vb = VB0 + (t & 1) * AVB;
            f32x4 sc[2][4]; bf16x8 kf[2][6];
#pragma unroll
            for (int s = 0; s < 6; ++s) kf[0][s] = frag_row(kb, AK_STRIDE, 0, 32 * s, lane);
#pragma unroll
            for (int c = 0; c < 4; ++c) {
                if (c < 3) {
#pragma unroll
                    for (int s = 0; s < 6; ++s) kf[(c + 1) & 1][s] = frag_row(kb, AK_STRIDE, 16 * (c + 1), 32 * s, lane); }
                sc[0][c] = (f32x4){0.f, 0.f, 0.f, 0.f}; sc[1][c] = (f32x4){0.f, 0.f, 0.f, 0.f};
#pragma unroll
                for (int s = 0; s < ((VAR & 1) ? 1 : 6); ++s) { sc[0][c] = mfma16(kf[c & 1][s], qf[0][s], sc[0][c]); sc[1][c] = mfma16(kf[c & 1][s], qf[1][s], sc[1][c]); }
                __builtin_amdgcn_sched_barrier(0);
            }
            bf16x8 vf[2][4];
#define ATT_LOADV_GRP(dst, g_) do { _Pragma("unroll") for (int j = 0; j < 4; ++j) dst[j] = frag_tr(vb, AV_STRIDE, 32 * ((g_) >> 1) + 4 * q4, 32 * ((g_) >> 1) + 16 + 4 * q4, 16 * (4 * ((g_) & 1) + j), lane); } while (0)
            ATT_LOADV_GRP(vf[0], 0);
            bf16x8 pf[2][2];
#pragma unroll
            for (int qt = 0; qt < 2; ++qt) {
                float mx = fmaxf(fmaxf(fmaxf(sc[qt][0][0], sc[qt][0][1]), fmaxf(sc[qt][0][2], sc[qt][0][3])), fmaxf(fmaxf(sc[qt][1][0], sc[qt][1][1]), fmaxf(sc[qt][1][2], sc[qt][1][3])));
                mx = fmaxf(mx, fmaxf(fmaxf(fmaxf(sc[qt][2][0], sc[qt][2][1]), fmaxf(sc[qt][2][2], sc[qt][2][3])), fmaxf(fmaxf(sc[qt][3][0], sc[qt][3][1]), fmaxf(sc[qt][3][2], sc[qt][3][3]))));
                mx = fmaxf(mx, __shfl_xor(mx, 16)); mx = fmaxf(mx, __shfl_xor(mx, 32));
                float mnew = mrun[qt];
                if (__any(mx > mrun[qt] + 10.f)) {
                    mnew = fmaxf(mrun[qt], mx); const float alpha = __builtin_amdgcn_exp2f(mrun[qt] - mnew); mrun[qt] = mnew; lrun[qt] *= alpha;
#pragma unroll
                    for (int c = 0; c < 8; ++c) o[qt][c] = o[qt][c] * alpha;
                }
                float ps = 0.f;
#pragma unroll
                for (int c = 0; c < 4; ++c)
#pragma unroll
                    for (int i = 0; i < 4; ++i) { sc[qt][c][i] = __builtin_amdgcn_exp2f(sc[qt][c][i] - mnew); ps += sc[qt][c][i]; }
                lrun[qt] += ps;
#pragma unroll
                for (int s = 0; s < 2; ++s) { v4u pw; pw.x = pk2(sc[qt][2 * s][0], sc[qt][2 * s][1]); pw.y = pk2(sc[qt][2 * s][2], sc[qt][2 * s][3]); pw.z = pk2(sc[qt][2 * s + 1][0], sc[qt][2 * s + 1][1]); pw.w = pk2(sc[qt][2 * s + 1][2], sc[qt][2 * s + 1][3]);
                    pf[qt][s] = __builtin_bit_cast(bf16x8, pw); }
            }
            __builtin_amdgcn_sched_barrier(0);
#pragma unroll
            for (int g = 0; g < ((VAR & 4) ? 1 : 4); ++g) {
                if (g < 3) ATT_LOADV_GRP(vf[(g + 1) & 1], g + 1);
#pragma unroll
                for (int j = 0; j < 4; ++j) { const int c = 4 * (g & 1) + j; o[0][c] = mfma16(vf[g & 1][j], pf[0][g >> 1], o[0][c]); o[1][c] = mfma16(vf[g & 1][j], pf[1][g >> 1], o[1][c]); }
                __builtin_amdgcn_sched_barrier(0);
            }
#undef ATT_LOADV_GRP
            asm volatile("s_waitcnt vmcnt(0)" ::: "memory");
            __syncthreads();
        }
#undef ATT_DMA_K
#undef ATT_DMA_V
#pragma unroll
        for (int qt = 0; qt < 2; ++qt) {
            float l = lrun[qt]; l += __shfl_xor(l, 16); l += __shfl_xor(l, 32);
            const float inv = 1.f / l;
#pragma unroll
            for (int c = 0; c < 8; ++c) { v2u w; w.x = pk2(o[qt][c][0] * inv, o[qt][c][1] * inv); w.y = pk2(o[qt][c][2] * inv, o[qt][c][3] * inv); *(v2u*)(MRG + (qrow0 + 16 * qt) * DM + 1024 + h * 128 + 16 * c + 4 * q4) = w; }
        }
    }
}

#ifndef MK_KROT
#define MK_KROT 0
#endif
#define GEMM_PHASE(EPI, Aptr, Bptr, M_, N_, K_, Eobj) do { pg8::Gemm g_{(const pg8::bf16_t*)(Aptr), (const pg8::bf16_t*)(Bptr), (M_), (N_), (K_), (K_)}; pg8::StaticOrder S_; S_.init((M_), (N_), F.G, vcu, (MK_KROT) && (K_) >= 1024); \
        pg8::gemm_phase<EPI, pg8::StaticOrder, true, true>(F.lds, g_, S_, (Eobj)); } while (0)
#define GEMM_CTX_SPLIT(Aptr, Bptr, KP, LDK) do { const int c_ = vcu, ks_ = c_ >> 5; int p0_, np_; \
        if ((KP) == 43) { np_ = ks_ < 3 ? 6 : 5; p0_ = ks_ < 3 ? 6 * ks_ : 18 + 5 * (ks_ - 3); } else { np_ = (KP) / 8; p0_ = np_ * ks_; } \
        pg8::Gemm g_{(const pg8::bf16_t*)(Aptr), (const pg8::bf16_t*)(Bptr), MC, DM, np_ * 128, (LDK)}; pg8::SplitOrder S_{c_, p0_ * 128}; EpiPartial E_{PART + (size_t)ks_ * MC * DM}; \
        pg8::gemm_phase<EpiPartial, pg8::SplitOrder, true, true>(F.lds, g_, S_, E_); } while (0)

DI void xcd_or_nothing(const XcdBarrier& bar, bool multi) { if (multi) xcd_barrier(bar); }
__global__ void __launch_bounds__(NTHR, 2) mk_fwd(Args A) {
    extern __shared__ __attribute__((aligned(16))) unsigned char lds_raw[];
    Frame F; F.lds = (LAS unsigned char*)lds_raw; F.wave = __builtin_amdgcn_readfirstlane((int)threadIdx.x >> 6); F.G = gridDim.x; F.a = &A;
    volatile LAS unsigned* MISC = (volatile LAS unsigned*)(F.lds + MISC_OFF);
    if (threadIdx.x < 64) MISC[threadIdx.x] = 0u;
    __syncthreads();
    const int lo = A.ph_lo, hi = A.ph_hi < MK_STOP_AFTER + 1 ? A.ph_hi : MK_STOP_AFTER + 1;
    const bool multi = (hi - lo) > 1;
    XcdBarrier bar; bar.bar = (unsigned*)(A.ws + WS_CTL) + CW_BAR; bar.x = 0; bar.st = nullptr; bar.w = F.wave;
    if (multi) bar = xcd_barrier_post((unsigned*)(A.ws + WS_CTL) + CW_BAR, MISC + 8);
    int vcu = (int)blockIdx.x;
    if (multi && F.G <= 256) { if (threadIdx.x == 0) { unsigned* ctl = (unsigned*)(A.ws + WS_CTL); const unsigned x = xb_xcc_id() & 7u; const unsigned rk = atomicAdd(&ctl[8192 + 64 * x], 1u);
            __hip_atomic_store(&ctl[16384 + blockIdx.x], rk * 8u + x + 1u, RLX_AGENT); } }
#ifndef MK_PHASE_MASK
#define MK_PHASE_MASK 0xFFFFFFFFull
#endif
#define IN(k) ((((MK_PHASE_MASK) >> (k)) & 1ull) && lo <= (k) && (k) < hi)
#if defined(MK_DOUBLE_BAR)
#define SEAM(k) do { if (IN((k) + 1)) { xcd_barrier(bar); xcd_barrier(bar); } } while (0)
#else
#define SEAM(k) do { if (IN((k) + 1)) xcd_barrier(bar); } while (0)
#endif
#ifndef MK_REPEAT_MASK
#define MK_REPEAT_MASK 0ull
#endif
#define REPK(k) ((int)(((MK_REPEAT_MASK) >> (k)) & 1ull))
    float* XL = A.out; float* XC = WSP(float, WS_XC); float* SCRL = WSP(float, WS_B); float* SCRC = WSP(float, WS_B + 128 * MiB); float* PART = WSP(float, WS_A); const CtxFix NOFIX{nullptr, nullptr, nullptr, 0.f}; const float* MOD = WSP(float, WS_MOD);
    bf16* XN = WSP(bf16, WS_XN); bf16* BIG = WSP(bf16, WS_BIG);

    if (IN(0)) { _Pragma("unroll") for (int rep = 0; rep < 1 + REPK(0); ++rep) { if (rep) xcd_or_nothing(bar, multi); phase_pre(F, A, rep == 0); } SEAM(0); }
    if (multi && F.G <= 256) {
        const unsigned* ctl = (const unsigned*)(A.ws + WS_CTL); LAS unsigned* cnt = (LAS unsigned*)(F.lds + MISC_OFF + 64);
        const int tid_ = TID(F);
        if (tid_ == 0) *cnt = 0u;
        __syncthreads();
        const unsigned mine = __hip_atomic_load(&ctl[16384 + blockIdx.x], RLX_AGENT);
        if (tid_ < F.G) { const unsigned kj = __hip_atomic_load(&ctl[16384 + tid_], RLX_AGENT); if (kj < mine) atomicAdd((unsigned*)cnt, 1u); }
        __syncthreads();
        vcu = (int)*cnt;
        __syncthreads();
    }
    if (IN(1)) { _Pragma("unroll") for (int rep = 0; rep < 1 + REPK(1); ++rep) { if (rep) xcd_or_nothing(bar, multi); phase_norm(F, A, 0, 0, MT, true, NOFIX); } SEAM(1); }
    if (IN(2)) { { EpiUp E{BIG}; GEMM_PHASE(EpiUp, XN, WSP(bf16, WS_WGU), MT, NGU, DM, E); }
#if defined(MK_PROBE_SAMETILE)
        { xcd_or_nothing(bar, multi); EpiUp E{(bf16*)SCRL}; pg8::Gemm g_{(const pg8::bf16_t*)XN, (const pg8::bf16_t*)WSP(bf16, WS_WGU), MT, NGU, DM, DM}; pg8::SameTileOrder S_; S_.init(MT, NGU, F.G, (int)blockIdx.x);
          pg8::gemm_phase<EpiUp, pg8::SameTileOrder, true, true>(F.lds, g_, S_, E); }
#endif
#if defined(MK_PROBE_NULLEPI)
        { xcd_or_nothing(bar, multi); EpiNull<true> E{SCRL + (size_t)blockIdx.x * 4096}; pg8::Gemm g_{(const pg8::bf16_t*)XN, (const pg8::bf16_t*)WSP(bf16, WS_WGU), MT, NGU, DM, DM}; pg8::StaticOrder S_; S_.init(MT, NGU, F.G, vcu);
          pg8::gemm_phase<EpiNull<true>, pg8::StaticOrder, true, true>(F.lds, g_, S_, E); }
#endif
#if defined(MK_PROBE_FEW)
        { xcd_or_nothing(bar, multi); EpiUp E{(bf16*)SCRL}; pg8::Gemm g_{(const pg8::bf16_t*)XN, (const pg8::bf16_t*)WSP(bf16, WS_WGU), MT, NGU, DM, DM}; pg8::FewTileOrder S_; S_.init(MT, NGU, F.G, vcu);
          pg8::gemm_phase<EpiUp, pg8::FewTileOrder, true, true>(F.lds, g_, S_, E); }
#endif
#if defined(MK_PROBE_FIX)
        { xcd_or_nothing(bar, multi); EpiUp E{(bf16*)SCRL}; pg8::Gemm g_{(const pg8::bf16_t*)XN, (const pg8::bf16_t*)WSP(bf16, WS_WGU), MT, NGU, DM, DM}; pg8::ProbeOrder<(MK_PROBE_FIX & 1) != 0, (MK_PROBE_FIX & 2) != 0> S_; S_.init(MT, NGU, F.G, vcu);
          pg8::gemm_phase<EpiUp, pg8::ProbeOrder<(MK_PROBE_FIX & 1) != 0, (MK_PROBE_FIX & 2) != 0>, true, true>(F.lds, g_, S_, E); }
#endif
        SEAM(2); }
    if (IN(3)) { _Pragma("unroll") for (int rep = 0; rep < 1 + REPK(3); ++rep) { if (rep) xcd_or_nothing(bar, multi); EpiResid E{A.in[I_X], A.in[I_CTX], rep ? SCRL : XL, rep ? SCRC : XC, MOD + 2 * DM, 0.5f}; GEMM_PHASE(EpiResid, BIG, WSP(bf16, WS_WD), ML, DM, FF, E); if (!rep) GEMM_CTX_SPLIT(BIG + (size_t)ML * FF, WSP(bf16, WS_WD), 43, FF); }
#if defined(MK_PROBE_NULLEPI_DOWN)
        { xcd_or_nothing(bar, multi); EpiNull<false> E{SCRL + (size_t)blockIdx.x * 4096}; pg8::Gemm g_{(const pg8::bf16_t*)BIG, (const pg8::bf16_t*)WSP(bf16, WS_WD), ML, DM, FF, FF}; pg8::StaticOrder S_; S_.init(ML, DM, F.G, vcu);
          pg8::gemm_phase<EpiNull<false>, pg8::StaticOrder, true, true>(F.lds, g_, S_, E); }
#endif
#if defined(MK_PROBE_SAMETILE_DOWN)
        { xcd_or_nothing(bar, multi); EpiResid E{A.in[I_X], A.in[I_CTX], SCRL, SCRC, MOD + 2 * DM, 0.5f}; pg8::Gemm g_{(const pg8::bf16_t*)BIG, (const pg8::bf16_t*)WSP(bf16, WS_WD), ML, DM, FF, FF}; pg8::SameTileOrder S_; S_.init(ML, DM, F.G, (int)blockIdx.x);
          pg8::gemm_phase<EpiResid, pg8::SameTileOrder, true, true>(F.lds, g_, S_, E); }
#endif
        SEAM(3); }
    if (IN(4)) { _Pragma("unroll") for (int rep = 0; rep < 1 + REPK(4); ++rep) { if (rep) xcd_or_nothing(bar, multi); phase_norm(F, A, 0, 1, MT, false, CtxFix{A.in[I_CTX], PART, MOD + 4 * MODW + 2 * DM, 0.5f}); } SEAM(4); }
    if (IN(5)) { _Pragma("unroll") for (int rep = 0; rep < 1 + REPK(5); ++rep) { if (rep) xcd_or_nothing(bar, multi); EpiProjAB E{BIG, WSP(float, WS_GATES), A.in[I_GATEB], WSP(float, WS_ROPEC), WSP(float, WS_ROPES)}; GEMM_PHASE(EpiProjAB, XN, WSP(bf16, WS_ABWIN), MT, AB_N, DM, E); } SEAM(5); }
    if (IN(6)) { _Pragma("unroll") for (int rep = 0; rep < 1 + REPK(6); ++rep) { if (rep) xcd_or_nothing(bar, multi); phase_m1(F, A); } SEAM(6); }
    if (IN(7)) { _Pragma("unroll") for (int rep = 0; rep < 1 + REPK(7); ++rep) { if (rep) xcd_or_nothing(bar, multi); phase_m2(F, A); } SEAM(7); }
    if (IN(8)) { phase_m3<0>(F, A, XN);
#if defined(MK_PROBE_M3)
        xcd_or_nothing(bar, multi); phase_m3<MK_PROBE_M3>(F, A, (bf16*)SCRL);
#endif
        SEAM(8); }
    if (IN(9)) { _Pragma("unroll") for (int rep = 0; rep < 1 + REPK(9); ++rep) { if (rep) xcd_or_nothing(bar, multi); EpiResid E{XL, XC, rep ? SCRL : XL, rep ? SCRC : XC, MOD + 5 * DM, 1.f}; GEMM_PHASE(EpiResid, XN, WSP(bf16, WS_ABWOUT), ML, DM, DM, E); if (!rep) GEMM_CTX_SPLIT(XN + (size_t)ML * DM, WSP(bf16, WS_ABWOUT), 16, DM); } SEAM(9); }
    if (IN(10)) { _Pragma("unroll") for (int rep = 0; rep < 1 + REPK(10); ++rep) { if (rep) xcd_or_nothing(bar, multi); phase_norm(F, A, 0, 2, MT, false, CtxFix{XC, PART, MOD + 4 * MODW + 5 * DM, 1.f}); } SEAM(10); }
    if (IN(11)) { _Pragma("unroll") for (int rep = 0; rep < 1 + REPK(11); ++rep) { if (rep) xcd_or_nothing(bar, multi); EpiUp E{BIG}; GEMM_PHASE(EpiUp, XN, WSP(bf16, WS_WGU) + (size_t)1 * NGU * DM, MT, NGU, DM, E); } SEAM(11); }
    if (IN(12)) { _Pragma("unroll") for (int rep = 0; rep < 1 + REPK(12); ++rep) { if (rep) xcd_or_nothing(bar, multi); EpiResid E{XL, XC, rep ? SCRL : XL, rep ? SCRC : XC, MOD + 8 * DM, 0.5f}; GEMM_PHASE(EpiResid, BIG, WSP(bf16, WS_WD) + (size_t)1 * DM * FF, ML, DM, FF, E); if (!rep) GEMM_CTX_SPLIT(BIG + (size_t)ML * FF, WSP(bf16, WS_WD) + (size_t)1 * DM * FF, 43, FF); } SEAM(12); }
    const float* MOD1 = MOD + 5 * MODW;
    if (IN(13)) { _Pragma("unroll") for (int rep = 0; rep < 1 + REPK(13); ++rep) { if (rep) xcd_or_nothing(bar, multi); phase_norm(F, A, 1, 0, MT, false, CtxFix{XC, PART, MOD + 4 * MODW + 8 * DM, 0.5f}); } SEAM(13); }
    if (IN(14)) { _Pragma("unroll") for (int rep = 0; rep < 1 + REPK(14); ++rep) { if (rep) xcd_or_nothing(bar, multi); EpiUp E{BIG}; GEMM_PHASE(EpiUp, XN, WSP(bf16, WS_WGU) + (size_t)2 * NGU * DM, MT, NGU, DM, E); } SEAM(14); }
    if (IN(15)) { _Pragma("unroll") for (int rep = 0; rep < 1 + REPK(15); ++rep) { if (rep) xcd_or_nothing(bar, multi); EpiResid E{XL, XC, rep ? SCRL : XL, rep ? SCRC : XC, MOD1 + 2 * DM, 0.5f}; GEMM_PHASE(EpiResid, BIG, WSP(bf16, WS_WD) + (size_t)2 * DM * FF, ML, DM, FF, E); if (!rep) GEMM_CTX_SPLIT(BIG + (size_t)ML * FF, WSP(bf16, WS_WD) + (size_t)2 * DM * FF, 43, FF); } SEAM(15); }
    if (IN(16)) { _Pragma("unroll") for (int rep = 0; rep < 1 + REPK(16); ++rep) { if (rep) xcd_or_nothing(bar, multi); phase_norm(F, A, 1, 1, MT, false, CtxFix{XC, PART, MOD1 + 4 * MODW + 2 * DM, 0.5f}); } SEAM(16); }
    if (IN(17)) { _Pragma("unroll") for (int rep = 0; rep < 1 + REPK(17); ++rep) { if (rep) xcd_or_nothing(bar, multi); EpiPlain E{BIG, CD_N, 4}; GEMM_PHASE(EpiPlain, XN, WSP(bf16, WS_CDWIN), MT, CD_N, DM, E); } SEAM(17); }
    if (IN(18)) { _Pragma("unroll") for (int rep = 0; rep < 1 + REPK(18); ++rep) { if (rep) xcd_or_nothing(bar, multi); phase_mla_norm(F, A); phase_lru<false>(F, A); } SEAM(18); }
    if (IN(19)) { _Pragma("unroll") for (int rep = 0; rep < 1 + REPK(19); ++rep) { if (rep) xcd_or_nothing(bar, multi); { EpiPlain E{WSP(bf16, WS_A), 1536, 0}; GEMM_PHASE(EpiPlain, WSP(bf16, WS_CQN), WSP(bf16, WS_WUQ), ML, 1536, 512, E); }
                  { EpiPlain E{WSP(bf16, WS_KVRAW), 2048, 0}; GEMM_PHASE(EpiPlain, WSP(bf16, WS_CKVN), WSP(bf16, WS_WUKV), MT, 2048, 256, E); }
                  phase_lru<true>(F, A); } SEAM(19); }
    if (IN(20)) { _Pragma("unroll") for (int rep = 0; rep < 1 + REPK(20); ++rep) { if (rep) xcd_or_nothing(bar, multi); phase_qk_norm(F, A); } SEAM(20); }
    if (IN(21)) { phase_attn<0>(F, A, XN);
#if defined(MK_PROBE_ATT)
        xcd_or_nothing(bar, multi); phase_attn<MK_PROBE_ATT>(F, A, (bf16*)SCRL);
#endif
        SEAM(21); }
    if (IN(22)) { _Pragma("unroll") for (int rep = 0; rep < 1 + REPK(22); ++rep) { if (rep) xcd_or_nothing(bar, multi); EpiResid E{XL, XC, rep ? SCRL : XL, rep ? SCRC : XC, MOD1 + 5 * DM, 1.f}; GEMM_PHASE(EpiResid, XN, WSP(bf16, WS_CDWOUT), ML, DM, DM, E); } SEAM(22); }
    if (IN(23)) { _Pragma("unroll") for (int rep = 0; rep < 1 + REPK(23); ++rep) { if (rep) xcd_or_nothing(bar, multi); phase_norm(F, A, 1, 2, ML, false, NOFIX); } SEAM(23); }
    if (IN(24)) { _Pragma("unroll") for (int rep = 0; rep < 1 + REPK(24); ++rep) { if (rep) xcd_or_nothing(bar, multi); EpiUp E{BIG}; GEMM_PHASE(EpiUp, XN, WSP(bf16, WS_WGU) + (size_t)3 * NGU * DM, ML, NGU, DM, E); } SEAM(24); }
    if (IN(25)) { _Pragma("unroll") for (int rep = 0; rep < 1 + REPK(25); ++rep) { if (rep) xcd_or_nothing(bar, multi); EpiResid E{XL, XC, rep ? SCRL : XL, rep ? SCRC : XC, MOD1 + 8 * DM, 0.5f}; GEMM_PHASE(EpiResid, BIG, WSP(bf16, WS_WD) + (size_t)3 * DM * FF, ML, DM, FF, E); } }
#undef IN
#undef SEAM
}

extern "C" void kernel_launch(void* const* d_in, const int* in_sizes, int n_in, void* d_out, int out_size, void* d_ws, size_t ws_size, hipStream_t stream) {
    static int grid = 0;
    if (grid == 0) {
        if (n_in != 31 || out_size != ML * DM || ws_size < WS_END) { fprintf(stderr, "kernel_launch: unexpected problem (n_in %d, out %d, ws %zu < %zu); nothing launched\n", n_in, out_size, ws_size, (size_t)WS_END); grid = -1; return; }
        int dev = 0, cus = 0, per_cu = 0;
        if (hipGetDevice(&dev) != hipSuccess || hipDeviceGetAttribute(&cus, hipDeviceAttributeMultiprocessorCount, dev) != hipSuccess) { grid = -1; return; }
        if (hipFuncSetAttribute((const void*)mk_fwd, hipFuncAttributeMaxDynamicSharedMemorySize, LDS_BYTES) != hipSuccess) { fprintf(stderr, "kernel_launch: hipFuncSetAttribute failed\n"); grid = -1; return; }
        if (hipOccupancyMaxActiveBlocksPerMultiprocessor(&per_cu, (const void*)mk_fwd, NTHR, LDS_BYTES) != hipSuccess || per_cu < 1 || cus < 256) {
            fprintf(stderr, "kernel_launch: the occupancy query reports %d workgroups per CU on %d CUs; the grid barrier needs 256 resident workgroups; nothing launched\n", per_cu, cus); (void)hipGetLastError(); grid = -1; return; }
        (void)hipGetLastError();
        grid = 256;
    }
    if (grid < 0) return;
    if (hipMemsetAsync((char*)d_ws + WS_CTL, 0, CTL_ZERO_BYTES, stream) != hipSuccess) return;
    Args a{};
    for (int i = 0; i < 31; ++i) a.in[i] = (const float*)d_in[i];
    a.out = (float*)d_out; a.ws = (unsigned char*)d_ws;
#if MK_ONE_LAUNCH
    a.ph_lo = 0; a.ph_hi = NPHASE;
    hipLaunchKernelGGL(mk_fwd, dim3(grid), dim3(NTHR), LDS_BYTES, stream, a);
#else
    for (int ph = 0; ph < NPHASE && ph <= MK_STOP_AFTER; ++ph) { a.ph_lo = ph; a.ph_hi = ph + 1; hipLaunchKernelGGL(mk_fwd, dim3(grid), dim3(NTHR), LDS_BYTES, stream, a); }
#endif
#if defined(MK_DEBUG_HASH)
    hipLaunchKernelGGL(dbg_hash, dim3(2048), dim3(256), 0, stream, a);
    hipLaunchKernelGGL(dbg_hash_apply, dim3(1024), dim3(256), 0, stream, a);
#endif
#if defined(MK_DEBUG_CHECKS)
    hipLaunchKernelGGL(dbg_checks, dim3(1), dim3(256), 0, stream, a);
    hipLaunchKernelGGL(dbg_apply, dim3(1024), dim3(256), 0, stream, a);
#endif
}
```

```cpp
#include <hip/hip_runtime.h>
#include <cstdio>
#include <cstdint>
#define MK_ONE_LAUNCH 1
namespace pg8 {
#define PG8_LAS __attribute__((address_space(3)))
typedef unsigned short bf16_t;
typedef short bf16x8 __attribute__((ext_vector_type(8)));
typedef float f32x4 __attribute__((ext_vector_type(4)));
typedef unsigned u32x4 __attribute__((ext_vector_type(4)));
constexpr int BM = 256, BK = 64, HALF = 128, HTB = HALF * BK * 2  , STAGE_BYTES = 8 * HTB, NXCD = 8, WGM = 8;

__host__ __device__ __forceinline__ int lds_byte(int r, int c) { const int st = (r >> 4) * 2 + (c >> 5), rr = r & 15, cc = c & 31, ob = rr * 64 + cc * 2; return st * 1024 + (ob ^ (((ob >> 9) & 1) << 5)); }
__host__ __device__ __forceinline__ void stage_rc(int b, int& R, int& C) { const int st = b / 1024, sb = b % 1024, swz = sb ^ (((sb >> 9) & 1) << 5); R = (st >> 1) * 16 + swz / 64; C = (st & 1) * 32 + (swz % 64) / 2; }
__host__ __device__ __forceinline__ int perm32(int rho) { const int n = rho >> 4, i = rho & 15; return 8 * (i >> 2) + 4 * n + (i & 3); }

struct Unit { int pm, pn, koff, rot; };
struct Gemm { const bf16_t* A; const bf16_t* Bt; int M, N, K, ldk; };

struct SplitOrder {
    int c, koff;
    __host__ __device__ bool next(int i, Unit& u) const { if (i > 0 || c >= 256) return false; u.pm = c & 3; u.pn = (c >> 2) & 7; u.koff = koff; u.rot = 0; return true; }
    __device__ __forceinline__ void a_ready(const Unit&) const {}
    __device__ __forceinline__ void done(const Unit&) const {}
};
template <bool FIXA, bool FIXB> struct ProbeOrder;
struct SameTileOrder {
    int nwg, G, c;
    __host__ __device__ void init(int M, int N, int G_, int c_) { nwg = (M / BM) * (N / BM); G = G_; c = c_; }
    __host__ __device__ bool next(int i, Unit& u) const { const long L = (long)i * G + c; if (L >= nwg) return false; u.pm = 0; u.pn = 0; u.koff = 0; u.rot = 0; return true; }
    __device__ __forceinline__ void a_ready(const Unit&) const {}
    __device__ __forceinline__ void done(const Unit&) const {}
};
struct StaticOrder {
    int nM, nN, nwg, G, c, rot_en;
    __host__ __device__ void init(int M, int N, int G_, int c_, int rot_en_ = 0) { nM = M / BM; nN = N / BM; nwg = nM * nN; G = G_; c = c_; rot_en = rot_en_; }
    __host__ __device__ bool next(int i, Unit& u) const {
        const long L = (long)i * G + c; if (L >= nwg) return false;
        int wgid = (int)L; { const int q = nwg / NXCD, r = nwg % NXCD, xcd = wgid % NXCD, off = wgid / NXCD; wgid = (xcd < r ? xcd * (q + 1) : r * (q + 1) + (xcd - r) * q) + off; }
        const int nig = WGM * nN, gid = wgid / nig, fm = gid * WGM, gsz = (nM - fm) < WGM ? (nM - fm) : WGM;
        u.pm = fm + ((wgid % nig) % gsz); u.pn = (wgid % nig) / gsz; u.koff = 0; u.rot = rot_en ? 2 * (((u.pm & 3) + (u.pn & 3) + i) & 3) : 0; return true;
    }
    __device__ __forceinline__ void a_ready(const Unit&) const {}
    __device__ __forceinline__ void done(const Unit&) const {}
};
typedef __bf16 bf16x2_t __attribute__((ext_vector_type(2)));
__device__ __forceinline__ unsigned cvt_pk_bf16(float lo, float hi) { bf16x2_t v = {(__bf16)lo, (__bf16)hi}; return __builtin_bit_cast(unsigned, v); }
template <class Epi, class Sched, bool ALIGN_EPI = false, bool SP2 = false>
__device__ __forceinline__ void gemm_phase(PG8_LAS unsigned char* lds, const Gemm g, const Sched& S, const Epi& E) {
    const int tid = threadIdx.x, wid = __builtin_amdgcn_readfirstlane(tid >> 6), lane = tid & 63, wr = wid >> 2, wc = wid & 3, fr = lane & 15, fq = lane >> 4;
    const int K = g.ldk, nt = g.K / BK;
    unsigned voffA[2], voffB[2];
#pragma unroll
    for (int i = 0; i < 2; ++i) { int R, C; stage_rc(tid * 16 + i * 8192, R, C); const int Rb = Epi::PERM ? ((R & ~31) + perm32(R & 31)) : R;
        voffA[i] = (unsigned)(R * K + C) * 2u; voffB[i] = (unsigned)(Rb * K + C) * 2u; }
    const size_t kstep = (size_t)(BK * 2);
    const size_t hstep = (size_t)HALF * K * 2;
    const size_t tstep = 2 * hstep;
    const unsigned ldsw = (unsigned)wid * 1024u;
    const int aoff = lds_byte(wr * 64 + fr, fq * 8), boff = lds_byte(wc * 32 + fr, fq * 8);
#define PG8_SA(b, h) (((b) * 2 + (h)) * HTB)
#define PG8_SB(b, h) ((4 + (b) * 2 + (h)) * HTB)
#define PG8_STAGE(bufoff, gbase, voff) do { _Pragma("unroll") for (int _i = 0; _i < 2; ++_i) \
        __builtin_amdgcn_global_load_lds((const unsigned*)((const char*)(gbase) + (voff)[_i]), (PG8_LAS unsigned*)(lds + (bufoff) + ldsw + _i * 8192), 16, 0, 0); } while (0)
#define PG8_LDA(dst, b, h) do { _Pragma("unroll") for (int m = 0; m < 4; ++m) _Pragma("unroll") for (int k = 0; k < 2; ++k) dst[m][k] = *(const PG8_LAS bf16x8*)(lds + PG8_SA(b, h) + aoff + m * 2048 + k * 1024); } while (0)
#define PG8_LDB(dst, b, h) do { _Pragma("unroll") for (int n = 0; n < 2; ++n) _Pragma("unroll") for (int k = 0; k < 2; ++k) dst[n][k] = *(const PG8_LAS bf16x8*)(lds + PG8_SB(b, h) + boff + n * 2048 + k * 1024); } while (0)
#define PG8_MMA(ai, bj, At, Bt) do { __builtin_amdgcn_s_setprio(1); _Pragma("unroll") for (int m = 0; m < 4; ++m) _Pragma("unroll") for (int n = 0; n < 2; ++n) _Pragma("unroll") for (int k = 0; k < 2; ++k) \
        acc[ai][bj][m][n] = __builtin_amdgcn_mfma_f32_16x16x32_bf16(Bt[n][k], At[m][k], acc[ai][bj][m][n], 0, 0, 0); __builtin_amdgcn_s_setprio(0); } while (0)
#define PG8_WAIT_V(n) asm volatile("s_waitcnt vmcnt(" #n ")" ::: "memory")
#define PG8_WAIT_L(n) asm volatile("s_waitcnt lgkmcnt(" #n ")" ::: "memory")
#define PG8_BAR __builtin_amdgcn_s_barrier()
#define PG8_SCHED __builtin_amdgcn_sched_barrier(0)
    Unit cur, nxt; int ui = 0;
    if (!S.next(0, cur)) return;
    f32x4 acc[2][2][4][2];
#pragma unroll
    for (int a = 0; a < 2; ++a)
#pragma unroll
        for (int b = 0; b < 2; ++b)
#pragma unroll
            for (int m = 0; m < 4; ++m)
#pragma unroll
                for (int n = 0; n < 2; ++n) acc[a][b][m][n] = (f32x4){0.f, 0.f, 0.f, 0.f};
    bf16x8 At[4][2], B0[2][2], B1[2][2];
    const char* cA = (const char*)g.A + (size_t)cur.pm * tstep + (size_t)cur.koff * 2; const char* cB = (const char*)g.Bt + (size_t)cur.pn * tstep + (size_t)cur.koff * 2;
    size_t kc = (size_t)cur.rot * kstep; const size_t kwrap = (size_t)nt * kstep;
    const char* pA = cA + kc; const char* pB = cB + kc;
    S.a_ready(cur);
    if constexpr (SP2) {
        PG8_STAGE(PG8_SB(0, 0), pB, voffB); PG8_STAGE(PG8_SB(0, 1), pB + hstep, voffB); PG8_STAGE(PG8_SA(0, 0), pA, voffA); PG8_STAGE(PG8_SA(0, 1), pA + hstep, voffA);
        if (wr == 1) PG8_BAR;
        PG8_WAIT_V(2); PG8_BAR;
        PG8_STAGE(PG8_SB(1, 0), pB + kstep, voffB); PG8_STAGE(PG8_SA(1, 0), pA + kstep, voffA); PG8_STAGE(PG8_SB(1, 1), pB + hstep + kstep, voffB);
        PG8_WAIT_V(6); PG8_BAR;
    } else {
        PG8_STAGE(PG8_SB(0, 0), pB, voffB); PG8_STAGE(PG8_SA(0, 0), pA, voffA); PG8_STAGE(PG8_SB(0, 1), pB + hstep, voffB); PG8_STAGE(PG8_SA(0, 1), pA + hstep, voffA);
        if (wr == 1) PG8_BAR;
        PG8_WAIT_V(4); PG8_BAR;
        PG8_STAGE(PG8_SB(1, 0), pB + kstep, voffB); PG8_STAGE(PG8_SA(1, 0), pA + kstep, voffA); PG8_STAGE(PG8_SB(1, 1), pB + hstep + kstep, voffB);
        PG8_WAIT_V(6); PG8_BAR;
    }
    for (;;) {
        const bool has_next = S.next(ui + 1, nxt);
        const char* nA = has_next ? (const char*)g.A + (size_t)nxt.pm * tstep + (size_t)nxt.koff * 2 : cA; const char* nB = has_next ? (const char*)g.Bt + (size_t)nxt.pn * tstep + (size_t)nxt.koff * 2 : cB;
        const size_t nk = (size_t)(has_next ? nxt.rot : cur.rot) * kstep;
        for (int t = 0; t < nt; t += 2) {
            const bool last = (t == nt - 2);
            const char* a1 = cA + kc + kstep;
            size_t k2 = kc + 2 * kstep; if (k2 >= kwrap) k2 -= kwrap;
            const char* a2 = last ? nA + nk : cA + k2; const char* b2 = last ? nB + nk : cB + k2;
            kc = k2;
            const char* a3 = a2 + kstep; const char* b3 = b2 + kstep;
            if (last && has_next) S.a_ready(nxt);
            if constexpr (SP2) {
            PG8_LDB(B0, 0, 0); PG8_LDB(B1, 0, 1); PG8_SCHED; PG8_LDA(At, 0, 0); PG8_STAGE(PG8_SA(1, 1), a1 + hstep, voffA);
            PG8_WAIT_V(8); PG8_WAIT_L(0); PG8_BAR; PG8_MMA(0, 0, At, B0); PG8_MMA(0, 1, At, B1); PG8_BAR; PG8_SCHED;
            PG8_LDA(At, 0, 1); PG8_STAGE(PG8_SB(0, 0), b2, voffB); PG8_STAGE(PG8_SB(0, 1), b2 + hstep, voffB); PG8_STAGE(PG8_SA(0, 0), a2, voffA);
            PG8_WAIT_V(8); PG8_WAIT_L(0); PG8_BAR; PG8_MMA(1, 0, At, B0); PG8_MMA(1, 1, At, B1); PG8_BAR; PG8_SCHED;
            PG8_LDB(B0, 1, 0); PG8_LDB(B1, 1, 1); PG8_SCHED; PG8_LDA(At, 1, 0); PG8_STAGE(PG8_SA(0, 1), a2 + hstep, voffA);
            PG8_WAIT_V(8); PG8_WAIT_L(0); PG8_BAR; PG8_MMA(0, 0, At, B0); PG8_MMA(0, 1, At, B1); PG8_BAR; PG8_SCHED;
            PG8_LDA(At, 1, 1); PG8_STAGE(PG8_SB(1, 0), b3, voffB); PG8_STAGE(PG8_SB(1, 1), b3 + hstep, voffB); PG8_STAGE(PG8_SA(1, 0), a3, voffA);
            PG8_WAIT_V(8); PG8_WAIT_L(0); PG8_BAR; PG8_MMA(1, 0, At, B0); PG8_MMA(1, 1, At, B1); PG8_BAR; PG8_SCHED;
            } else {
            PG8_LDB(B0, 0, 0); PG8_SCHED; PG8_LDA(At, 0, 0); PG8_STAGE(PG8_SA(1, 1), a1 + hstep, voffA);
            PG8_WAIT_L(8); PG8_BAR; PG8_WAIT_L(0); PG8_MMA(0, 0, At, B0); PG8_BAR; PG8_SCHED;
            PG8_LDB(B1, 0, 1); PG8_STAGE(PG8_SB(0, 0), b2, voffB);
            PG8_BAR; PG8_WAIT_L(0); PG8_MMA(0, 1, At, B1); PG8_BAR;
            PG8_LDA(At, 0, 1); PG8_STAGE(PG8_SA(0, 0), a2, voffA);
            PG8_BAR; PG8_WAIT_L(0); PG8_MMA(1, 0, At, B0); PG8_BAR; PG8_SCHED;
            PG8_STAGE(PG8_SB(0, 1), b2 + hstep, voffB);
            PG8_WAIT_V(6); PG8_BAR; PG8_MMA(1, 1, At, B1); PG8_BAR;
            PG8_LDB(B0, 1, 0); PG8_SCHED; PG8_LDA(At, 1, 0); PG8_STAGE(PG8_SA(0, 1), a2 + hstep, voffA);
            PG8_WAIT_L(8); PG8_BAR; PG8_WAIT_L(0); PG8_MMA(0, 0, At, B0); PG8_BAR; PG8_SCHED;
            PG8_LDB(B1, 1, 1); PG8_STAGE(PG8_SB(1, 0), b3, voffB);
            PG8_BAR; PG8_WAIT_L(0); PG8_MMA(0, 1, At, B1); PG8_BAR;
            PG8_LDA(At, 1, 1); PG8_STAGE(PG8_SA(1, 0), a3, voffA);
            PG8_BAR; PG8_WAIT_L(0); PG8_MMA(1, 0, At, B0); PG8_BAR; PG8_SCHED;
            PG8_STAGE(PG8_SB(1, 1), b3 + hstep, voffB);
            PG8_WAIT_V(6); PG8_BAR; PG8_MMA(1, 1, At, B1); PG8_BAR;
            }
        }
        if constexpr (ALIGN_EPI) { if (wr == 0) PG8_BAR; }
        if constexpr (!Epi::AFTER_DRAIN) { E(acc, cur, wr, wc, fr, fq); S.done(cur); }
        if (!has_next) break;
#pragma unroll
        for (int a = 0; a < 2; ++a)
#pragma unroll
            for (int b = 0; b < 2; ++b)
#pragma unroll
                for (int m = 0; m < 4; ++m)
#pragma unroll
                    for (int n = 0; n < 2; ++n) acc[a][b][m][n] = (f32x4){0.f, 0.f, 0.f, 0.f};
        cur = nxt; cA = nA; cB = nB; kc = (size_t)cur.rot * kstep; ++ui;
        if constexpr (ALIGN_EPI) { if (wr == 1) PG8_BAR; }
    }
    PG8_WAIT_V(0);
    if constexpr (!ALIGN_EPI) { if (wr == 0) PG8_BAR; }
    PG8_BAR;
    if constexpr (Epi::AFTER_DRAIN) { E.fused(acc, cur, wr, wc, fr, fq, lds, wid, lane); S.done(cur); }
#undef PG8_SA
#undef PG8_SB
#undef PG8_STAGE
#undef PG8_LDA
#undef PG8_LDB
#undef PG8_MMA
#undef PG8_WAIT_V
#undef PG8_WAIT_L
#undef PG8_BAR
#undef PG8_SCHED
}
struct FewTileOrder : StaticOrder {
    __host__ __device__ bool next(int i, Unit& u) const { if (!StaticOrder::next(i, u)) return false; u.pm = c & 3; u.pn = (c >> 2) & 7; return true; }
};
template <bool FIXA, bool FIXB> struct ProbeOrder : StaticOrder {
    __host__ __device__ bool next(int i, Unit& u) const { if (!StaticOrder::next(i, u)) return false; if (FIXA) u.pm = 0; if (FIXB) u.pn = 0; return true; }
};
}

#ifndef MK_ONE_LAUNCH
#define MK_ONE_LAUNCH 0
#endif
#ifndef MK_STOP_AFTER
#define MK_STOP_AFTER 99
#endif
constexpr int NWAVES = 8, NTHR = 512;
constexpr int DM = 2048, NB = 4, SEQ = 4096, CTXL = 256, FF = 5504, MODW = 9 * DM;
constexpr int ML = NB * SEQ, MC = NB * CTXL, MT = ML + MC;
constexpr int NGU = 2 * FF;
constexpr int AB_N = 6400, AB_LD = 6144, CD_N = 3072;
constexpr int NCH = 34;
constexpr int USLOT = 272 * 128;
constexpr float EPS = 1e-6f;
constexpr int NPHASE = 26;

constexpr size_t MiB = 1u << 20;
constexpr size_t WS_CTL = 0, CTL_ZERO_BYTES = 2 * MiB;
constexpr size_t WS_MOD = 1 * MiB;
constexpr size_t WS_ROPEC = 2 * MiB, WS_ROPES = 3 * MiB;
constexpr size_t WS_AXC = 4 * MiB, WS_AXS = 4 * MiB + 8192;
constexpr size_t WS_GATES = 5 * MiB;
constexpr size_t WS_SCAL = 7 * MiB;
constexpr size_t WS_AGG = 8 * MiB;
constexpr size_t WS_XC = 16 * MiB;
constexpr size_t WS_WGU = 32 * MiB;
constexpr size_t WS_WD = 204 * MiB;
constexpr size_t WS_ABWIN = 290 * MiB;
constexpr size_t WS_ABWOUT = 315 * MiB;
constexpr size_t WS_CDWIN = 323 * MiB;
constexpr size_t WS_CDWOUT = 335 * MiB;
constexpr size_t WS_WUQ = 343 * MiB;
constexpr size_t WS_WUKV = 345 * MiB;
constexpr size_t WS_LWT = 346 * MiB;
constexpr size_t WS_XN = 348 * MiB;
constexpr size_t WS_BIG = 416 * MiB;
constexpr size_t WS_A = 620 * MiB;
constexpr size_t WS_KVRAW = 668 * MiB;
constexpr size_t WS_B = 765 * MiB;
constexpr size_t WS_CQN = 765 * MiB, WS_CKVN = 782 * MiB, WS_QF = 791 * MiB, WS_KF = 839 * MiB;
constexpr size_t WS_END = 910 * MiB;
constexpr int CW_BAR = 4096;

constexpr int RING_BYTES = 131072;
constexpr int LDS_BYTES = 159744;
constexpr int MISC_OFF = LDS_BYTES - 256;

#define GAS __attribute__((address_space(1)))
#define LAS __attribute__((address_space(3)))
#define DI __device__ __forceinline__
typedef unsigned short bf16;
typedef unsigned v4u __attribute__((ext_vector_type(4)));
typedef unsigned v2u __attribute__((ext_vector_type(2)));
typedef float f32x4 __attribute__((ext_vector_type(4)));
typedef float f32x2 __attribute__((ext_vector_type(2)));
typedef short bf16x8 __attribute__((ext_vector_type(8)));
typedef short s16x4 __attribute__((ext_vector_type(4)));
typedef GAS unsigned gu32;
#define RLX_AGENT __ATOMIC_RELAXED, __HIP_MEMORY_SCOPE_AGENT
#define LDS_WAIT() asm volatile("s_waitcnt lgkmcnt(0)" ::: "memory")
#define VM_WAIT() asm volatile("s_waitcnt vmcnt(0)" ::: "memory")
DI int lane_id() { int l; asm volatile("v_mbcnt_lo_u32_b32 %0, -1, 0\n\tv_mbcnt_hi_u32_b32 %0, -1, %0" : "=v"(l)); return l; }
DI float bf2f(unsigned h) { return __builtin_bit_cast(float, h << 16); }
DI float bflo(unsigned w) { return __builtin_bit_cast(float, w << 16); }
DI float bfhi(unsigned w) { return __builtin_bit_cast(float, w & 0xffff0000u); }
DI unsigned pk2(float lo, float hi) { return pg8::cvt_pk_bf16(lo, hi); }
DI unsigned short f2bf(float f) { return (unsigned short)(pk2(f, 0.f) & 0xffffu); }
DI float wave_sum(float v) {
#pragma unroll
    for (int o = 1; o < 64; o <<= 1) v += __shfl_xor(v, o);
    return v;
}
DI float wave_max(float v) {
#pragma unroll
    for (int o = 1; o < 64; o <<= 1) v = fmaxf(v, __shfl_xor(v, o));
    return v;
}
DI float sigmoidf_(float x) { return __builtin_amdgcn_rcpf(1.f + __expf(-x)); }
DI float siluf_(float x) { return x * sigmoidf_(x); }
DI float logsigf_(float x) { return fminf(x, 0.f) - log1pf(__expf(-fabsf(x))); }
DI float gelu_tanh(float x) { const float z = 0.7978845608028654f * (x + 0.044715f * x * x * x); const float t = 1.f - 2.f * __builtin_amdgcn_rcpf(1.f + __expf(2.f * z)); return 0.5f * x * (1.f + t); }
DI f32x4 mfma16(bf16x8 a, bf16x8 b, f32x4 c) { return __builtin_amdgcn_mfma_f32_16x16x32_bf16(a, b, c, 0, 0, 0); }
DI bf16x8 frag_row(const LAS unsigned char* base, int stride_b, int row0, int k0, int lane) {
    return *(const LAS bf16x8*)(base + (row0 + (lane & 15)) * stride_b + (k0 + 8 * (lane >> 4)) * 2);
}
DI bf16x8 frag_tr(const LAS unsigned char* base, int stride_b, int ka, int kb, int c0, int lane) {
    const int idx = lane & 15, qq = idx >> 2, p = idx & 3;
    const s16x4 lo = __builtin_amdgcn_ds_read_tr16_b64_v4i16((LAS s16x4*)(base + (ka + qq) * stride_b + (c0 + 4 * p) * 2));
    const s16x4 hi = __builtin_amdgcn_ds_read_tr16_b64_v4i16((LAS s16x4*)(base + (kb + qq) * stride_b + (c0 + 4 * p) * 2));
    bf16x8 o; o[0] = lo[0]; o[1] = lo[1]; o[2] = lo[2]; o[3] = lo[3]; o[4] = hi[0]; o[5] = hi[1]; o[6] = hi[2]; o[7] = hi[3]; return o;
}

DI void glds16(const void* gsrc, unsigned lds_dst) {
    unsigned keep; asm volatile("s_mov_b32 %0, m0\n\ts_mov_b32 m0, %2\n\ts_nop 0\n\tglobal_load_lds_dwordx4 %1, off\n\ts_mov_b32 m0, %0" : "=&s"(keep) : "v"(gsrc), "s"(lds_dst) : "memory");
}
#define XB_TMO      128
#define XB_XCNT(j)  (256  + 64 * (j))
#define XB_XSUB(j)  (1280 + 64 * (j))
#define XB_XGEN(j)  (2304 + 64 * (j))
#define XB_TOP      3328
#define XB_TOPGEN   3392
#define XCD_BAR_WORDS 3456
#define XB_SPIN_CAP (1u << 18)

__device__ __forceinline__ unsigned xb_ld(unsigned* p)              { return __hip_atomic_load(p, __ATOMIC_RELAXED, __HIP_MEMORY_SCOPE_AGENT); }
__device__ __forceinline__ unsigned xb_add(unsigned* p, unsigned v) { return __hip_atomic_fetch_add(p, v, __ATOMIC_RELAXED, __HIP_MEMORY_SCOPE_AGENT); }
__device__ __forceinline__ unsigned xb_xcc_id() { return (unsigned)__builtin_amdgcn_s_getreg((3 << 11) | 20) & 0xFu; }
#define XB_SPIN(cond, bar) do { unsigned _sp = 0; while (cond) { __builtin_amdgcn_s_sleep(1); \
    if ((++_sp & 255u) == 0u) { if (xb_ld(&(bar)[XB_TMO])) break; if (_sp > XB_SPIN_CAP) { atomicAdd(&(bar)[XB_TMO], 1u); break; } } } } while (0)

struct XcdBarrier {
    unsigned* bar; unsigned x; int w;
    volatile LAS unsigned* st;
};

__device__ __forceinline__ XcdBarrier xcd_barrier_post(unsigned* bar, volatile LAS unsigned* st) {
    XcdBarrier b; b.bar = bar; b.x = xb_xcc_id(); b.st = st;
    b.w = __builtin_amdgcn_readfirstlane((int)threadIdx.x >> 6);
    if (threadIdx.x == 0) (void)xb_add(&bar[XB_XCNT(b.x)], 1u);
    return b;
}
__device__ __forceinline__ void xcd_barrier_complete(unsigned* bar, unsigned x, unsigned& nloc, unsigned& nx) {
    const unsigned G = gridDim.x * gridDim.y * gridDim.z;
    unsigned sum, cnt, mine, sp = 0u;
    for (;;) {
        sum = 0u; cnt = 0u; mine = 0u;
#pragma unroll
        for (unsigned j = 0; j < 16; ++j) { const unsigned c = xb_ld(&bar[XB_XCNT(j)]); sum += c; cnt += (c > 0u) ? 1u : 0u; mine = (j == x) ? c : mine; }
        if (sum == G) break;
        __builtin_amdgcn_s_sleep(1);
        if ((++sp & 255u) == 0u) { if (xb_ld(&bar[XB_TMO])) break; if (sp > XB_SPIN_CAP) { atomicAdd(&bar[XB_TMO], 1u); break; } }
    }
    nloc = mine > 0u ? mine : 1u; nx = cnt > 0u ? cnt : 1u;
}

__device__ __forceinline__ void xcd_barrier(const XcdBarrier& b) {
    asm volatile("s_waitcnt vmcnt(0)" ::: "memory");
    __syncthreads();
    if (b.w == 0 && lane_id() == 0) {
        unsigned* bar = b.bar;
        __builtin_amdgcn_s_waitcnt(0);
        unsigned nloc = b.st[0], nx = b.st[1];
        if (nloc == 0u) { xcd_barrier_complete(bar, b.x, nloc, nx); b.st[0] = nloc; b.st[1] = nx; }
        const unsigned old = xb_add(&bar[XB_XSUB(b.x)], 1u);
        const unsigned gen = old / nloc;
        if (old + 1u == (gen + 1u) * nloc) {
            __builtin_amdgcn_fence(__ATOMIC_RELEASE, "agent");
            asm volatile("s_waitcnt vmcnt(0)" ::: "memory");
            const unsigned og = xb_add(&bar[XB_TOP], 1u);
            const unsigned tg = og / nx;
            if (og + 1u == (tg + 1u) * nx) xb_add(&bar[XB_TOPGEN], 1u);
            else XB_SPIN(xb_ld(&bar[XB_TOPGEN]) == tg, bar);
            __builtin_amdgcn_fence(__ATOMIC_ACQUIRE, "agent");
            xb_add(&bar[XB_XGEN(b.x)], 1u);
            asm volatile("s_waitcnt vmcnt(0)" ::: "memory");
        } else {
            XB_SPIN(xb_ld(&bar[XB_XGEN(b.x)]) == gen, bar);
            __builtin_amdgcn_fence(__ATOMIC_ACQUIRE, "agent");
            asm volatile("s_waitcnt vmcnt(0)" ::: "memory");
        }
    }
    __syncthreads();
}


struct Args { const float* in[31]; float* out; unsigned char* ws; int ph_lo, ph_hi; };
enum { I_X = 0, I_C, I_CTX, I_CCTX, I_ADAW, I_ADAB, I_NORMG, I_WG, I_WU, I_WD, I_ABWIN, I_ABWOUT, I_DECAY, I_RETGN, I_GATEB, I_MLGN, I_CDWIN, I_CDWOUT,
       I_CONVW, I_CONVB, I_LWA, I_LBA, I_LWX, I_LBX, I_LAM, I_QNG, I_KVNG, I_WUQ, I_WUK, I_WUV, I_QKNG };

typedef pg8::f32x4 accv;
struct EpiUp {
    static constexpr bool PERM = true, AFTER_DRAIN = false;
    bf16* O;
    DI void operator()(const accv (&acc)[2][2][4][2], const pg8::Unit& u, int wr, int wc, int fr, int fq) const {
        const int row0 = u.pm * 256 + wr * 64 + fr, col0 = u.pn * 128 + wc * 32 + 8 * fq;
#pragma unroll
        for (int ai = 0; ai < 2; ++ai)
#pragma unroll
            for (int m = 0; m < 4; ++m) {
                const accv g0 = acc[ai][0][m][0], g1 = acc[ai][0][m][1], u0 = acc[ai][1][m][0], u1 = acc[ai][1][m][1];
                v4u w;
                w.x = pk2(siluf_(g0[0]) * u0[0], siluf_(g0[1]) * u0[1]); w.y = pk2(siluf_(g0[2]) * u0[2], siluf_(g0[3]) * u0[3]);
                w.z = pk2(siluf_(g1[0]) * u1[0], siluf_(g1[1]) * u1[1]); w.w = pk2(siluf_(g1[2]) * u1[2], siluf_(g1[3]) * u1[3]);
                *(v4u*)(O + (size_t)(row0 + ai * 128 + m * 16) * FF + col0) = w;
            }
    }
};
struct EpiResid {
    static constexpr bool PERM = false, AFTER_DRAIN = false;
    const float* inL; const float* inC; float* outL; float* outC; const float* gate  ; float scale;
    DI void operator()(const accv (&acc)[2][2][4][2], const pg8::Unit& u, int wr, int wc, int fr, int fq) const {
        const bool lat = u.pm < 64;
        const int rloc = (lat ? u.pm * 256 : (u.pm - 64) * 256) + wr * 64 + fr, col0 = u.pn * 256 + wc * 32 + 4 * fq;
        const int bidx = lat ? (u.pm >> 4) : 4;
        const float* ib = lat ? inL : inC; float* ob = lat ? outL : outC;
        accv gv[2][2];
#pragma unroll
        for (int bj = 0; bj < 2; ++bj)
#pragma unroll
            for (int n = 0; n < 2; ++n) gv[bj][n] = *(const accv*)(gate + (size_t)bidx * MODW + col0 + bj * 128 + n * 16) * scale;
#pragma unroll
        for (int ai = 0; ai < 2; ++ai) {
            accv xi[4][2][2];
#pragma unroll
            for (int m = 0; m < 4; ++m) { const size_t ro = (size_t)(rloc + ai * 128 + m * 16) * DM + col0;
#pragma unroll
                for (int bj = 0; bj < 2; ++bj)
#pragma unroll
                    for (int n = 0; n < 2; ++n) xi[m][bj][n] = *(const accv*)(ib + ro + bj * 128 + n * 16); }
            asm volatile("" ::: "memory");
#pragma unroll
            for (int m = 0; m < 4; ++m) { const size_t ro = (size_t)(rloc + ai * 128 + m * 16) * DM + col0;
#pragma unroll
                for (int bj = 0; bj < 2; ++bj)
#pragma unroll
                    for (int n = 0; n < 2; ++n) *(accv*)(ob + ro + bj * 128 + n * 16) = xi[m][bj][n] + gv[bj][n] * acc[ai][bj][m][n]; }
            asm volatile("" ::: "memory");
        }
    }
};
struct EpiPlain {
    static constexpr bool PERM = true, AFTER_DRAIN = false;
    bf16* O; int ldc; int ngelu;
    DI void operator()(const accv (&acc)[2][2][4][2], const pg8::Unit& u, int wr, int wc, int fr, int fq) const {
        const int row0 = u.pm * 256 + wr * 64 + fr, col0 = u.pn * 256 + wc * 32 + 8 * fq; const bool act = u.pn < ngelu;
#pragma unroll
        for (int ai = 0; ai < 2; ++ai)
#pragma unroll
            for (int m = 0; m < 4; ++m)
#pragma unroll
                for (int bj = 0; bj < 2; ++bj) {
                    accv v0 = acc[ai][bj][m][0], v1 = acc[ai][bj][m][1];
                    if (act) {
#pragma unroll
                        for (int e = 0; e < 4; ++e) { v0[e] = gelu_tanh(v0[e]); v1[e] = gelu_tanh(v1[e]); } }
                    v4u w; w.x = pk2(v0[0], v0[1]); w.y = pk2(v0[2], v0[3]); w.z = pk2(v1[0], v1[1]); w.w = pk2(v1[2], v1[3]);
                    *(v4u*)(O + (size_t)(row0 + ai * 128 + m * 16) * ldc + col0 + bj * 128) = w;
                }
    }
};
struct EpiProjAB {
    static constexpr bool PERM = true, AFTER_DRAIN = false;
    bf16* O; float* gates; const float* gate_b; const float* ropec; const float* ropes;
    DI void operator()(const accv (&acc)[2][2][4][2], const pg8::Unit& u, int wr, int wc, int fr, int fq) const {
        const int pn = u.pn, row0 = u.pm * 256 + wr * 64 + fr; const bool lat = u.pm < 64;
        if (pn == 24) {
            if (wc == 0 && fq < 2) {
                const accv b0 = *(const accv*)(gate_b + 8 * fq), b1 = *(const accv*)(gate_b + 8 * fq + 4);
#pragma unroll
                for (int ai = 0; ai < 2; ++ai)
#pragma unroll
                    for (int m = 0; m < 4; ++m) { float* gp = gates + (size_t)(row0 + ai * 128 + m * 16) * 16 + 8 * fq;
                        *(accv*)gp = acc[ai][0][m][0] + b0; *(accv*)(gp + 4) = acc[ai][0][m][1] + b1; }
            }
            return;
        }
        const bool rope = (pn < 4) && lat;
        const float sc = (pn == 2 || pn == 3 || pn == 12 || pn == 13) ? 0.08838834764831845f : 1.f;
        const int actk = (pn >= 8 && pn < 12) ? 1 : ((pn >= 20 && pn < 24) ? 2 : 0);
        const int col0 = pn * 256 + wc * 32 + 8 * fq;
        accv csv[2][4], snv[2][4];
#pragma unroll
        for (int ai = 0; ai < 2; ++ai)
#pragma unroll
            for (int m = 0; m < 4; ++m) { csv[ai][m] = (accv){1.f, 1.f, 1.f, 1.f}; snv[ai][m] = (accv){0.f, 0.f, 0.f, 0.f};
                if (rope) { const int pos = (row0 + ai * 128 + m * 16) & (SEQ - 1); csv[ai][m] = *(const accv*)(ropec + pos * 64 + 16 * wc + 4 * fq); snv[ai][m] = *(const accv*)(ropes + pos * 64 + 16 * wc + 4 * fq); } }
        asm volatile("" ::: "memory");
#pragma unroll
        for (int ai = 0; ai < 2; ++ai)
#pragma unroll
            for (int m = 0; m < 4; ++m) {
                const int row = row0 + ai * 128 + m * 16;
                const accv cs = csv[ai][m], sn = snv[ai][m];
#pragma unroll
                for (int bj = 0; bj < 2; ++bj) {
                    accv v0 = acc[ai][bj][m][0], v1 = acc[ai][bj][m][1];
                    if (rope) { const accv x1 = v0, x2 = v1; v0 = x1 * cs - x2 * sn; v1 = x1 * sn + x2 * cs; }
                    v0 = v0 * sc; v1 = v1 * sc;
                    if (actk == 1) {
#pragma unroll
                        for (int e = 0; e < 4; ++e) { v0[e] = siluf_(v0[e]); v1[e] = siluf_(v1[e]); } }
                    if (actk == 2) {
#pragma unroll
                        for (int e = 0; e < 4; ++e) { v0[e] = sigmoidf_(v0[e]); v1[e] = sigmoidf_(v1[e]); } }
                    v4u w; w.x = pk2(v0[0], v0[1]); w.y = pk2(v0[2], v0[3]); w.z = pk2(v1[0], v1[1]); w.w = pk2(v1[2], v1[3]);
                    *(v4u*)(O + (size_t)row * AB_LD + col0 + bj * 128) = w;
                }
            }
    }
};

struct EpiPartial {
    static constexpr bool PERM = false, AFTER_DRAIN = false;
    float* P;
    DI void operator()(const accv (&acc)[2][2][4][2], const pg8::Unit& u, int wr, int wc, int fr, int fq) const {
        const int row0 = u.pm * 256 + wr * 64 + fr, col0 = u.pn * 256 + wc * 32 + 4 * fq;
#pragma unroll
        for (int ai = 0; ai < 2; ++ai)
#pragma unroll
            for (int m = 0; m < 4; ++m) { float* rp = P + (size_t)(row0 + ai * 128 + m * 16) * DM + col0;
#pragma unroll
                for (int bj = 0; bj < 2; ++bj)
#pragma unroll
                    for (int n = 0; n < 2; ++n) *(accv*)(rp + bj * 128 + n * 16) = acc[ai][bj][m][n]; }
    }
};

template <bool P> struct EpiNull {
    static constexpr bool PERM = P, AFTER_DRAIN = false;
    float* O;
    DI void operator()(const accv (&acc)[2][2][4][2], const pg8::Unit& u, int wr, int wc, int fr, int fq) const {
        accv s = {0.f, 0.f, 0.f, 0.f};
#pragma unroll
        for (int ai = 0; ai < 2; ++ai)
#pragma unroll
            for (int bj = 0; bj < 2; ++bj)
#pragma unroll
                for (int m = 0; m < 4; ++m)
#pragma unroll
                    for (int n = 0; n < 2; ++n) s = s + acc[ai][bj][m][n];
        *(accv*)(O + (size_t)((wr * 4 + wc) * 64 + fq * 16 + fr) * 4) = s;
    }
};

struct Frame {
    LAS unsigned char* lds;
    int wave, G;
    const Args* a;
};
#define WSP(T, off) ((T*)(A.ws + (off)))
#define TID(F) ((F).wave * 64 + lane_id())

DI void cvt_item(const float* W, int ldw, int K, bf16* WT, int k0, int n0, int srcc, LAS float* scr, int lane) {
    const float* wp = W + (size_t)k0 * ldw + (srcc >= 0 ? srcc : 0);
#pragma unroll
    for (int i = 0; i < 32; ++i) { const int kk = 2 * i + (lane >> 5); scr[kk * 33 + (lane & 31)] = (srcc >= 0) ? wp[(size_t)kk * ldw] : 0.f; }
    LDS_WAIT(); asm volatile("" ::: "memory");
    const int c = lane & 7;
#pragma unroll
    for (int j = 0; j < 4; ++j) { const int n = (lane >> 3) + 8 * j; const LAS float* s = scr + (8 * c) * 33 + n;
        v4u o; o.x = pk2(s[0 * 33], s[1 * 33]); o.y = pk2(s[2 * 33], s[3 * 33]); o.z = pk2(s[4 * 33], s[5 * 33]); o.w = pk2(s[6 * 33], s[7 * 33]);
        *(v4u*)(WT + (size_t)(n0 + n) * K + k0 + 8 * c) = o; }
    LDS_WAIT(); asm volatile("" ::: "memory");
}
DI void cvt_item4(const float* W, int ldw, int K, bf16* WT, int k0, int n0, int srcc0, LAS float* scr, int lane) {
    const int kk8 = lane >> 3, n4 = lane & 7;
    const float* wp = W + (size_t)(k0 + kk8) * ldw + (srcc0 >= 0 ? srcc0 : 0) + 4 * n4;
    f32x4 v[8];
#pragma unroll
    for (int i = 0; i < 8; ++i) v[i] = (srcc0 >= 0) ? *(const f32x4*)(wp + (size_t)(8 * i) * ldw) : (f32x4){0.f, 0.f, 0.f, 0.f};
#pragma unroll
    for (int i = 0; i < 8; ++i) { LAS float* d = scr + (8 * i + kk8) * 33 + 4 * n4; d[0] = v[i].x; d[1] = v[i].y; d[2] = v[i].z; d[3] = v[i].w; }
    LDS_WAIT(); asm volatile("" ::: "memory");
    const int c = lane & 7;
#pragma unroll
    for (int j = 0; j < 4; ++j) { const int n = (lane >> 3) + 8 * j; const LAS float* s = scr + (8 * c) * 33 + n;
        v4u o; o.x = pk2(s[0 * 33], s[1 * 33]); o.y = pk2(s[2 * 33], s[3 * 33]); o.z = pk2(s[4 * 33], s[5 * 33]); o.w = pk2(s[6 * 33], s[7 * 33]);
        *(v4u*)(WT + (size_t)(n0 + n) * K + k0 + 8 * c) = o; }
    LDS_WAIT(); asm volatile("" ::: "memory");
}
DI int rope_src(int p) { const int e = p & 7, hi = (p >> 3) * 4; return e < 4 ? hi + e : 64 + hi + (e - 4); }

DI void phase_pre(const Frame& F, const Args& A, bool do_adaln) {
    const int lane = lane_id(), wave = F.wave, tid = wave * 64 + lane, G = F.G;
    {
        float* rc = WSP(float, WS_ROPEC); float* rs = WSP(float, WS_ROPES); float* ac = WSP(float, WS_AXC); float* as = WSP(float, WS_AXS);
        for (int i = blockIdx.x * NTHR + tid; i < SEQ * 64 + 64 * 16; i += G * NTHR) {
            int pos, k; float fr_;
            if (i < SEQ * 64) { pos = i >> 6; k = i & 63; fr_ = exp2f(-(float)k * (13.287712379549449f / 64.f)); }
            else { const int i2 = i - SEQ * 64; pos = i2 >> 4; k = i2 & 15; fr_ = exp2f(-(float)k * (13.287712379549449f / 16.f)); }
            const float ang = (float)pos * fr_;
            const double rev = (double)ang * 0.15915494309189535; const float fr2 = (float)(rev - rint(rev));
            const float s = __builtin_amdgcn_sinf(fr2), c = __builtin_amdgcn_cosf(fr2);
            if (i < SEQ * 64) { rc[i] = c; rs[i] = s; } else { ac[i - SEQ * 64] = c; as[i - SEQ * 64] = s; }
        }
    }
    if (do_adaln) {
        LAS float* sc = (LAS float*)F.lds;
        LAS float* red = (LAS float*)(F.lds + 40960);
        const float* cc = A.in[I_C]; const float* cx = A.in[I_CCTX];
        for (int i = tid; i < 5 * DM; i += NTHR) { const int r = i / DM, k = i % DM; const float v = r < 4 ? cc[r * DM + k] : cx[k]; sc[i] = siluf_(v); }
        __syncthreads();
        float* MOD = WSP(float, WS_MOD);
        for (int unit = blockIdx.x; unit < 576; unit += G) {
            const int kh = unit & 1, u2 = unit >> 1, l = u2 / 144, n0 = (u2 % 144) * 128;
            const float* W = A.in[I_ADAW] + (size_t)l * DM * MODW + n0 + 2 * lane;
            float acc[5][2];
#pragma unroll
            for (int r = 0; r < 5; ++r) { acc[r][0] = 0.f; acc[r][1] = 0.f; }
            const int kb = kh * 1024 + wave * 128;
#pragma unroll 16
            for (int k = 0; k < 128; ++k) {
                const f32x2 w = *(const f32x2*)(W + (size_t)(kb + k) * MODW);
#pragma unroll
                for (int r = 0; r < 5; ++r) { const float s = sc[r * DM + kb + k]; acc[r][0] += s * w.x; acc[r][1] += s * w.y; }
            }
#pragma unroll
            for (int r = 0; r < 5; ++r) { red[(wave * 5 + r) * 128 + 2 * lane] = acc[r][0]; red[(wave * 5 + r) * 128 + 2 * lane + 1] = acc[r][1]; }
            __syncthreads();
            for (int i = tid; i < 640; i += NTHR) { const int r = i >> 7, c = i & 127; float s = kh ? 0.f : A.in[I_ADAB][l * MODW + n0 + c];
#pragma unroll
                for (int w = 0; w < 8; ++w) s += red[(w * 5 + r) * 128 + c];
                atomicAdd(&MOD[(size_t)(l * 5 + r) * MODW + n0 + c], s); }
            __syncthreads();
        }
    }
    {
        LAS float* scr = (LAS float*)(F.lds + wave * 8448);
        const int gw = blockIdx.x * NWAVES + wave, NGW = G * NWAVES;
        constexpr int I_GU = 32 * (NGU / 32), I_D = (FF / 64) * (DM / 32), I_ABI = 32 * (AB_N / 32), I_SQ = 32 * 64, I_CDI = 32 * (CD_N / 32), I_UQ = 8 * 48, I_UKV = 4 * 64, I_LW = 2 * 4;
        constexpr int NITEMS = 4 * I_GU + 4 * I_D + I_ABI + I_SQ + I_CDI + I_SQ + I_UQ + I_UKV + 32 * I_LW;
        for (int it = gw; it < NITEMS; it += NGW) {
            int r = it;
            if (r < 4 * I_GU) { const int q = r / I_GU; r -= q * I_GU; const int nbk = NGU / 32, kb = r / nbk, nb = r % nbk;
                const float* W = (((32 * nb) & 255) < 128 ? A.in[I_WG] : A.in[I_WU]) + (size_t)q * DM * FF;
                cvt_item4(W, FF, DM, WSP(bf16, WS_WGU) + (size_t)q * NGU * DM, 64 * kb, 32 * nb, (nb >> 3) * 128 + ((32 * nb) & 127), scr, lane); continue; }
            r -= 4 * I_GU;
            if (r < 4 * I_D) { const int q = r / I_D; r -= q * I_D; const int nbk = DM / 32, kb = r / nbk, nb = r % nbk;
                cvt_item4(A.in[I_WD] + (size_t)q * FF * DM, DM, FF, WSP(bf16, WS_WD) + (size_t)q * DM * FF, 64 * kb, 32 * nb, 32 * nb, scr, lane); continue; }
            r -= 4 * I_D;
            if (r < I_ABI) { const int nbk = AB_N / 32, kb = r / nbk, nb = r % nbk, R = 32 * nb + (lane & 31), tile = R >> 8;
                int src = R;
                if (tile < 4 || (tile >= 12 && tile < 16)) src = (R & ~127) + rope_src(R & 127);
                if (R >= 6160) src = -1;
                cvt_item(A.in[I_ABWIN], 6160, DM, WSP(bf16, WS_ABWIN), 64 * kb, 32 * nb, src, scr, lane); continue; }
            r -= I_ABI;
            if (r < I_SQ) { const int kb = r / 64, nb = r % 64; cvt_item4(A.in[I_ABWOUT], DM, DM, WSP(bf16, WS_ABWOUT), 64 * kb, 32 * nb, 32 * nb, scr, lane); continue; }
            r -= I_SQ;
            if (r < I_CDI) { const int nbk = CD_N / 32, kb = r / nbk, nb = r % nbk, R = 32 * nb + (lane & 31);
                cvt_item4(A.in[I_CDWIN], 2880, DM, WSP(bf16, WS_CDWIN), 64 * kb, 32 * nb, 32 * nb < 2880 ? 32 * nb : -1, scr, lane); continue; }
            r -= I_CDI;
            if (r < I_SQ) { const int kb = r / 64, nb = r % 64; cvt_item4(A.in[I_CDWOUT], DM, DM, WSP(bf16, WS_CDWOUT), 64 * kb, 32 * nb, 32 * nb, scr, lane); continue; }
            r -= I_SQ;
            if (r < I_UQ) { const int kb = r / 48, nb = r % 48; cvt_item4(A.in[I_WUQ], 1536, 512, WSP(bf16, WS_WUQ), 64 * kb, 32 * nb, 32 * nb, scr, lane); continue; }
            r -= I_UQ;
            if (r < I_UKV) { const int kb = r / 64, nb = r % 64, R = 32 * nb + (lane & 31);
                cvt_item4(nb < 32 ? A.in[I_WUK] : A.in[I_WUV], 1024, 256, WSP(bf16, WS_WUKV), 64 * kb, 32 * nb, (32 * nb) & 1023, scr, lane); continue; }
            r -= I_UKV;
            { const int mg = r / I_LW; r -= mg * I_LW; const int mat = mg >> 3, g = mg & 7, kb = r / 4, nb = r % 4;
              const float* W = ((mat & 1) ? A.in[I_LWX] : A.in[I_LWA]) + (size_t)((mat >> 1) * 8 + g) * 128 * 128;
              cvt_item4(W, 128, 128, WSP(bf16, WS_LWT) + (size_t)mg * 128 * 128, 64 * kb, 32 * nb, 32 * nb, scr, lane); }
        }
    }
}

struct CtxFix { const float* cin; const float* part; const float* gate; float scale; };
DI void phase_norm(const Frame& F, const Args& A, int l, int which, int nrows, bool first, const CtxFix cf) {
    const int lane = lane_id(), gw = blockIdx.x * NWAVES + F.wave, NGW = F.G * NWAVES;
    const f32x4* gn = (const f32x4*)(A.in[I_NORMG] + (size_t)(l * 3 + which) * DM);
    const float* XL = first ? A.in[I_X] : A.out; const float* XC = first ? A.in[I_CTX] : WSP(float, WS_XC);
    const float* MOD = WSP(float, WS_MOD); bf16* XN = WSP(bf16, WS_XN);
    f32x4 g[8];
#pragma unroll
    for (int j = 0; j < 4; ++j) { g[2 * j] = gn[2 * lane + 128 * j]; g[2 * j + 1] = gn[2 * lane + 128 * j + 1]; }
    f32x4 nv[8];
#define NORM_SIMPLE(r_) ((r_) < ML || cf.part == nullptr)
#define NORM_LOAD(r_) do { const f32x4* xr_ = (const f32x4*)((r_) < ML ? XL + (size_t)(r_) * DM : XC + (size_t)((r_) - ML) * DM) + 2 * lane; _Pragma("unroll") for (int j = 0; j < 4; ++j) { nv[2 * j] = xr_[128 * j]; nv[2 * j + 1] = xr_[128 * j + 1]; } } while (0)
    if (gw < nrows && NORM_SIMPLE(gw)) NORM_LOAD(gw);
    for (int row = gw; row < nrows; row += NGW) {
        const bool lat = row < ML;
        const int bidx = lat ? (row >> 12) : 4;
        const f32x4* shp = (const f32x4*)(MOD + (size_t)(l * 5 + bidx) * MODW + (3 * which) * DM) + 2 * lane; const f32x4* scp = shp + DM / 4;
        f32x4 v[8]; float ss = 0.f;
        if (NORM_SIMPLE(row)) {
#pragma unroll
            for (int j = 0; j < 8; ++j) v[j] = nv[j];
        } else {
            const size_t ro = (size_t)(row - ML) * DM; const f32x4* xr = (const f32x4*)(cf.cin + ro) + 2 * lane; const f32x4* gt = (const f32x4*)cf.gate + 2 * lane;
            f32x4* xo = (f32x4*)(WSP(float, WS_XC) + ro) + 2 * lane;
#pragma unroll
            for (int j = 0; j < 8; ++j) { const int o = 128 * (j >> 1) + (j & 1); f32x4 s = *((const f32x4*)(cf.part + ro) + 2 * lane + o);
#pragma unroll
                for (int k = 1; k < 8; ++k) s = s + *((const f32x4*)(cf.part + (size_t)k * MC * DM + ro) + 2 * lane + o);
                v[j] = xr[o] + gt[o] * s * cf.scale; }
            asm volatile("" ::: "memory");
#pragma unroll
            for (int j = 0; j < 8; ++j) xo[128 * (j >> 1) + (j & 1)] = v[j];
        }
        { const int nr = row + NGW; if (nr < nrows && NORM_SIMPLE(nr)) NORM_LOAD(nr); }
#pragma unroll
        for (int j = 0; j < 8; ++j) ss += (v[j].x * v[j].x + v[j].y * v[j].y) + (v[j].z * v[j].z + v[j].w * v[j].w);
        const float rs = __frsqrt_rn(wave_sum(ss) * (1.f / DM) + EPS);
        v4u* o16 = (v4u*)(XN + (size_t)row * DM) + lane;
        f32x4 cs_[8], ch_[8];
#pragma unroll
        for (int j = 0; j < 4; ++j) { cs_[2 * j] = scp[128 * j]; cs_[2 * j + 1] = scp[128 * j + 1]; ch_[2 * j] = shp[128 * j]; ch_[2 * j + 1] = shp[128 * j + 1]; }
        asm volatile("" ::: "memory");
#pragma unroll
        for (int j = 0; j < 4; ++j) { const f32x4 y0 = (v[2 * j] * rs) * g[2 * j] * (cs_[2 * j] + 1.f) + ch_[2 * j], y1 = (v[2 * j + 1] * rs) * g[2 * j + 1] * (cs_[2 * j + 1] + 1.f) + ch_[2 * j + 1];
            v4u w; w.x = pk2(y0.x, y0.y); w.y = pk2(y0.z, y0.w); w.z = pk2(y1.x, y1.y); w.w = pk2(y1.z, y1.w); o16[64 * j] = w; }
    }
#undef NORM_SIMPLE
#undef NORM_LOAD
}

DI int chunk_row0(int b, int j) { return j < 2 ? ML + b * CTXL + 128 * j : b * SEQ + 128 * (j - 2); }
DI int us_slot(int b, int h, int mx, int j, int d) { return ((((b * 4 + h) * 2 + mx) * NCH + j) * 2 + d); }
DI int sc_idx(int b, int h, int d, int j) { return ((b * 4 + h) * 2 + d) * NCH + j; }
constexpr int LV_STRIDE = 544, LK_STRIDE = 272, LKT_STRIDE = 288;
DI void mlstm_gate_scan(const float* gates, int R0, int h, int d, int lane, float (&Av)[2], float (&Bv)[2], int (&cpos)[2], float& blast) {
    float iv[2], lf[2];
#pragma unroll
    for (int t = 0; t < 2; ++t) { const int e = 2 * lane + t; cpos[t] = d ? 127 - e : e; const float* g = gates + (size_t)(R0 + cpos[t]) * 16 + d * 8 + h; iv[t] = g[0]; lf[t] = logsigf_(g[4]); }
    float s = lf[0] + lf[1], inc = s;
#pragma unroll
    for (int o = 1; o < 64; o <<= 1) { const float t = __shfl_up(inc, o); if (lane >= o) inc += t; }
    const float exc = inc - s;
    Bv[0] = exc + lf[0]; Bv[1] = exc + s; Av[0] = iv[0] - Bv[0]; Av[1] = iv[1] - Bv[1];
    blast = __shfl(inc, 63);
}

DI void phase_m1(const Frame& F, const Args& A) {
    const int lane = lane_id(), wave = F.wave, tid = wave * 64 + lane, r16 = lane & 15, q4 = lane >> 4;
    LAS unsigned char* LV = F.lds; LAS unsigned char* LKf = F.lds + 71680; LAS unsigned char* LKb = LKf + 36864;
    LAS float* TW = (LAS float*)(LKb + 36864);
    const bf16* PROJ = WSP(bf16, WS_BIG); const float* GATES = WSP(float, WS_GATES); bf16* U = WSP(bf16, WS_A); float* SCAL = WSP(float, WS_SCAL);
    for (int unit = blockIdx.x; unit < NB * 4 * 2 * NCH; unit += F.G) {
        const int j = unit % NCH, t_ = unit / NCH, mx = t_ & 1, h = (t_ >> 1) & 3, b = t_ >> 3;
        const int R0 = chunk_row0(b, j);
        const int kcol = mx ? 3584 + 128 * h : 512 + 128 * h, vcol = mx ? 4096 + 256 * h : 1024 + 256 * h;
        v4u kst[4], vst[8];
#pragma unroll
        for (int x = 0; x < 8; ++x) { const int i = tid + NTHR * x, rr = i >> 5, c = i & 31; vst[x] = *(const v4u*)(PROJ + (size_t)(R0 + rr) * AB_LD + vcol + 8 * c); }
#pragma unroll
        for (int x = 0; x < 4; ++x) { const int i = tid + NTHR * x, rr = i >> 4, c = i & 15; kst[x] = *(const v4u*)(PROJ + (size_t)(R0 + rr) * AB_LD + kcol + 8 * c); }
        asm volatile("" ::: "memory");
        if (mx == 0) {
            if (tid < 128) { const float lgf = logsigf_(A.in[I_DECAY][h]), lgb = logsigf_(A.in[I_DECAY][4 + h]); TW[tid] = __expf((float)(127 - tid) * lgf); TW[128 + tid] = __expf((float)tid * lgb); }
        } else if (wave < 2) {
            const int d = wave; float Av[2], Bv[2], blast; int cp[2];
            mlstm_gate_scan(GATES, R0, h, d, lane, Av, Bv, cp, blast);
            const float mA = wave_max(fmaxf(Av[0], Av[1]));
            TW[d * 128 + cp[0]] = __expf(Av[0] - mA); TW[d * 128 + cp[1]] = __expf(Av[1] - mA);
            if (lane == 0) { SCAL[sc_idx(b, h, d, j)] = blast + mA; SCAL[2048 + sc_idx(b, h, d, j)] = blast; }
        }
        __syncthreads();
#pragma unroll
        for (int x = 0; x < 8; ++x) { const int i = tid + NTHR * x, rr = i >> 5, c = i & 31; *(LAS v4u*)(LV + rr * LV_STRIDE + c * 16) = vst[x]; }
        if (tid < 128) { unsigned z0 = 0u; asm volatile("" : "+v"(z0)); v4u one = {z0 + 0x3F80u, z0, z0, z0}, zero = {z0, z0, z0, z0}; *(LAS v4u*)(LV + tid * LV_STRIDE + 512) = one; *(LAS v4u*)(LV + tid * LV_STRIDE + 528) = zero; }
#pragma unroll
        for (int x = 0; x < 4; ++x) { const int i = tid + NTHR * x, rr = i >> 4, c = i & 15; const v4u kv = kst[x];
            const float wf = TW[rr], wb = TW[128 + rr]; v4u of, ob;
            of.x = pk2(bflo(kv.x) * wf, bfhi(kv.x) * wf); of.y = pk2(bflo(kv.y) * wf, bfhi(kv.y) * wf); of.z = pk2(bflo(kv.z) * wf, bfhi(kv.z) * wf); of.w = pk2(bflo(kv.w) * wf, bfhi(kv.w) * wf);
            ob.x = pk2(bflo(kv.x) * wb, bfhi(kv.x) * wb); ob.y = pk2(bflo(kv.y) * wb, bfhi(kv.y) * wb); ob.z = pk2(bflo(kv.z) * wb, bfhi(kv.z) * wb); ob.w = pk2(bflo(kv.w) * wb, bfhi(kv.w) * wb);
            *(LAS v4u*)(LKf + rr * LKT_STRIDE + c * 16) = of; *(LAS v4u*)(LKb + rr * LKT_STRIDE + c * 16) = ob; }
        __syncthreads();
#pragma unroll 1
        for (int d = 0; d < 2; ++d) {
            const LAS unsigned char* LK = d ? LKb : LKf;
            f32x4 acc[17];
#pragma unroll
            for (int c = 0; c < 17; ++c) acc[c] = (f32x4){0.f, 0.f, 0.f, 0.f};
            bf16x8 ka[2], vb[2][17];
#define M1_LOAD(buf_, s_) do { ka[buf_] = frag_tr(LK, LKT_STRIDE, 32 * (s_) + 8 * q4, 32 * (s_) + 8 * q4 + 4, 16 * wave, lane); \
                _Pragma("unroll") for (int c = 0; c < 17; ++c) vb[buf_][c] = frag_tr(LV, LV_STRIDE, 32 * (s_) + 8 * q4, 32 * (s_) + 8 * q4 + 4, 16 * c, lane); } while (0)
            M1_LOAD(0, 0);
#pragma unroll
            for (int s = 0; s < 4; ++s) {
                if (s < 3) M1_LOAD((s + 1) & 1, s + 1);
#pragma unroll
                for (int c = 0; c < 17; ++c) acc[c] = mfma16(ka[s & 1], vb[s & 1][c], acc[c]);
                __builtin_amdgcn_sched_barrier(0);
            }
#undef M1_LOAD
            bf16* Ub = U + (size_t)us_slot(b, h, mx, j, d) * USLOT;
#pragma unroll
            for (int c = 0; c < 17; ++c) { v2u w; w.x = pk2(acc[c][0], acc[c][1]); w.y = pk2(acc[c][2], acc[c][3]); *(v2u*)(Ub + (16 * c + r16) * 128 + 16 * wave + 4 * q4) = w; }
        }
        __syncthreads();
    }
}

DI void phase_m2(const Frame& F, const Args& A) {
    const v4u* U = WSP(const v4u, WS_A); v4u* S = WSP(v4u, WS_B); float* SCAL = WSP(float, WS_SCAL);
    constexpr int V8 = USLOT / 8, NIT = 64 * V8, NI = 3;
    const int t0 = blockIdx.x * NTHR + TID(F), NT = F.G * NTHR;
    float st[NI][8], m[NI], aret[NI]; int seqb[NI], e8[NI], dd[NI], mxx[NI], scb[NI]; bool ok[NI];
#pragma unroll
    for (int ii = 0; ii < NI; ++ii) { const int it = t0 + ii * NT; ok[ii] = it < NIT; const int itc = ok[ii] ? it : 0;
        const int seq = itc / V8; e8[ii] = itc % V8; const int d = seq & 1, mx = (seq >> 1) & 1, h = (seq >> 2) & 3, b = seq >> 4;
        dd[ii] = d; mxx[ii] = mx; seqb[ii] = (((b * 4 + h) * 2 + mx) * NCH) * 2 + d; scb[ii] = ((b * 4 + h) * 2 + d) * NCH; m[ii] = -1e30f;
        aret[ii] = __expf(128.f * logsigf_(A.in[I_DECAY][d * 4 + h]));
#pragma unroll
        for (int e = 0; e < 8; ++e) st[ii][e] = 0.f; }
#define M2_J(dir_, k_) ((dir_) ? ((k_) == 0 ? 1 : ((k_) == 1 ? 0 : 35 - (k_))) : (k_))
    v4u un[NI]; float mln[NI], bln[NI];
#pragma unroll
    for (int ii = 0; ii < NI; ++ii) { mln[ii] = 0.f; bln[ii] = 0.f; if (ok[ii]) { const int j0 = M2_J(dd[ii], 0); un[ii] = U[(size_t)(seqb[ii] + 2 * j0) * V8 + e8[ii]]; if (mxx[ii]) { mln[ii] = SCAL[scb[ii] + j0]; bln[ii] = SCAL[2048 + scb[ii] + j0]; } } }
#pragma unroll 1
    for (int k = 0; k < NCH; ++k) {
        v4u u[NI]; float mlc[NI], blc[NI];
#pragma unroll
        for (int ii = 0; ii < NI; ++ii) { u[ii] = un[ii]; mlc[ii] = mln[ii]; blc[ii] = bln[ii];
            if (ok[ii] && k + 1 < NCH) { const int j1 = M2_J(dd[ii], k + 1); un[ii] = U[(size_t)(seqb[ii] + 2 * j1) * V8 + e8[ii]]; if (mxx[ii]) { mln[ii] = SCAL[scb[ii] + j1]; bln[ii] = SCAL[2048 + scb[ii] + j1]; } } }
#pragma unroll
        for (int ii = 0; ii < NI; ++ii) if (ok[ii]) {
            const int j = M2_J(dd[ii], k); const size_t slot = (size_t)(seqb[ii] + 2 * j) * V8 + e8[ii];
            float a = aret[ii], g = 1.f;
            if (mxx[ii]) { const int si = scb[ii] + j; const float ml = mlc[ii], bl = blc[ii]; const float mn = fmaxf(bl + m[ii], ml);
                a = __expf(bl + m[ii] - mn); g = __expf(ml - mn); if (e8[ii] == 0) SCAL[4096 + si] = m[ii]; m[ii] = mn; }
            v4u o; o.x = pk2(st[ii][0], st[ii][1]); o.y = pk2(st[ii][2], st[ii][3]); o.z = pk2(st[ii][4], st[ii][5]); o.w = pk2(st[ii][6], st[ii][7]); S[slot] = o;
            st[ii][0] = a * st[ii][0] + g * bflo(u[ii].x); st[ii][1] = a * st[ii][1] + g * bfhi(u[ii].x); st[ii][2] = a * st[ii][2] + g * bflo(u[ii].y); st[ii][3] = a * st[ii][3] + g * bfhi(u[ii].y);
            st[ii][4] = a * st[ii][4] + g * bflo(u[ii].z); st[ii][5] = a * st[ii][5] + g * bfhi(u[ii].z); st[ii][6] = a * st[ii][6] + g * bflo(u[ii].w); st[ii][7] = a * st[ii][7] + g * bfhi(u[ii].w);
        }
    }
#undef M2_J
}

template <int MX, int VAR = 0> DI void m3_unit(const Frame& F, const Args& A, int b, int h, int j, bf16* MRG) {
    const int tid = TID(F);
    const int lane = tid & 63, wave = F.wave, r16 = lane & 15, q4 = lane >> 4;
    LAS unsigned char* LV = F.lds; LAS unsigned char* LS = F.lds + 71680;
    LAS float* TB = (LAS float*)(F.lds + 71680 + 73984);
    const bf16* PROJ = WSP(bf16, WS_BIG); const v4u* S = WSP(const v4u, WS_B);
    constexpr int mx = MX;
    const int R0 = chunk_row0(b, j);
    const int qcol = mx ? 3072 + 128 * h : 128 * h, kcol = mx ? 3584 + 128 * h : 512 + 128 * h, vcol = mx ? 4096 + 256 * h : 1024 + 256 * h, gcol = mx ? 5120 + 256 * h : 2048 + 256 * h;
    const float lgf = logsigf_(A.in[I_DECAY][h]), lgb = logsigf_(A.in[I_DECAY][4 + h]);
    const int myq = 16 * wave + r16;
    v4u kst[4], vst[8]; bf16x8 qf[4];
#pragma unroll
    for (int x = 0; x < 4; ++x) { const int i = tid + NTHR * x, rr = i >> 4, c = i & 15; kst[x] = *(const v4u*)(PROJ + (size_t)(R0 + rr) * AB_LD + kcol + 8 * c); }
#pragma unroll
    for (int x = 0; x < 8; ++x) { const int i = tid + NTHR * x, rr = i >> 5, c = i & 31; vst[x] = *(const v4u*)(PROJ + (size_t)(R0 + rr) * AB_LD + vcol + 8 * c); }
#pragma unroll
    for (int s = 0; s < 4; ++s) qf[s] = *(const bf16x8*)(PROJ + (size_t)(R0 + myq) * AB_LD + qcol + 32 * s + 8 * q4);
    asm volatile("" ::: "memory");
    if (mx == 0) {
        if (tid < 128) { TB[3 * 128 + tid] = __expf((float)(tid + 1) * lgf); TB[(4 + 3) * 128 + tid] = __expf((float)(128 - tid) * lgb); }
    } else if (wave < 2) {
        const int d = wave; float Av[2], Bv[2], blast; int cp[2];
        mlstm_gate_scan(WSP(float, WS_GATES), R0, h, d, lane, Av, Bv, cp, blast);
        const float mprev = WSP(float, WS_SCAL)[4096 + sc_idx(b, h, d, j)];
        float inc = fmaxf(Av[0], Av[1]);
#pragma unroll
        for (int o = 1; o < 64; o <<= 1) { const float t = __shfl_up(inc, o); if (lane >= o) inc = fmaxf(inc, t); }
        float prev = __shfl_up(inc, 1); if (lane == 0) prev = -3.0e38f;
        const float rm0 = fmaxf(prev, Av[0]), rm1 = inc;
        const float M0 = fmaxf(mprev, rm0), M1 = fmaxf(mprev, rm1);
        LAS float* T = TB + d * 4 * 128;
        T[cp[0]] = Av[0]; T[cp[1]] = Av[1]; T[128 + cp[0]] = M0; T[128 + cp[1]] = M1; T[256 + cp[0]] = Bv[0]; T[256 + cp[1]] = Bv[1];
        T[384 + cp[0]] = __expf(mprev - M0); T[384 + cp[1]] = __expf(mprev - M1);
    }
#pragma unroll
    for (int x = 0; x < 4; ++x) { const int i = tid + NTHR * x, rr = i >> 4, c = i & 15; *(LAS v4u*)(LS + rr * LK_STRIDE + c * 16) = kst[x]; }
#pragma unroll
    for (int x = 0; x < 8; ++x) { const int i = tid + NTHR * x, rr = i >> 5, c = i & 31; *(LAS v4u*)(LV + rr * LV_STRIDE + c * 16) = vst[x]; }
    if (tid < 128) { unsigned z0 = 0u; asm volatile("" : "+v"(z0)); v4u one = {z0 + 0x3F80u, z0, z0, z0}, zero = {z0, z0, z0, z0}; *(LAS v4u*)(LV + tid * LV_STRIDE + 512) = one; *(LAS v4u*)(LV + tid * LV_STRIDE + 528) = zero; }
    const unsigned ls_lds = (unsigned)(size_t)LS;
#define M3_DMA_S(d_, hi_) do { const v4u* Sp_ = S + (size_t)us_slot(b, h, mx, j, (d_)) * (USLOT / 8); const int p0_ = (hi_) ? 2176 : 0, lim_ = (hi_) ? 4624 : 2176; \
        _Pragma("unroll 1") for (int ins = wave; ins < ((hi_) ? 39 : 34); ins += 8) { { const int p = p0_ + ins * 64 + lane; if (p < lim_) { const int rr = p / 17, c0_ = p - rr * 17, c = c0_ == 16 ? 0 : c0_; \
            glds16(Sp_ + rr * 16 + c, ls_lds + (unsigned)(p0_ + ins * 64) * 16u); } } } } while (0)
    __syncthreads();
    asm volatile("" : "+v"(qf[0]), "+v"(qf[1]), "+v"(qf[2]), "+v"(qf[3]));
    if (!(VAR & 1)) M3_DMA_S(0, 1);
    f32x4 sc[8];
#pragma unroll
    for (int c = 0; c < 8; ++c) { sc[c] = (f32x4){0.f, 0.f, 0.f, 0.f};
#pragma unroll
        for (int s = 0; s < 4; ++s) sc[c] = mfma16(frag_row(LS, LK_STRIDE, 16 * c, 32 * s, lane), qf[s], sc[c]); }
    f32x4 hs[16];
    { float z0 = 0.f; asm volatile("" : "+v"(z0), "+v"(sc[7][3]));
#pragma unroll
      for (int c = 0; c < 16; ++c) hs[c] = (f32x4){z0, z0, z0, z0}; }
    asm volatile("s_waitcnt vmcnt(0)" ::: "memory");
    __syncthreads();
#pragma unroll 1
    for (int d = 0; d < 2; ++d) {
        const LAS float* T = TB + d * 4 * 128;
        const float sdq = T[384 + myq], Mq = mx ? T[128 + myq] : 0.f, Bq = mx ? T[256 + myq] : 0.f;
        const float lg2 = (d ? lgb : lgf) * 1.4426950408889634f;
        float inv = 1.f;
#pragma unroll
        for (int half = 0; half < 2; ++half) {
            constexpr int NTL[2] = {9, 8}; const int c0 = half ? 0 : 8;
            if (!(VAR & 1)) { if (half == 0) M3_DMA_S(d, 0); else if (d == 0) M3_DMA_S(1, 1); }
            int myq_d = myq, q4_d = q4; float sdq_d = sdq; asm volatile("" : "+v"(myq_d), "+v"(q4_d), "+v"(sdq_d));
            f32x4 acc[9];
#pragma unroll
            for (int c = 0; c < 9; ++c) acc[c] = (f32x4){0.f, 0.f, 0.f, 0.f};
#pragma unroll
            for (int s = 0; s < ((VAR & 2) ? 0 : 4); ++s) {
                float pv[8];
#pragma unroll
                for (int jj = 0; jj < 8; ++jj) { const int c = 2 * s + (jj >> 2), i = jj & 3, key = 16 * c + 4 * q4_d + i;
                    const bool valid = d ? (key >= myq_d) : (key <= myq_d);
                    float w;
                    if (mx == 0) w = __builtin_amdgcn_exp2f((float)(d ? key - myq_d : myq_d - key) * lg2); else w = __expf(T[key] - Mq);
                    pv[jj] = valid ? sc[c][i] * w : 0.f; }
                v4u pw; pw.x = pk2(pv[0], pv[1]); pw.y = pk2(pv[2], pv[3]); pw.z = pk2(pv[4], pv[5]); pw.w = pk2(pv[6], pv[7]);
                const bf16x8 pf = __builtin_bit_cast(bf16x8, pw);
                const v4u qw = __builtin_bit_cast(v4u, qf[s]); v4u qs;
                qs.x = pk2(bflo(qw.x) * sdq_d, bfhi(qw.x) * sdq_d); qs.y = pk2(bflo(qw.y) * sdq_d, bfhi(qw.y) * sdq_d); qs.z = pk2(bflo(qw.z) * sdq_d, bfhi(qw.z) * sdq_d); qs.w = pk2(bflo(qw.w) * sdq_d, bfhi(qw.w) * sdq_d);
                const bf16x8 qd = __builtin_bit_cast(bf16x8, qs);
#pragma unroll
                for (int c = 0; c < NTL[half]; ++c) {
                    acc[c] = mfma16(frag_tr(LV, LV_STRIDE, 32 * s + 4 * q4, 32 * s + 16 + 4 * q4, 16 * (c0 + c), lane), pf, acc[c]);
                    acc[c] = mfma16(frag_row(LS, LK_STRIDE, 16 * (c0 + c), 32 * s, lane), qd, acc[c]);
                    if (c % 2 == 1) __builtin_amdgcn_sched_barrier(0);
                }
                __builtin_amdgcn_sched_barrier(0);
            }
            if (half == 0 && mx == 1) { const float den = __shfl(acc[8][0], r16);
                inv = 1.f / fmaxf(fabsf(den), __expf(-(Bq + Mq))); }
#pragma unroll
            for (int c = 0; c < 8; ++c) hs[c0 + c] = hs[c0 + c] + acc[c] * inv;
            asm volatile("s_waitcnt vmcnt(0)" ::: "memory");
            __syncthreads();
        }
    }
#undef M3_DMA_S
    float s1 = 0.f;
#pragma unroll
    for (int c = 0; c < 16; ++c) s1 += (hs[c][0] + hs[c][1]) + (hs[c][2] + hs[c][3]);
    s1 += __shfl_xor(s1, 16); s1 += __shfl_xor(s1, 32);
    const float mu = s1 * (1.f / 256.f); float s2 = 0.f;
#pragma unroll
    for (int c = 0; c < 16; ++c) { const f32x4 dd = hs[c] - mu; s2 += (dd[0] * dd[0] + dd[1] * dd[1]) + (dd[2] * dd[2] + dd[3] * dd[3]); }
    s2 += __shfl_xor(s2, 16); s2 += __shfl_xor(s2, 32);
    const float rstd = __frsqrt_rn(s2 * (1.f / 256.f) + EPS);
    const float* gn = (mx ? A.in[I_MLGN] : A.in[I_RETGN]) + h * 256;
    const size_t row = (size_t)(R0 + myq);
    v2u gwv[16]; f32x4 gnv[16];
#pragma unroll
    for (int c = 0; c < 16; ++c) { gwv[c] = *(const v2u*)(PROJ + row * AB_LD + gcol + 16 * c + 4 * q4); gnv[c] = *(const f32x4*)(gn + 16 * c + 4 * q4); }
    asm volatile("" ::: "memory");
#pragma unroll
    for (int c = 0; c < ((VAR & 8) ? 1 : 16); ++c) { const int dv = 16 * c + 4 * q4;
        const f32x4 g4 = gnv[c]; const v2u gw = gwv[c];
        const f32x4 y = (hs[c] - mu) * rstd * g4;
        v2u w; w.x = pk2(y[0] * bflo(gw.x), y[1] * bfhi(gw.x)); w.y = pk2(y[2] * bflo(gw.y), y[3] * bfhi(gw.y));
        *(v2u*)(MRG + row * DM + mx * 1024 + h * 256 + dv) = w; }
}
template <int VAR> DI void phase_m3(const Frame& F, const Args& A, bf16* MRG) {
    for (int unit = blockIdx.x; unit < NB * 4 * NCH; unit += F.G) { const int j = unit % NCH, t_ = unit / NCH; m3_unit<0, VAR>(F, A, t_ >> 2, t_ & 3, j, MRG); }
    for (int unit = blockIdx.x; unit < NB * 4 * NCH; unit += F.G) { const int j = unit % NCH, t_ = unit / NCH; m3_unit<1, VAR>(F, A, t_ >> 2, t_ & 3, j, MRG); }
}

template <bool FINAL> DI void phase_lru(const Frame& F, const Args& A) {
    LAS unsigned char* LXB = F.lds;
    LAS float* LXF = (LAS float*)(F.lds + 35904);
    LAS unsigned char* LXL = F.lds + 35904 + 67584;
    const bf16* P2 = WSP(bf16, WS_BIG); const bf16* LWT = WSP(bf16, WS_LWT); float* AGG = WSP(float, WS_AGG); bf16* MRG = WSP(bf16, WS_XN);
    for (int unit = blockIdx.x; unit < NB * NCH * 8; unit += F.G) {
        const int g = unit & 7, bj_ = unit >> 3, j = bj_ % NCH, b = bj_ / NCH;
        if (FINAL && j < 2) continue;
        const int tid = TID(F);
        const int lane = tid & 63, wave = F.wave, r16 = lane & 15, q4 = lane >> 4;
        const int R0 = chunk_row0(b, j), seq0 = j < 2 ? ML + b * CTXL : b * SEQ, seqlen = j < 2 ? CTXL : SEQ, t0 = R0 - seq0;
        for (int i = tid; i < 131 * 16; i += NTHR) { const int rr = i >> 4, c = i & 15, t = t0 - 2 + rr; v4u v = {0u, 0u, 0u, 0u};
            if (t >= 0 && t < seqlen) v = *(const v4u*)(P2 + (size_t)(seq0 + t) * CD_N + 1024 + 128 * g + 8 * c);
            *(LAS v4u*)(LXB + rr * 272 + c * 16) = v; }
        __syncthreads();
        { const int ch = tid & 127; const float* cw = A.in[I_CONVW] + 128 * g + ch; const float w0 = cw[0], w1 = cw[1024], w2 = cw[2048], w3 = cw[3072], cb = A.in[I_CONVB][128 * g + ch];
#pragma unroll 4
          for (int k = 0; k < 32; ++k) { const int row = (tid >> 7) + 4 * k; const LAS unsigned short* xp = (const LAS unsigned short*)(LXB + row * 272 + ch * 2);
              const float xl = cb + w0 * bf2f(xp[0]) + w1 * bf2f(xp[136]) + w2 * bf2f(xp[272]) + w3 * bf2f(xp[408]);
              LXF[row * 132 + ch] = xl; *(LAS unsigned short*)(LXL + row * 272 + ch * 2) = f2bf(xl); } }
        __syncthreads();
        const int chb = 16 * wave + r16, ch = 128 * g + chb;
        float hsum[8][4];
#pragma unroll
        for (int d = 0; d < 2; ++d) {
            bf16x8 wa[4], wx[4];
#pragma unroll
            for (int s = 0; s < 4; ++s) { wa[s] = *(const bf16x8*)(LWT + (size_t)((2 * d) * 8 + g) * 16384 + chb * 128 + 32 * s + 8 * q4);
                                          wx[s] = *(const bf16x8*)(LWT + (size_t)((2 * d + 1) * 8 + g) * 16384 + chb * 128 + 32 * s + 8 * q4); }
            const float ba = A.in[I_LBA][d * 1024 + ch], bx = A.in[I_LBX][d * 1024 + ch], lam = A.in[I_LAM][d * 1024 + ch];
            const float sp8 = -8.f * (fmaxf(-lam, 0.f) + log1pf(__expf(-fabsf(lam))));
            float carry = 0.f;
            if (FINAL) {
                const float* ag = AGG + ((size_t)(d * NB + b) * NCH) * 2048 + 2 * ch;
                for (int k = 0; k < NCH; ++k) { const int jj = d ? (k == 0 ? 1 : (k == 1 ? 0 : 35 - k)) : k; if (jj == j) break; const f32x2 ph = *(const f32x2*)(ag + (size_t)jj * 2048); carry = ph.y + ph.x * carry; }
            }
            float ptot = 1.f;
#pragma unroll
            for (int mm = 0; mm < 8; ++mm) {
                const int m = d ? 7 - mm : mm;
                f32x4 aa = {0.f, 0.f, 0.f, 0.f}, ax = {0.f, 0.f, 0.f, 0.f};
#pragma unroll
                for (int s = 0; s < 4; ++s) { const bf16x8 xf = frag_row(LXL, 272, 16 * m, 32 * s, lane); aa = mfma16(xf, wa[s], aa); ax = mfma16(xf, wx[s], ax); }
                float av[4], bv[4];
#pragma unroll
                for (int i = 0; i < 4; ++i) { const int row = 16 * m + 4 * q4 + i; const float rg = sigmoidf_(aa[i] + ba), ig = sigmoidf_(ax[i] + bx), la = sp8 * rg;
                    av[i] = __expf(la); bv[i] = __builtin_amdgcn_sqrtf(fmaxf(1.f - av[i] * av[i], 0.f)) * ig * LXF[row * 132 + chb]; }
                float P = 1.f, H = 0.f;
#pragma unroll
                for (int ii = 0; ii < 4; ++ii) { const int i = d ? 3 - ii : ii; H = av[i] * H + bv[i]; P *= av[i]; }
                float hstart = carry, cnext = carry;
#pragma unroll
                for (int qq_ = 0; qq_ < 4; ++qq_) { const int qq = d ? 3 - qq_ : qq_;
                    const float Pq = __shfl(P, r16 + 16 * qq), Hq = __shfl(H, r16 + 16 * qq);
                    const bool before = d ? (qq > q4) : (qq < q4);
                    if (before) hstart = Hq + Pq * hstart;
                    cnext = Hq + Pq * cnext; ptot *= Pq; }
                if (FINAL) { float hcur = hstart;
#pragma unroll
                    for (int ii = 0; ii < 4; ++ii) { const int i = d ? 3 - ii : ii; hcur = av[i] * hcur + bv[i]; if (d == 0) hsum[m][i] = hcur; else hsum[m][i] += hcur; } }
                carry = cnext;
                __builtin_amdgcn_sched_barrier(0);
            }
            if (!FINAL && q4 == 0) { f32x2 ph; ph.x = ptot; ph.y = carry; *(f32x2*)(AGG + ((size_t)(d * NB + b) * NCH + j) * 2048 + 2 * ch) = ph; }
        }
        if (FINAL) {
            unsigned short ybv[8][4];
#pragma unroll
            for (int m = 0; m < 8; ++m)
#pragma unroll
                for (int i = 0; i < 4; ++i) ybv[m][i] = P2[(size_t)(R0 + 16 * m + 4 * q4 + i) * CD_N + ch];
            asm volatile("" ::: "memory");
#pragma unroll
            for (int m = 0; m < 8; ++m)
#pragma unroll
                for (int i = 0; i < 4; ++i) { const size_t row = (size_t)(R0 + 16 * m + 4 * q4 + i); MRG[row * DM + ch] = f2bf(bf2f(ybv[m][i]) * hsum[m][i]); }
        }
        __syncthreads();
    }
}
DI void phase_mla_norm(const Frame& F, const Args& A) {
    const int lane = lane_id(), gw = blockIdx.x * NWAVES + F.wave, NGW = F.G * NWAVES;
    const bf16* P2 = WSP(bf16, WS_BIG); bf16* CQN = WSP(bf16, WS_CQN); bf16* CKVN = WSP(bf16, WS_CKVN);
    for (int row = gw; row < MT; row += NGW) {
        const v4u q = *(const v4u*)(P2 + (size_t)row * CD_N + 2048 + 8 * lane); const v2u k = *(const v2u*)(P2 + (size_t)row * CD_N + 2560 + 4 * lane);
        float qv[8] = {bflo(q.x), bfhi(q.x), bflo(q.y), bfhi(q.y), bflo(q.z), bfhi(q.z), bflo(q.w), bfhi(q.w)}, kv[4] = {bflo(k.x), bfhi(k.x), bflo(k.y), bfhi(k.y)};
        float sq = 0.f, sk = 0.f;
#pragma unroll
        for (int e = 0; e < 8; ++e) sq += qv[e] * qv[e];
#pragma unroll
        for (int e = 0; e < 4; ++e) sk += kv[e] * kv[e];
        const float rq = __frsqrt_rn(wave_sum(sq) * (1.f / 512.f) + EPS), rk = __frsqrt_rn(wave_sum(sk) * (1.f / 256.f) + EPS);
        const float* gq = A.in[I_QNG] + 8 * lane; const float* gk = A.in[I_KVNG] + 4 * lane;
        v4u oq; oq.x = pk2(qv[0] * rq * gq[0], qv[1] * rq * gq[1]); oq.y = pk2(qv[2] * rq * gq[2], qv[3] * rq * gq[3]); oq.z = pk2(qv[4] * rq * gq[4], qv[5] * rq * gq[5]); oq.w = pk2(qv[6] * rq * gq[6], qv[7] * rq * gq[7]);
        v2u ok; ok.x = pk2(kv[0] * rk * gk[0], kv[1] * rk * gk[1]); ok.y = pk2(kv[2] * rk * gk[2], kv[3] * rk * gk[3]);
        *(v4u*)(CQN + (size_t)row * 512 + 8 * lane) = oq; *(v2u*)(CKVN + (size_t)row * 256 + 4 * lane) = ok;
    }
}
DI void qk_head_norm(const v4u (&x)[3], const float (&g)[24], float scale, bool rot, const f32x4 (&cs)[2], const f32x4 (&sn)[2], int sub, bf16* op) {
    float v[24];
#pragma unroll
    for (int i = 0; i < 3; ++i) { v[8 * i] = bflo(x[i].x); v[8 * i + 1] = bfhi(x[i].x); v[8 * i + 2] = bflo(x[i].y); v[8 * i + 3] = bfhi(x[i].y); v[8 * i + 4] = bflo(x[i].z); v[8 * i + 5] = bfhi(x[i].z); v[8 * i + 6] = bflo(x[i].w); v[8 * i + 7] = bfhi(x[i].w); }
    float ss = 0.f;
#pragma unroll
    for (int i = 0; i < 24; ++i) ss += v[i] * v[i];
    ss += __shfl_xor(ss, 1); ss += __shfl_xor(ss, 2); ss += __shfl_xor(ss, 4);
    const float rs = __frsqrt_rn(ss * (1.f / 192.f) + EPS) * scale;
#pragma unroll
    for (int i = 0; i < 24; ++i) v[i] = v[i] * rs * g[i];
#pragma unroll
    for (int i = 0; i < 8; ++i) { const float own = v[16 + i], pr = __shfl_xor(own, 2); const float c = cs[i >> 2][i & 3], s_ = sn[i >> 2][i & 3];
        if (rot) v[16 + i] = (sub & 2) ? pr * s_ + own * c : own * c - pr * s_; }
    v4u o0, o1, o2;
    o0.x = pk2(v[0], v[1]); o0.y = pk2(v[2], v[3]); o0.z = pk2(v[4], v[5]); o0.w = pk2(v[6], v[7]);
    o1.x = pk2(v[8], v[9]); o1.y = pk2(v[10], v[11]); o1.z = pk2(v[12], v[13]); o1.w = pk2(v[14], v[15]);
    o2.x = pk2(v[16], v[17]); o2.y = pk2(v[18], v[19]); o2.z = pk2(v[20], v[21]); o2.w = pk2(v[22], v[23]);
    *(v4u*)(op + sub * 16) = o0; *(v4u*)(op + sub * 16 + 8) = o1; *(v4u*)(op + 128 + sub * 8) = o2;
}
DI void phase_qk_norm(const Frame& F, const Args& A) {
    const int lane = lane_id(), gw = blockIdx.x * NWAVES + F.wave, NGW = F.G * NWAVES, h = lane >> 3, sub = lane & 7;
    const bf16* P2 = WSP(bf16, WS_BIG); const bf16* QRAW = WSP(bf16, WS_A); const bf16* KVRAW = WSP(bf16, WS_KVRAW); bf16* QF = WSP(bf16, WS_QF); bf16* KF = WSP(bf16, WS_KF);
    const float* axc = WSP(float, WS_AXC); const float* axs = WSP(float, WS_AXS);
    const float* g0 = A.in[I_QKNG]; const float* g1 = g0 + 192;
    float gq[24], gk[24];
#pragma unroll
    for (int i = 0; i < 16; ++i) { gq[i] = g0[sub * 16 + i]; gk[i] = g1[sub * 16 + i]; }
#pragma unroll
    for (int i = 0; i < 8; ++i) { gq[16 + i] = g0[128 + sub * 8 + i]; gk[16 + i] = g1[128 + sub * 8 + i]; }
    constexpr float QS = 0.07216878364870323f * 1.4426950408889634f;
    for (int row = gw; row < MT; row += NGW) {
        const bool lat = row < ML;
        f32x4 cs[2] = {{1.f, 1.f, 1.f, 1.f}, {1.f, 1.f, 1.f, 1.f}}, sn[2] = {{0.f, 0.f, 0.f, 0.f}, {0.f, 0.f, 0.f, 0.f}};
        if (lat) { const int t = row & (SEQ - 1), pos = sub < 4 ? (t >> 6) : (t & 63); const f32x4* cp = (const f32x4*)(axc + pos * 16 + (sub & 1) * 8); const f32x4* sp = (const f32x4*)(axs + pos * 16 + (sub & 1) * 8);
            cs[0] = cp[0]; cs[1] = cp[1]; sn[0] = sp[0]; sn[1] = sp[1]; }
        v4u kx[3]; kx[0] = *(const v4u*)(KVRAW + (size_t)row * 2048 + h * 128 + sub * 16); kx[1] = *(const v4u*)(KVRAW + (size_t)row * 2048 + h * 128 + sub * 16 + 8); kx[2] = *(const v4u*)(P2 + (size_t)row * CD_N + 2816 + sub * 8);
        v4u qx[3];
        if (lat) { const bf16* qp = QRAW + (size_t)row * 1536 + h * 192; qx[0] = *(const v4u*)(qp + sub * 16); qx[1] = *(const v4u*)(qp + sub * 16 + 8); qx[2] = *(const v4u*)(qp + 128 + sub * 8); }
        else { qx[0] = kx[0]; qx[1] = kx[1]; qx[2] = kx[2]; }
        qk_head_norm(kx, gk, 1.f, lat, cs, sn, sub, KF + (size_t)row * 1536 + h * 192);
        if (lat) qk_head_norm(qx, gq, QS, true, cs, sn, sub, QF + (size_t)row * 1536 + h * 192);
    }
}
constexpr int AK_STRIDE = 400, AV_STRIDE = 288, AK_BYTES = 64 * AK_STRIDE, AV_BYTES = 64 * AV_STRIDE, ABUF = AK_BYTES + AV_BYTES;
DI int key_row(int b, int n) { return n < CTXL ? ML + b * CTXL + n : b * SEQ + (n - CTXL); }
constexpr int AKB = AK_BYTES, AVB = 64 * AV_STRIDE;
template <int VAR> DI void phase_attn(const Frame& F, const Args& A, bf16* MRG) {
    const bf16* QF = WSP(bf16, WS_QF); const bf16* KF = WSP(bf16, WS_KF); const bf16* KVRAW = WSP(bf16, WS_KVRAW);
    constexpr int NT = (CTXL + SEQ) / 64;
    LAS unsigned char* KB0 = F.lds; LAS unsigned char* VB0 = F.lds + 2 * AKB;
    const unsigned kb_lds = (unsigned)(size_t)KB0, vb_lds = (unsigned)(size_t)VB0;
    for (int unit = blockIdx.x; unit < NB * 8 * 16; unit += F.G) {
        const int tid = TID(F);
        const int lane = tid & 63, wave = F.wave, r16 = lane & 15, q4 = lane >> 4;
        const int qb = unit & 15, h = (unit >> 4) & 7, b = unit >> 7;
        const size_t qrow0 = (size_t)b * SEQ + qb * 256 + 32 * wave + r16;
        bf16x8 qf[2][6];
#pragma unroll
        for (int qt = 0; qt < 2; ++qt)
#pragma unroll
            for (int s = 0; s < 6; ++s) qf[qt][s] = *(const bf16x8*)(QF + (qrow0 + 16 * qt) * 1536 + h * 192 + 32 * s + 8 * q4);
#define ATT_DMA_K(t, buf) do { _Pragma("unroll") for (int x = 0; x < 4; ++x) { const int ins = wave + 8 * x; if (ins < 25) { const int p = ins * 64 + lane, rr = p / 25, c0_ = p - rr * 25, c = c0_ == 24 ? 0 : c0_; \
            glds16(KF + (size_t)key_row(b, 64 * (t) + rr) * 1536 + h * 192 + 8 * c, kb_lds + (buf) * AKB + ins * 1024); } } } while (0)
#define ATT_DMA_V(t, buf) do { _Pragma("unroll") for (int x = 0; x < 3; ++x) { const int ins = wave + 8 * x; if (ins < 18) { const int p = ins * 64 + lane, rr = p / 18, c0_ = p - rr * 18, c = c0_ >= 16 ? 0 : c0_; \
            glds16(KVRAW + (size_t)key_row(b, 64 * (t) + rr) * 2048 + 1024 + h * 128 + 8 * c, vb_lds + (buf) * AVB + ins * 1024); } } } while (0)
        ATT_DMA_K(0, 0); ATT_DMA_V(0, 0);
        asm volatile("s_waitcnt vmcnt(0)" ::: "memory");
        __syncthreads();
        f32x4 o[2][8];
#pragma unroll
        for (int qt = 0; qt < 2; ++qt)
#pragma unroll
            for (int c = 0; c < 8; ++c) o[qt][c] = (f32x4){0.f, 0.f, 0.f, 0.f};
        float mrun[2] = {-1e30f, -1e30f}, lrun[2] = {0.f, 0.f};
#pragma unroll 1
        for (int t = 0; t < NT; ++t) {
            if (t + 1 < NT) { ATT_DMA_K(t + 1, (t + 1) & 1); ATT_DMA_V(t + 1, (t + 1) & 1); }
            const LAS unsigned char* kb = KB0 + (t & 1) * AKB; const LAS unsigned char* vb = VB0 + (t & 1) * AVB;
            f32x4 sc[2][4]; bf16x8 kf[2][6];
#pragma unroll
            for (int s = 0; s < 6; ++s) kf[0][s] = frag_row(kb, AK_STRIDE, 0, 32 * s, lane);
#pragma unroll
            for (int c = 0; c < 4; ++c) {
                if (c < 3) {
#pragma unroll
                    for (int s = 0; s < 6; ++s) kf[(c + 1) & 1][s] = frag_row(kb, AK_STRIDE, 16 * (c + 1), 32 * s, lane); }
                sc[0][c] = (f32x4){0.f, 0.f, 0.f, 0.f}; sc[1][c] = (f32x4){0.f, 0.f, 0.f, 0.f};
#pragma unroll
                for (int s = 0; s < ((VAR & 1) ? 1 : 6); ++s) { sc[0][c] = mfma16(kf[c & 1][s], qf[0][s], sc[0][c]); sc[1][c] = mfma16(kf[c & 1][s], qf[1][s], sc[1][c]); }
                __builtin_amdgcn_sched_barrier(0);
            }
            bf16x8 vf[2][4];
#define ATT_LOADV_GRP(dst, g_) do { _Pragma("unroll") for (int j = 0; j < 4; ++j) dst[j] = frag_tr(vb, AV_STRIDE, 32 * ((g_) >> 1) + 4 * q4, 32 * ((g_) >> 1) + 16 + 4 * q4, 16 * (4 * ((g_) & 1) + j), lane); } while (0)
            ATT_LOADV_GRP(vf[0], 0);
            bf16x8 pf[2][2];
#pragma unroll
            for (int qt = 0; qt < 2; ++qt) {
                float mx = fmaxf(fmaxf(fmaxf(sc[qt][0][0], sc[qt][0][1]), fmaxf(sc[qt][0][2], sc[qt][0][3])), fmaxf(fmaxf(sc[qt][1][0], sc[qt][1][1]), fmaxf(sc[qt][1][2], sc[qt][1][3])));
                mx = fmaxf(mx, fmaxf(fmaxf(fmaxf(sc[qt][2][0], sc[qt][2][1]), fmaxf(sc[qt][2][2], sc[qt][2][3])), fmaxf(fmaxf(sc[qt][3][0], sc[qt][3][1]), fmaxf(sc[qt][3][2], sc[qt][3][3]))));
                mx = fmaxf(mx, __shfl_xor(mx, 16)); mx = fmaxf(mx, __shfl_xor(mx, 32));
                float mnew = mrun[qt];
                if (__any(mx > mrun[qt] + 10.f)) {
                    mnew = fmaxf(mrun[qt], mx); const float alpha = __builtin_amdgcn_exp2f(mrun[qt] - mnew); mrun[qt] = mnew; lrun[qt] *= alpha;
#pragma unroll
                    for (int c = 0; c < 8; ++c) o[qt][c] = o[qt][c] * alpha;
                }
                float ps = 0.f;
#pragma unroll
                for (int c = 0; c < 4; ++c)
#pragma unroll
                    for (int i = 0; i < 4; ++i) { sc[qt][c][i] = __builtin_amdgcn_exp2f(sc[qt][c][i] - mnew); ps += sc[qt][c][i]; }
                lrun[qt] += ps;
#pragma unroll
                for (int s = 0; s < 2; ++s) { v4u pw; pw.x = pk2(sc[qt][2 * s][0], sc[qt][2 * s][1]); pw.y = pk2(sc[qt][2 * s][2], sc[qt][2 * s][3]); pw.z = pk2(sc[qt][2 * s + 1][0], sc[qt][2 * s + 1][1]); pw.w = pk2(sc[qt][2 * s + 1][2], sc[qt][2 * s + 1][3]);
                    pf[qt][s] = __builtin_bit_cast(bf16x8, pw); }
            }
            __builtin_amdgcn_sched_barrier(0);
#pragma unroll
            for (int g = 0; g < ((VAR & 4) ? 1 : 4); ++g) {
                if (g < 3) ATT_LOADV_GRP(vf[(g + 1) & 1], g + 1);
#pragma unroll
                for (int j = 0; j < 4; ++j) { const int c = 4 * (g & 1) + j; o[0][c] = mfma16(vf[g & 1][j], pf[0][g >> 1], o[0][c]); o[1][c] = mfma16(vf[g & 1][j], pf[1][g >> 1], o[1][c]); }
                __builtin_amdgcn_sched_barrier(0);
            }
#undef ATT_LOADV_GRP
            asm volatile("s_waitcnt vmcnt(0)" ::: "memory");
            __syncthreads();
        }
#undef ATT_DMA_K
#undef ATT_DMA_V
#pragma unroll
        for (int qt = 0; qt < 2; ++qt) {
            float l = lrun[qt]; l += __shfl_xor(l, 16); l += __shfl_xor(l, 32);
            const float inv = 1.f / l;
#pragma unroll
            for (int c = 0; c < 8; ++c) { v2u w; w.x = pk2(o[qt][c][0] * inv, o[qt][c][1] * inv); w.y = pk2(o[qt][c][2] * inv, o[qt][c][3] * inv); *(v2u*)(MRG + (qrow0 + 16 * qt) * DM + 1024 + h * 128 + 16 * c + 4 * q4) = w; }
        }
    }
}

#ifndef MK_KROT
#define MK_KROT 0
#endif
#define GEMM_PHASE(EPI, Aptr, Bptr, M_, N_, K_, Eobj) do { pg8::Gemm g_{(const pg8::bf16_t*)(Aptr), (const pg8::bf16_t*)(Bptr), (M_), (N_), (K_), (K_)}; pg8::StaticOrder S_; S_.init((M_), (N_), F.G, vcu, (MK_KROT) && (K_) >= 1024); \
        pg8::gemm_phase<EPI, pg8::StaticOrder, true, true>(F.lds, g_, S_, (Eobj)); } while (0)
#define GEMM_CTX_SPLIT(Aptr, Bptr, KP, LDK) do { const int c_ = vcu, ks_ = c_ >> 5; int p0_, np_; \
        if ((KP) == 43) { np_ = ks_ < 3 ? 6 : 5; p0_ = ks_ < 3 ? 6 * ks_ : 18 + 5 * (ks_ - 3); } else { np_ = (KP) / 8; p0_ = np_ * ks_; } \
        pg8::Gemm g_{(const pg8::bf16_t*)(Aptr), (const pg8::bf16_t*)(Bptr), MC, DM, np_ * 128, (LDK)}; pg8::SplitOrder S_{c_, p0_ * 128}; EpiPartial E_{PART + (size_t)ks_ * MC * DM}; \
        pg8::gemm_phase<EpiPartial, pg8::SplitOrder, true, true>(F.lds, g_, S_, E_); } while (0)

DI void xcd_or_nothing(const XcdBarrier& bar, bool multi) { if (multi) xcd_barrier(bar); }
__global__ void __launch_bounds__(NTHR, 2) mk_fwd(Args A) {
    extern __shared__ __attribute__((aligned(16))) unsigned char lds_raw[];
    Frame F; F.lds = (LAS unsigned char*)lds_raw; F.wave = __builtin_amdgcn_readfirstlane((int)threadIdx.x >> 6); F.G = gridDim.x; F.a = &A;
    volatile LAS unsigned* MISC = (volatile LAS unsigned*)(F.lds + MISC_OFF);
    if (threadIdx.x < 64) MISC[threadIdx.x] = 0u;
    __syncthreads();
    const int lo = A.ph_lo, hi = A.ph_hi < MK_STOP_AFTER + 1 ? A.ph_hi : MK_STOP_AFTER + 1;
    const bool multi = (hi - lo) > 1;
    XcdBarrier bar; bar.bar = (unsigned*)(A.ws + WS_CTL) + CW_BAR; bar.x = 0; bar.st = nullptr; bar.w = F.wave;
    if (multi) bar = xcd_barrier_post((unsigned*)(A.ws + WS_CTL) + CW_BAR, MISC + 8);
    int vcu = (int)blockIdx.x;
    if (multi && F.G <= 256) { if (threadIdx.x == 0) { unsigned* ctl = (unsigned*)(A.ws + WS_CTL); const unsigned x = xb_xcc_id() & 7u; const unsigned rk = atomicAdd(&ctl[8192 + 64 * x], 1u);
            __hip_atomic_store(&ctl[16384 + blockIdx.x], rk * 8u + x + 1u, RLX_AGENT); } }
#ifndef MK_PHASE_MASK
#define MK_PHASE_MASK 0xFFFFFFFFull
#endif
#define IN(k) ((((MK_PHASE_MASK) >> (k)) & 1ull) && lo <= (k) && (k) < hi)
#if defined(MK_DOUBLE_BAR)
#define SEAM(k) do { if (IN((k) + 1)) { xcd_barrier(bar); xcd_barrier(bar); } } while (0)
#else
#define SEAM(k) do { if (IN((k) + 1)) xcd_barrier(bar); } while (0)
#endif
#ifndef MK_REPEAT_MASK
#define MK_REPEAT_MASK 0ull
#endif
#define REPK(k) ((int)(((MK_REPEAT_MASK) >> (k)) & 1ull))
    float* XL = A.out; float* XC = WSP(float, WS_XC); float* SCRL = WSP(float, WS_B); float* SCRC = WSP(float, WS_B + 128 * MiB); float* PART = WSP(float, WS_A); const CtxFix NOFIX{nullptr, nullptr, nullptr, 0.f}; const float* MOD = WSP(float, WS_MOD);
    bf16* XN = WSP(bf16, WS_XN); bf16* BIG = WSP(bf16, WS_BIG);

    if (IN(0)) { _Pragma("unroll") for (int rep = 0; rep < 1 + REPK(0); ++rep) { if (rep) xcd_or_nothing(bar, multi); phase_pre(F, A, rep == 0); } SEAM(0); }
    if (multi && F.G <= 256) {
        const unsigned* ctl = (const unsigned*)(A.ws + WS_CTL); LAS unsigned* cnt = (LAS unsigned*)(F.lds + MISC_OFF + 64);
        const int tid_ = TID(F);
        if (tid_ == 0) *cnt = 0u;
        __syncthreads();
        const unsigned mine = __hip_atomic_load(&ctl[16384 + blockIdx.x], RLX_AGENT);
        if (tid_ < F.G) { const unsigned kj = __hip_atomic_load(&ctl[16384 + tid_], RLX_AGENT); if (kj < mine) atomicAdd((unsigned*)cnt, 1u); }
        __syncthreads();
        vcu = (int)*cnt;
        __syncthreads();
    }
    if (IN(1)) { _Pragma("unroll") for (int rep = 0; rep < 1 + REPK(1); ++rep) { if (rep) xcd_or_nothing(bar, multi); phase_norm(F, A, 0, 0, MT, true, NOFIX); } SEAM(1); }
    if (IN(2)) { { EpiUp E{BIG}; GEMM_PHASE(EpiUp, XN, WSP(bf16, WS_WGU), MT, NGU, DM, E); }
#if defined(MK_PROBE_SAMETILE)
        { xcd_or_nothing(bar, multi); EpiUp E{(bf16*)SCRL}; pg8::Gemm g_{(const pg8::bf16_t*)XN, (const pg8::bf16_t*)WSP(bf16, WS_WGU), MT, NGU, DM, DM}; pg8::SameTileOrder S_; S_.init(MT, NGU, F.G, (int)blockIdx.x);
          pg8::gemm_phase<EpiUp, pg8::SameTileOrder, true, true>(F.lds, g_, S_, E); }
#endif
#if defined(MK_PROBE_NULLEPI)
        { xcd_or_nothing(bar, multi); EpiNull<true> E{SCRL + (size_t)blockIdx.x * 4096}; pg8::Gemm g_{(const pg8::bf16_t*)XN, (const pg8::bf16_t*)WSP(bf16, WS_WGU), MT, NGU, DM, DM}; pg8::StaticOrder S_; S_.init(MT, NGU, F.G, vcu);
          pg8::gemm_phase<EpiNull<true>, pg8::StaticOrder, true, true>(F.lds, g_, S_, E); }
#endif
#if defined(MK_PROBE_FEW)
        { xcd_or_nothing(bar, multi); EpiUp E{(bf16*)SCRL}; pg8::Gemm g_{(const pg8::bf16_t*)XN, (const pg8::bf16_t*)WSP(bf16, WS_WGU), MT, NGU, DM, DM}; pg8::FewTileOrder S_; S_.init(MT, NGU, F.G, vcu);
          pg8::gemm_phase<EpiUp, pg8::FewTileOrder, true, true>(F.lds, g_, S_, E); }
#endif
#if defined(MK_PROBE_FIX)
        { xcd_or_nothing(bar, multi); EpiUp E{(bf16*)SCRL}; pg8::Gemm g_{(const pg8::bf16_t*)XN, (const pg8::bf16_t*)WSP(bf16, WS_WGU), MT, NGU, DM, DM}; pg8::ProbeOrder<(MK_PROBE_FIX & 1) != 0, (MK_PROBE_FIX & 2) != 0> S_; S_.init(MT, NGU, F.G, vcu);
          pg8::gemm_phase<EpiUp, pg8::ProbeOrder<(MK_PROBE_FIX & 1) != 0, (MK_PROBE_FIX & 2) != 0>, true, true>(F.lds, g_, S_, E); }
#endif
        SEAM(2); }
    if (IN(3)) { _Pragma("unroll") for (int rep = 0; rep < 1 + REPK(3); ++rep) { if (rep) xcd_or_nothing(bar, multi); EpiResid E{A.in[I_X], A.in[I_CTX], rep ? SCRL : XL, rep ? SCRC : XC, MOD + 2 * DM, 0.5f}; GEMM_PHASE(EpiResid, BIG, WSP(bf16, WS_WD), ML, DM, FF, E); if (!rep) GEMM_CTX_SPLIT(BIG + (size_t)ML * FF, WSP(bf16, WS_WD), 43, FF); }
#if defined(MK_PROBE_NULLEPI_DOWN)
        { xcd_or_nothing(bar, multi); EpiNull<false> E{SCRL + (size_t)blockIdx.x * 4096}; pg8::Gemm g_{(const pg8::bf16_t*)BIG, (const pg8::bf16_t*)WSP(bf16, WS_WD), ML, DM, FF, FF}; pg8::StaticOrder S_; S_.init(ML, DM, F.G, vcu);
          pg8::gemm_phase<EpiNull<false>, pg8::StaticOrder, true, true>(F.lds, g_, S_, E); }
#endif
#if defined(MK_PROBE_SAMETILE_DOWN)
        { xcd_or_nothing(bar, multi); EpiResid E{A.in[I_X], A.in[I_CTX], SCRL, SCRC, MOD + 2 * DM, 0.5f}; pg8::Gemm g_{(const pg8::bf16_t*)BIG, (const pg8::bf16_t*)WSP(bf16, WS_WD), ML, DM, FF, FF}; pg8::SameTileOrder S_; S_.init(ML, DM, F.G, (int)blockIdx.x);
          pg8::gemm_phase<EpiResid, pg8::SameTileOrder, true, true>(F.lds, g_, S_, E); }
#endif
        SEAM(3); }
    if (IN(4)) { _Pragma("unroll") for (int rep = 0; rep < 1 + REPK(4); ++rep) { if (rep) xcd_or_nothing(bar, multi); phase_norm(F, A, 0, 1, MT, false, CtxFix{A.in[I_CTX], PART, MOD + 4 * MODW + 2 * DM, 0.5f}); } SEAM(4); }
    if (IN(5)) { _Pragma("unroll") for (int rep = 0; rep < 1 + REPK(5); ++rep) { if (rep) xcd_or_nothing(bar, multi); EpiProjAB E{BIG, WSP(float, WS_GATES), A.in[I_GATEB], WSP(float, WS_ROPEC), WSP(float, WS_ROPES)}; GEMM_PHASE(EpiProjAB, XN, WSP(bf16, WS_ABWIN), MT, AB_N, DM, E); } SEAM(5); }
    if (IN(6)) { _Pragma("unroll") for (int rep = 0; rep < 1 + REPK(6); ++rep) { if (rep) xcd_or_nothing(bar, multi); phase_m1(F, A); } SEAM(6); }
    if (IN(7)) { _Pragma("unroll") for (int rep = 0; rep < 1 + REPK(7); ++rep) { if (rep) xcd_or_nothing(bar, multi); phase_m2(F, A); } SEAM(7); }
    if (IN(8)) { phase_m3<0>(F, A, XN);
#if defined(MK_PROBE_M3)
        xcd_or_nothing(bar, multi); phase_m3<MK_PROBE_M3>(F, A, (bf16*)SCRL);
#endif
        SEAM(8); }
    if (IN(9)) { _Pragma("unroll") for (int rep = 0; rep < 1 + REPK(9); ++rep) { if (rep) xcd_or_nothing(bar, multi); EpiResid E{XL, XC, rep ? SCRL : XL, rep ? SCRC : XC, MOD + 5 * DM, 1.f}; GEMM_PHASE(EpiResid, XN, WSP(bf16, WS_ABWOUT), ML, DM, DM, E); if (!rep) GEMM_CTX_SPLIT(XN + (size_t)ML * DM, WSP(bf16, WS_ABWOUT), 16, DM); } SEAM(9); }
    if (IN(10)) { _Pragma("unroll") for (int rep = 0; rep < 1 + REPK(10); ++rep) { if (rep) xcd_or_nothing(bar, multi); phase_norm(F, A, 0, 2, MT, false, CtxFix{XC, PART, MOD + 4 * MODW + 5 * DM, 1.f}); } SEAM(10); }
    if (IN(11)) { _Pragma("unroll") for (int rep = 0; rep < 1 + REPK(11); ++rep) { if (rep) xcd_or_nothing(bar, multi); EpiUp E{BIG}; GEMM_PHASE(EpiUp, XN, WSP(bf16, WS_WGU) + (size_t)1 * NGU * DM, MT, NGU, DM, E); } SEAM(11); }
    if (IN(12)) { _Pragma("unroll") for (int rep = 0; rep < 1 + REPK(12); ++rep) { if (rep) xcd_or_nothing(bar, multi); EpiResid E{XL, XC, rep ? SCRL : XL, rep ? SCRC : XC, MOD + 8 * DM, 0.5f}; GEMM_PHASE(EpiResid, BIG, WSP(bf16, WS_WD) + (size_t)1 * DM * FF, ML, DM, FF, E); if (!rep) GEMM_CTX_SPLIT(BIG + (size_t)ML * FF, WSP(bf16, WS_WD) + (size_t)1 * DM * FF, 43, FF); } SEAM(12); }
    const float* MOD1 = MOD + 5 * MODW;
    if (IN(13)) { _Pragma("unroll") for (int rep = 0; rep < 1 + REPK(13); ++rep) { if (rep) xcd_or_nothing(bar, multi); phase_norm(F, A, 1, 0, MT, false, CtxFix{XC, PART, MOD + 4 * MODW + 8 * DM, 0.5f}); } SEAM(13); }
    if (IN(14)) { _Pragma("unroll") for (int rep = 0; rep < 1 + REPK(14); ++rep) { if (rep) xcd_or_nothing(bar, multi); EpiUp E{BIG}; GEMM_PHASE(EpiUp, XN, WSP(bf16, WS_WGU) + (size_t)2 * NGU * DM, MT, NGU, DM, E); } SEAM(14); }
    if (IN(15)) { _Pragma("unroll") for (int rep = 0; rep < 1 + REPK(15); ++rep) { if (rep) xcd_or_nothing(bar, multi); EpiResid E{XL, XC, rep ? SCRL : XL, rep ? SCRC : XC, MOD1 + 2 * DM, 0.5f}; GEMM_PHASE(EpiResid, BIG, WSP(bf16, WS_WD) + (size_t)2 * DM * FF, ML, DM, FF, E); if (!rep) GEMM_CTX_SPLIT(BIG + (size_t)ML * FF, WSP(bf16, WS_WD) + (size_t)2 * DM * FF, 43, FF); } SEAM(15); }
    if (IN(16)) { _Pragma("unroll") for (int rep = 0; rep < 1 + REPK(16); ++rep) { if (rep) xcd_or_nothing(bar, multi); phase_norm(F, A, 1, 1, MT, false, CtxFix{XC, PART, MOD1 + 4 * MODW + 2 * DM, 0.5f}); } SEAM(16); }
    if (IN(17)) { _Pragma("unroll") for (int rep = 0; rep < 1 + REPK(17); ++rep) { if (rep) xcd_or_nothing(bar, multi); EpiPlain E{BIG, CD_N, 4}; GEMM_PHASE(EpiPlain, XN, WSP(bf16, WS_CDWIN), MT, CD_N, DM, E); } SEAM(17); }
    if (IN(18)) { _Pragma("unroll") for (int rep = 0; rep < 1 + REPK(18); ++rep) { if (rep) xcd_or_nothing(bar, multi); phase_mla_norm(F, A); phase_lru<false>(F, A); } SEAM(18); }
    if (IN(19)) { _Pragma("unroll") for (int rep = 0; rep < 1 + REPK(19); ++rep) { if (rep) xcd_or_nothing(bar, multi); { EpiPlain E{WSP(bf16, WS_A), 1536, 0}; GEMM_PHASE(EpiPlain, WSP(bf16, WS_CQN), WSP(bf16, WS_WUQ), ML, 1536, 512, E); }
                  { EpiPlain E{WSP(bf16, WS_KVRAW), 2048, 0}; GEMM_PHASE(EpiPlain, WSP(bf16, WS_CKVN), WSP(bf16, WS_WUKV), MT, 2048, 256, E); }
                  phase_lru<true>(F, A); } SEAM(19); }
    if (IN(20)) { _Pragma("unroll") for (int rep = 0; rep < 1 + REPK(20); ++rep) { if (rep) xcd_or_nothing(bar, multi); phase_qk_norm(F, A); } SEAM(20); }
    if (IN(21)) { phase_attn<0>(F, A, XN);
#if defined(MK_PROBE_ATT)
        xcd_or_nothing(bar, multi); phase_attn<MK_PROBE_ATT>(F, A, (bf16*)SCRL);
#endif
        SEAM(21); }
    if (IN(22)) { _Pragma("unroll") for (int rep = 0; rep < 1 + REPK(22); ++rep) { if (rep) xcd_or_nothing(bar, multi); EpiResid E{XL, XC, rep ? SCRL : XL, rep ? SCRC : XC, MOD1 + 5 * DM, 1.f}; GEMM_PHASE(EpiResid, XN, WSP(bf16, WS_CDWOUT), ML, DM, DM, E); } SEAM(22); }
    if (IN(23)) { _Pragma("unroll") for (int rep = 0; rep < 1 + REPK(23); ++rep) { if (rep) xcd_or_nothing(bar, multi); phase_norm(F, A, 1, 2, ML, false, NOFIX); } SEAM(23); }
    if (IN(24)) { _Pragma("unroll") for (int rep = 0; rep < 1 + REPK(24); ++rep) { if (rep) xcd_or_nothing(bar, multi); EpiUp E{BIG}; GEMM_PHASE(EpiUp, XN, WSP(bf16, WS_WGU) + (size_t)3 * NGU * DM, ML, NGU, DM, E); } SEAM(24); }
    if (IN(25)) { _Pragma("unroll") for (int rep = 0; rep < 1 + REPK(25); ++rep) { if (rep) xcd_or_nothing(bar, multi); EpiResid E{XL, XC, rep ? SCRL : XL, rep ? SCRC : XC, MOD1 + 8 * DM, 0.5f}; GEMM_PHASE(EpiResid, BIG, WSP(bf16, WS_WD) + (size_t)3 * DM * FF, ML, DM, FF, E); } }
#undef IN
#undef SEAM
}

extern "C" void kernel_launch(void* const* d_in, const int* in_sizes, int n_in, void* d_out, int out_size, void* d_ws, size_t ws_size, hipStream_t stream) {
    static int grid = 0;
    if (grid == 0) {
        if (n_in != 31 || out_size != ML * DM || ws_size < WS_END) { fprintf(stderr, "kernel_launch: unexpected problem (n_in %d, out %d, ws %zu < %zu); nothing launched\n", n_in, out_size, ws_size, (size_t)WS_END); grid = -1; return; }
        int dev = 0, cus = 0, per_cu = 0;
        if (hipGetDevice(&dev) != hipSuccess || hipDeviceGetAttribute(&cus, hipDeviceAttributeMultiprocessorCount, dev) != hipSuccess) { grid = -1; return; }
        if (hipFuncSetAttribute((const void*)mk_fwd, hipFuncAttributeMaxDynamicSharedMemorySize, LDS_BYTES) != hipSuccess) { fprintf(stderr, "kernel_launch: hipFuncSetAttribute failed\n"); grid = -1; return; }
        if (hipOccupancyMaxActiveBlocksPerMultiprocessor(&per_cu, (const void*)mk_fwd, NTHR, LDS_BYTES) != hipSuccess || per_cu < 1 || cus < 256) {
            fprintf(stderr, "kernel_launch: the occupancy query reports %d workgroups per CU on %d CUs; the grid barrier needs 256 resident workgroups; nothing launched\n", per_cu, cus); (void)hipGetLastError(); grid = -1; return; }
        (void)hipGetLastError();
        grid = 256;
    }
    if (grid < 0) return;
    if (hipMemsetAsync((char*)d_ws + WS_CTL, 0, CTL_ZERO_BYTES, stream) != hipSuccess) return;
    Args a{};
    for (int i = 0; i < 31; ++i) a.in[i] = (const float*)d_in[i];
    a.out = (float*)d_out; a.ws = (unsigned char*)d_ws;
#if MK_ONE_LAUNCH
    a.ph_lo = 0; a.ph_hi = NPHASE;
    hipLaunchKernelGGL(mk_fwd, dim3(grid), dim3(NTHR), LDS_BYTES, stream, a);
#else
    for (int ph = 0; ph < NPHASE && ph <= MK_STOP_AFTER; ++ph) { a.ph_lo = ph; a.ph_hi = ph + 1; hipLaunchKernelGGL(mk_fwd, dim3(grid), dim3(NTHR), LDS_BYTES, stream, a); }
#endif
#if defined(MK_DEBUG_HASH)
    hipLaunchKernelGGL(dbg_hash, dim3(2048), dim3(256), 0, stream, a);
    hipLaunchKernelGGL(dbg_hash_apply, dim3(1024), dim3(256), 0, stream, a);
#endif
#if defined(MK_DEBUG_CHECKS)
    hipLaunchKernelGGL(dbg_checks, dim3(1), dim3(256), 0, stream, a);
    hipLaunchKernelGGL(dbg_apply, dim3(1024), dim3(256), 0, stream, a);
#endif
}
```

```cpp
#include <hip/hip_runtime.h>
#include <cstdio>
#include <cstdint>
#define MK_ONE_LAUNCH 1
namespace pg8 {
#define PG8_LAS __attribute__((address_space(3)))
typedef unsigned short bf16_t;
typedef short bf16x8 __attribute__((ext_vector_type(8)));
typedef float f32x4 __attribute__((ext_vector_type(4)));
typedef unsigned u32x4 __attribute__((ext_vector_type(4)));
constexpr int BM = 256, BK = 64, HALF = 128, HTB = HALF * BK * 2  , STAGE_BYTES = 8 * HTB, NXCD = 8, WGM = 8;

__host__ __device__ __forceinline__ int lds_byte(int r, int c) { const int st = (r >> 4) * 2 + (c >> 5), rr = r & 15, cc = c & 31, ob = rr * 64 + cc * 2; return st * 1024 + (ob ^ (((ob >> 9) & 1) << 5)); }
__host__ __device__ __forceinline__ void stage_rc(int b, int& R, int& C) { const int st = b / 1024, sb = b % 1024, swz = sb ^ (((sb >> 9) & 1) << 5); R = (st >> 1) * 16 + swz / 64; C = (st & 1) * 32 + (swz % 64) / 2; }
__host__ __device__ __forceinline__ int perm32(int rho) { const int n = rho >> 4, i = rho & 15; return 8 * (i >> 2) + 4 * n + (i & 3); }

struct Unit { int pm, pn, koff, rot; };
struct Gemm { const bf16_t* A; const bf16_t* Bt; int M, N, K, ldk; };

struct SplitOrder {
    int c, koff;
    __host__ __device__ bool next(int i, Unit& u) const { if (i > 0 || c >= 256) return false; u.pm = c & 3; u.pn = (c >> 2) & 7; u.koff = koff; u.rot = 0; return true; }
    __device__ __forceinline__ void a_ready(const Unit&) const {}
    __device__ __forceinline__ void done(const Unit&) const {}
};
template <bool FIXA, bool FIXB> struct ProbeOrder;
struct SameTileOrder {
    int nwg, G, c;
    __host__ __device__ void init(int M, int N, int G_, int c_) { nwg = (M / BM) * (N / BM); G = G_; c = c_; }
    __host__ __device__ bool next(int i, Unit& u) const { const long L = (long)i * G + c; if (L >= nwg) return false; u.pm = 0; u.pn = 0; u.koff = 0; u.rot = 0; return true; }
    __device__ __forceinline__ void a_ready(const Unit&) const {}
    __device__ __forceinline__ void done(const Unit&) const {}
};
struct StaticOrder {
    int nM, nN, nwg, G, c, rot_en, wgm;
    __host__ __device__ void init(int M, int N, int G_, int c_, int rot_en_ = 0, int wgm_ = WGM) { nM = M / BM; nN = N / BM; nwg = nM * nN; G = G_; c = c_; rot_en = rot_en_; wgm = wgm_; }
    __host__ __device__ bool next(int i, Unit& u) const {
        const long L = (long)i * G + c; if (L >= nwg) return false;
        int wgid = (int)L; { const int q = nwg / NXCD, r = nwg % NXCD, xcd = wgid % NXCD, off = wgid / NXCD; wgid = (xcd < r ? xcd * (q + 1) : r * (q + 1) + (xcd - r) * q) + off; }
        const int nig = wgm * nN, gid = wgid / nig, fm = gid * wgm, gsz = (nM - fm) < wgm ? (nM - fm) : wgm;
        u.pm = fm + ((wgid % nig) % gsz); u.pn = (wgid % nig) / gsz; u.koff = 0; u.rot = rot_en ? 2 * (((u.pm & 3) + (u.pn & 3) + i) & 3) : 0; return true;
    }
    __device__ __forceinline__ void a_ready(const Unit&) const {}
    __device__ __forceinline__ void done(const Unit&) const {}
};
struct SliceOrder : StaticOrder {
    int s;
    __host__ __device__ bool next(int i, Unit& u) const { if (i > 0) return false; return StaticOrder::next(s, u); }
};
typedef __bf16 bf16x2_t __attribute__((ext_vector_type(2)));
__device__ __forceinline__ unsigned cvt_pk_bf16(float lo, float hi) { bf16x2_t v = {(__bf16)lo, (__bf16)hi}; return __builtin_bit_cast(unsigned, v); }
template <class Epi, class Sched, bool ALIGN_EPI = false, bool SP2 = false>
__device__ __forceinline__ void gemm_phase(PG8_LAS unsigned char* lds, const Gemm g, const Sched& S, const Epi& E) {
    const int tid = threadIdx.x, wid = __builtin_amdgcn_readfirstlane(tid >> 6), lane = tid & 63, wr = wid >> 2, wc = wid & 3, fr = lane & 15, fq = lane >> 4;
    const int K = g.ldk, nt = g.K / BK;
    unsigned voffA[2], voffB[2];
#pragma unroll
    for (int i = 0; i < 2; ++i) { int R, C; stage_rc(tid * 16 + i * 8192, R, C); const int Rb = Epi::PERM ? ((R & ~31) + perm32(R & 31)) : R;
        voffA[i] = (unsigned)(R * K + C) * 2u; voffB[i] = (unsigned)(Rb * K + C) * 2u; }
    const size_t kstep = (size_t)(BK * 2);
    const size_t hstep = (size_t)HALF * K * 2;
    const size_t tstep = 2 * hstep;
    const unsigned ldsw = (unsigned)wid * 1024u;
    const int aoff = lds_byte(wr * 64 + fr, fq * 8), boff = lds_byte(wc * 32 + fr, fq * 8);
#define PG8_SA(b, h) (((b) * 2 + (h)) * HTB)
#define PG8_SB(b, h) ((4 + (b) * 2 + (h)) * HTB)
#define PG8_STAGE(bufoff, gbase, voff) do { _Pragma("unroll") for (int _i = 0; _i < 2; ++_i) \
        __builtin_amdgcn_global_load_lds((const unsigned*)((const char*)(gbase) + (voff)[_i]), (PG8_LAS unsigned*)(lds + (bufoff) + ldsw + _i * 8192), 16, 0, 0); } while (0)
#define PG8_LDA(dst, b, h) do { _Pragma("unroll") for (int m = 0; m < 4; ++m) _Pragma("unroll") for (int k = 0; k < 2; ++k) dst[m][k] = *(const PG8_LAS bf16x8*)(lds + PG8_SA(b, h) + aoff + m * 2048 + k * 1024); } while (0)
#define PG8_LDB(dst, b, h) do { _Pragma("unroll") for (int n = 0; n < 2; ++n) _Pragma("unroll") for (int k = 0; k < 2; ++k) dst[n][k] = *(const PG8_LAS bf16x8*)(lds + PG8_SB(b, h) + boff + n * 2048 + k * 1024); } while (0)
#define PG8_MMA(ai, bj, At, Bt) do { __builtin_amdgcn_s_setprio(1); _Pragma("unroll") for (int m = 0; m < 4; ++m) _Pragma("unroll") for (int n = 0; n < 2; ++n) _Pragma("unroll") for (int k = 0; k < 2; ++k) \
        acc[ai][bj][m][n] = __builtin_amdgcn_mfma_f32_16x16x32_bf16(Bt[n][k], At[m][k], acc[ai][bj][m][n], 0, 0, 0); __builtin_amdgcn_s_setprio(0); } while (0)
#define PG8_WAIT_V(n) asm volatile("s_waitcnt vmcnt(" #n ")" ::: "memory")
#define PG8_WAIT_L(n) asm volatile("s_waitcnt lgkmcnt(" #n ")" ::: "memory")
#define PG8_BAR __builtin_amdgcn_s_barrier()
#define PG8_SCHED __builtin_amdgcn_sched_barrier(0)
    Unit cur, nxt; int ui = 0;
    if (!S.next(0, cur)) return;
    f32x4 acc[2][2][4][2];
#pragma unroll
    for (int a = 0; a < 2; ++a)
#pragma unroll
        for (int b = 0; b < 2; ++b)
#pragma unroll
            for (int m = 0; m < 4; ++m)
#pragma unroll
                for (int n = 0; n < 2; ++n) acc[a][b][m][n] = (f32x4){0.f, 0.f, 0.f, 0.f};
    bf16x8 At[4][2], B0[2][2], B1[2][2];
    const char* cA = (const char*)g.A + (size_t)cur.pm * tstep + (size_t)cur.koff * 2; const char* cB = (const char*)g.Bt + (size_t)cur.pn * tstep + (size_t)cur.koff * 2;
    size_t kc = (size_t)cur.rot * kstep; const size_t kwrap = (size_t)nt * kstep;
    const char* pA = cA + kc; const char* pB = cB + kc;
    S.a_ready(cur);
    if constexpr (SP2) {
        PG8_STAGE(PG8_SB(0, 0), pB, voffB); PG8_STAGE(PG8_SB(0, 1), pB + hstep, voffB); PG8_STAGE(PG8_SA(0, 0), pA, voffA); PG8_STAGE(PG8_SA(0, 1), pA + hstep, voffA);
        if (wr == 1) PG8_BAR;
        PG8_WAIT_V(2); PG8_BAR;
        PG8_STAGE(PG8_SB(1, 0), pB + kstep, voffB); PG8_STAGE(PG8_SA(1, 0), pA + kstep, voffA); PG8_STAGE(PG8_SB(1, 1), pB + hstep + kstep, voffB);
        PG8_WAIT_V(6); PG8_BAR;
    } else {
        PG8_STAGE(PG8_SB(0, 0), pB, voffB); PG8_STAGE(PG8_SA(0, 0), pA, voffA); PG8_STAGE(PG8_SB(0, 1), pB + hstep, voffB); PG8_STAGE(PG8_SA(0, 1), pA + hstep, voffA);
        if (wr == 1) PG8_BAR;
        PG8_WAIT_V(4); PG8_BAR;
        PG8_STAGE(PG8_SB(1, 0), pB + kstep, voffB); PG8_STAGE(PG8_SA(1, 0), pA + kstep, voffA); PG8_STAGE(PG8_SB(1, 1), pB + hstep + kstep, voffB);
        PG8_WAIT_V(6); PG8_BAR;
    }
    for (;;) {
        const bool has_next = S.next(ui + 1, nxt);
        const char* nA = has_next ? (const char*)g.A + (size_t)nxt.pm * tstep + (size_t)nxt.koff * 2 : cA; const char* nB = has_next ? (const char*)g.Bt + (size_t)nxt.pn * tstep + (size_t)nxt.koff * 2 : cB;
        const size_t nk = (size_t)(has_next ? nxt.rot : cur.rot) * kstep;
        for (int t = 0; t < nt; t += 2) {
            const bool last = (t == nt - 2);
            const char* a1 = cA + kc + kstep;
            size_t k2 = kc + 2 * kstep; if (k2 >= kwrap) k2 -= kwrap;
            const char* a2 = last ? nA + nk : cA + k2; const char* b2 = last ? nB + nk : cB + k2;
            kc = k2;
            const char* a3 = a2 + kstep; const char* b3 = b2 + kstep;
            if (last && has_next) S.a_ready(nxt);
            if constexpr (SP2) {
            PG8_LDB(B0, 0, 0); PG8_LDB(B1, 0, 1); PG8_SCHED; PG8_LDA(At, 0, 0); PG8_STAGE(PG8_SA(1, 1), a1 + hstep, voffA);
            PG8_WAIT_V(8); PG8_WAIT_L(0); PG8_BAR; PG8_MMA(0, 0, At, B0); PG8_MMA(0, 1, At, B1); PG8_BAR; PG8_SCHED;
            PG8_LDA(At, 0, 1); PG8_STAGE(PG8_SB(0, 0), b2, voffB); PG8_STAGE(PG8_SB(0, 1), b2 + hstep, voffB); PG8_STAGE(PG8_SA(0, 0), a2, voffA);
            PG8_WAIT_V(8); PG8_WAIT_L(0); PG8_BAR; PG8_MMA(1, 0, At, B0); PG8_MMA(1, 1, At, B1); PG8_BAR; PG8_SCHED;
            PG8_LDB(B0, 1, 0); PG8_LDB(B1, 1, 1); PG8_SCHED; PG8_LDA(At, 1, 0); PG8_STAGE(PG8_SA(0, 1), a2 + hstep, voffA);
            PG8_WAIT_V(8); PG8_WAIT_L(0); PG8_BAR; PG8_MMA(0, 0, At, B0); PG8_MMA(0, 1, At, B1); PG8_BAR; PG8_SCHED;
            PG8_LDA(At, 1, 1); PG8_STAGE(PG8_SB(1, 0), b3, voffB); PG8_STAGE(PG8_SB(1, 1), b3 + hstep, voffB); PG8_STAGE(PG8_SA(1, 0), a3, voffA);
            PG8_WAIT_V(8); PG8_WAIT_L(0); PG8_BAR; PG8_MMA(1, 0, At, B0); PG8_MMA(1, 1, At, B1); PG8_BAR; PG8_SCHED;
            } else {
            PG8_LDB(B0, 0, 0); PG8_SCHED; PG8_LDA(At, 0, 0); PG8_STAGE(PG8_SA(1, 1), a1 + hstep, voffA);
            PG8_WAIT_L(8); PG8_BAR; PG8_WAIT_L(0); PG8_MMA(0, 0, At, B0); PG8_BAR; PG8_SCHED;
            PG8_LDB(B1, 0, 1); PG8_STAGE(PG8_SB(0, 0), b2, voffB);
            PG8_BAR; PG8_WAIT_L(0); PG8_MMA(0, 1, At, B1); PG8_BAR;
            PG8_LDA(At, 0, 1); PG8_STAGE(PG8_SA(0, 0), a2, voffA);
            PG8_BAR; PG8_WAIT_L(0); PG8_MMA(1, 0, At, B0); PG8_BAR; PG8_SCHED;
            PG8_STAGE(PG8_SB(0, 1), b2 + hstep, voffB);
            PG8_WAIT_V(6); PG8_BAR; PG8_MMA(1, 1, At, B1); PG8_BAR;
            PG8_LDB(B0, 1, 0); PG8_SCHED; PG8_LDA(At, 1, 0); PG8_STAGE(PG8_SA(0, 1), a2 + hstep, voffA);
            PG8_WAIT_L(8); PG8_BAR; PG8_WAIT_L(0); PG8_MMA(0, 0, At, B0); PG8_BAR; PG8_SCHED;
            PG8_LDB(B1, 1, 1); PG8_STAGE(PG8_SB(1, 0), b3, voffB);
            PG8_BAR; PG8_WAIT_L(0); PG8_MMA(0, 1, At, B1); PG8_BAR;
            PG8_LDA(At, 1, 1); PG8_STAGE(PG8_SA(1, 0), a3, voffA);
            PG8_BAR; PG8_WAIT_L(0); PG8_MMA(1, 0, At, B0); PG8_BAR; PG8_SCHED;
            PG8_STAGE(PG8_SB(1, 1), b3 + hstep, voffB);
            PG8_WAIT_V(6); PG8_BAR; PG8_MMA(1, 1, At, B1); PG8_BAR;
            }
        }
        if constexpr (ALIGN_EPI) { if (wr == 0) PG8_BAR; }
        if constexpr (!Epi::AFTER_DRAIN) { E(acc, cur, wr, wc, fr, fq); S.done(cur); }
        if (!has_next) break;
#pragma unroll
        for (int a = 0; a < 2; ++a)
#pragma unroll
            for (int b = 0; b < 2; ++b)
#pragma unroll
                for (int m = 0; m < 4; ++m)
#pragma unroll
                    for (int n = 0; n < 2; ++n) acc[a][b][m][n] = (f32x4){0.f, 0.f, 0.f, 0.f};
        cur = nxt; cA = nA; cB = nB; kc = (size_t)cur.rot * kstep; ++ui;
        if constexpr (ALIGN_EPI) { if (wr == 1) PG8_BAR; }
    }
    PG8_WAIT_V(0);
    if constexpr (!ALIGN_EPI) { if (wr == 0) PG8_BAR; }
    PG8_BAR;
    if constexpr (Epi::AFTER_DRAIN) { E.fused(acc, cur, wr, wc, fr, fq, lds, wid, lane); S.done(cur); }
#undef PG8_SA
#undef PG8_SB
#undef PG8_STAGE
#undef PG8_LDA
#undef PG8_LDB
#undef PG8_MMA
#undef PG8_WAIT_V
#undef PG8_WAIT_L
#undef PG8_BAR
#undef PG8_SCHED
}
struct FewTileOrder : StaticOrder {
    __host__ __device__ bool next(int i, Unit& u) const { if (!StaticOrder::next(i, u)) return false; u.pm = c & 3; u.pn = (c >> 2) & 7; return true; }
};
template <bool FIXA, bool FIXB> struct ProbeOrder : StaticOrder {
    __host__ __device__ bool next(int i, Unit& u) const { if (!StaticOrder::next(i, u)) return false; if (FIXA) u.pm = 0; if (FIXB) u.pn = 0; return true; }
};
}

#ifndef MK_ONE_LAUNCH
#define MK_ONE_LAUNCH 0
#endif
#ifndef MK_STOP_AFTER
#define MK_STOP_AFTER 99
#endif
constexpr int NWAVES = 8, NTHR = 512;
constexpr int DM = 2048, NB = 4, SEQ = 4096, CTXL = 256, FF = 5504, MODW = 9 * DM;
constexpr int ML = NB * SEQ, MC = NB * CTXL, MT = ML + MC;
constexpr int NGU = 2 * FF;
constexpr int AB_N = 6400, AB_LD = 6144, CD_N = 3072;
constexpr int NCH = 34;
constexpr int USLOT = 272 * 128;
constexpr float EPS = 1e-6f;
constexpr int NPHASE = 26;

constexpr size_t MiB = 1u << 20;
constexpr size_t WS_CTL = 0, CTL_ZERO_BYTES = 2 * MiB;
constexpr size_t WS_MOD = 1 * MiB;
constexpr size_t WS_ROPEC = 2 * MiB, WS_ROPES = 3 * MiB;
constexpr size_t WS_AXC = 4 * MiB, WS_AXS = 4 * MiB + 8192;
constexpr size_t WS_GATES = 5 * MiB;
constexpr size_t WS_SCAL = 7 * MiB;
constexpr size_t WS_AGG = 8 * MiB;
constexpr size_t WS_NSTAT = 24 * MiB;
constexpr int CW_NCNT = 32768;
constexpr size_t WS_XC = 16 * MiB;
constexpr size_t WS_WGU = 32 * MiB;
constexpr size_t WS_WD = 204 * MiB;
constexpr size_t WS_ABWIN = 290 * MiB;
constexpr size_t WS_ABWOUT = 315 * MiB;
constexpr size_t WS_CDWIN = 323 * MiB;
constexpr size_t WS_CDWOUT = 335 * MiB;
constexpr size_t WS_WUQ = 343 * MiB;
constexpr size_t WS_WUKV = 345 * MiB;
constexpr size_t WS_LWT = 346 * MiB;
constexpr size_t WS_XN = 348 * MiB;
constexpr size_t WS_BIG = 416 * MiB;
constexpr size_t WS_A = 620 * MiB;
constexpr size_t WS_KVRAW = 668 * MiB;
constexpr size_t WS_B = 765 * MiB;
constexpr size_t WS_CQN = 765 * MiB, WS_CKVN = 782 * MiB, WS_QF = 791 * MiB, WS_KF = 839 * MiB;
constexpr size_t WS_END = 910 * MiB;
constexpr int CW_BAR = 4096;

constexpr int RING_BYTES = 131072;
constexpr int LDS_BYTES = 159744;
constexpr int MISC_OFF = LDS_BYTES - 256;

#define GAS __attribute__((address_space(1)))
#define LAS __attribute__((address_space(3)))
#define DI __device__ __forceinline__
typedef unsigned short bf16;
typedef unsigned v4u __attribute__((ext_vector_type(4)));
typedef unsigned v2u __attribute__((ext_vector_type(2)));
typedef float f32x4 __attribute__((ext_vector_type(4)));
typedef float f32x2 __attribute__((ext_vector_type(2)));
typedef short bf16x8 __attribute__((ext_vector_type(8)));
typedef short s16x4 __attribute__((ext_vector_type(4)));
typedef GAS unsigned gu32;
#define RLX_AGENT __ATOMIC_RELAXED, __HIP_MEMORY_SCOPE_AGENT
#define LDS_WAIT() asm volatile("s_waitcnt lgkmcnt(0)" ::: "memory")
#define VM_WAIT() asm volatile("s_waitcnt vmcnt(0)" ::: "memory")
DI int lane_id() { int l; asm volatile("v_mbcnt_lo_u32_b32 %0, -1, 0\n\tv_mbcnt_hi_u32_b32 %0, -1, %0" : "=v"(l)); return l; }
DI float bf2f(unsigned h) { return __builtin_bit_cast(float, h << 16); }
DI float bflo(unsigned w) { return __builtin_bit_cast(float, w << 16); }
DI float bfhi(unsigned w) { return __builtin_bit_cast(float, w & 0xffff0000u); }
DI unsigned pk2(float lo, float hi) { return pg8::cvt_pk_bf16(lo, hi); }
DI unsigned short f2bf(float f) { return (unsigned short)(pk2(f, 0.f) & 0xffffu); }
DI float wave_sum(float v) {
#pragma unroll
    for (int o = 1; o < 64; o <<= 1) v += __shfl_xor(v, o);
    return v;
}
DI float wave_max(float v) {
#pragma unroll
    for (int o = 1; o < 64; o <<= 1) v = fmaxf(v, __shfl_xor(v, o));
    return v;
}
DI float sigmoidf_(float x) { return __builtin_amdgcn_rcpf(1.f + __expf(-x)); }
DI float siluf_(float x) { return x * sigmoidf_(x); }
DI float logsigf_(float x) { return fminf(x, 0.f) - log1pf(__expf(-fabsf(x))); }
DI float gelu_tanh(float x) { const float z = 0.7978845608028654f * (x + 0.044715f * x * x * x); const float t = 1.f - 2.f * __builtin_amdgcn_rcpf(1.f + __expf(2.f * z)); return 0.5f * x * (1.f + t); }
DI f32x4 mfma16(bf16x8 a, bf16x8 b, f32x4 c) { return __builtin_amdgcn_mfma_f32_16x16x32_bf16(a, b, c, 0, 0, 0); }
DI bf16x8 frag_row(const LAS unsigned char* base, int stride_b, int row0, int k0, int lane) {
    return *(const LAS bf16x8*)(base + (row0 + (lane & 15)) * stride_b + (k0 + 8 * (lane >> 4)) * 2);
}
DI bf16x8 frag_tr(const LAS unsigned char* base, int stride_b, int ka, int kb, int c0, int lane) {
    const int idx = lane & 15, qq = idx >> 2, p = idx & 3;
    const s16x4 lo = __builtin_amdgcn_ds_read_tr16_b64_v4i16((LAS s16x4*)(base + (ka + qq) * stride_b + (c0 + 4 * p) * 2));
    const s16x4 hi = __builtin_amdgcn_ds_read_tr16_b64_v4i16((LAS s16x4*)(base + (kb + qq) * stride_b + (c0 + 4 * p) * 2));
    bf16x8 o; o[0] = lo[0]; o[1] = lo[1]; o[2] = lo[2]; o[3] = lo[3]; o[4] = hi[0]; o[5] = hi[1]; o[6] = hi[2]; o[7] = hi[3]; return o;
}

DI void glds16(const void* gsrc, unsigned lds_dst) {
    unsigned keep; asm volatile("s_mov_b32 %0, m0\n\ts_mov_b32 m0, %2\n\ts_nop 0\n\tglobal_load_lds_dwordx4 %1, off\n\ts_mov_b32 m0, %0" : "=&s"(keep) : "v"(gsrc), "s"(lds_dst) : "memory");
}
#define XB_TMO      128
#define XB_XCNT(j)  (256  + 64 * (j))
#define XB_XSUB(j)  (1280 + 64 * (j))
#define XB_XGEN(j)  (2304 + 64 * (j))
#define XB_TOP      3328
#define XB_TOPGEN   3392
#define XCD_BAR_WORDS 3456
#define XB_SPIN_CAP (1u << 18)

__device__ __forceinline__ unsigned xb_ld(unsigned* p)              { return __hip_atomic_load(p, __ATOMIC_RELAXED, __HIP_MEMORY_SCOPE_AGENT); }
__device__ __forceinline__ unsigned xb_add(unsigned* p, unsigned v) { return __hip_atomic_fetch_add(p, v, __ATOMIC_RELAXED, __HIP_MEMORY_SCOPE_AGENT); }
__device__ __forceinline__ unsigned xb_xcc_id() { return (unsigned)__builtin_amdgcn_s_getreg((3 << 11) | 20) & 0xFu; }
#define XB_SPIN(cond, bar) do { unsigned _sp = 0; while (cond) { __builtin_amdgcn_s_sleep(1); \
    if ((++_sp & 255u) == 0u) { if (xb_ld(&(bar)[XB_TMO])) break; if (_sp > XB_SPIN_CAP) { atomicAdd(&(bar)[XB_TMO], 1u); break; } } } } while (0)

struct XcdBarrier {
    unsigned* bar; unsigned x; int w;
    volatile LAS unsigned* st;
};

__device__ __forceinline__ XcdBarrier xcd_barrier_post(unsigned* bar, volatile LAS unsigned* st) {
    XcdBarrier b; b.bar = bar; b.x = xb_xcc_id(); b.st = st;
    b.w = __builtin_amdgcn_readfirstlane((int)threadIdx.x >> 6);
    if (threadIdx.x == 0) (void)xb_add(&bar[XB_XCNT(b.x)], 1u);
    return b;
}
__device__ __forceinline__ void xcd_barrier_complete(unsigned* bar, unsigned x, unsigned& nloc, unsigned& nx) {
    const unsigned G = gridDim.x * gridDim.y * gridDim.z;
    unsigned sum, cnt, mine, sp = 0u;
    for (;;) {
        sum = 0u; cnt = 0u; mine = 0u;
#pragma unroll
        for (unsigned j = 0; j < 16; ++j) { const unsigned c = xb_ld(&bar[XB_XCNT(j)]); sum += c; cnt += (c > 0u) ? 1u : 0u; mine = (j == x) ? c : mine; }
        if (sum == G) break;
        __builtin_amdgcn_s_sleep(1);
        if ((++sp & 255u) == 0u) { if (xb_ld(&bar[XB_TMO])) break; if (sp > XB_SPIN_CAP) { atomicAdd(&bar[XB_TMO], 1u); break; } }
    }
    nloc = mine > 0u ? mine : 1u; nx = cnt > 0u ? cnt : 1u;
}

__device__ __forceinline__ void xcd_barrier(const XcdBarrier& b) {
    asm volatile("s_waitcnt vmcnt(0)" ::: "memory");
    __syncthreads();
    if (b.w == 0 && lane_id() == 0) {
        unsigned* bar = b.bar;
        __builtin_amdgcn_s_waitcnt(0);
        unsigned nloc = b.st[0], nx = b.st[1];
        if (nloc == 0u) { xcd_barrier_complete(bar, b.x, nloc, nx); b.st[0] = nloc; b.st[1] = nx; }
        const unsigned old = xb_add(&bar[XB_XSUB(b.x)], 1u);
        const unsigned gen = old / nloc;
        if (old + 1u == (gen + 1u) * nloc) {
            __builtin_amdgcn_fence(__ATOMIC_RELEASE, "agent");
            asm volatile("s_waitcnt vmcnt(0)" ::: "memory");
            const unsigned og = xb_add(&bar[XB_TOP], 1u);
            const unsigned tg = og / nx;
            if (og + 1u == (tg + 1u) * nx) xb_add(&bar[XB_TOPGEN], 1u);
            else XB_SPIN(xb_ld(&bar[XB_TOPGEN]) == tg, bar);
            __builtin_amdgcn_fence(__ATOMIC_ACQUIRE, "agent");
            xb_add(&bar[XB_XGEN(b.x)], 1u);
            asm volatile("s_waitcnt vmcnt(0)" ::: "memory");
        } else {
            XB_SPIN(xb_ld(&bar[XB_XGEN(b.x)]) == gen, bar);
            __builtin_amdgcn_fence(__ATOMIC_ACQUIRE, "agent");
            asm volatile("s_waitcnt vmcnt(0)" ::: "memory");
        }
    }
    __syncthreads();
}


struct Args { const float* in[31]; float* out; unsigned char* ws; int ph_lo, ph_hi; };
enum { I_X = 0, I_C, I_CTX, I_CCTX, I_ADAW, I_ADAB, I_NORMG, I_WG, I_WU, I_WD, I_ABWIN, I_ABWOUT, I_DECAY, I_RETGN, I_GATEB, I_MLGN, I_CDWIN, I_CDWOUT,
       I_CONVW, I_CONVB, I_LWA, I_LBA, I_LWX, I_LBX, I_LAM, I_QNG, I_KVNG, I_WUQ, I_WUK, I_WUV, I_QKNG };

typedef pg8::f32x4 accv;
struct EpiUp {
    static constexpr bool PERM = true, AFTER_DRAIN = false;
    bf16* O;
    DI void operator()(const accv (&acc)[2][2][4][2], const pg8::Unit& u, int wr, int wc, int fr, int fq) const {
        const int row0 = u.pm * 256 + wr * 64 + fr, col0 = u.pn * 128 + wc * 32 + 8 * fq;
#pragma unroll
        for (int ai = 0; ai < 2; ++ai)
#pragma unroll
            for (int m = 0; m < 4; ++m) {
                const accv g0 = acc[ai][0][m][0], g1 = acc[ai][0][m][1], u0 = acc[ai][1][m][0], u1 = acc[ai][1][m][1];
                v4u w;
                w.x = pk2(siluf_(g0[0]) * u0[0], siluf_(g0[1]) * u0[1]); w.y = pk2(siluf_(g0[2]) * u0[2], siluf_(g0[3]) * u0[3]);
                w.z = pk2(siluf_(g1[0]) * u1[0], siluf_(g1[1]) * u1[1]); w.w = pk2(siluf_(g1[2]) * u1[2], siluf_(g1[3]) * u1[3]);
                *(v4u*)(O + (size_t)(row0 + ai * 128 + m * 16) * FF + col0) = w;
            }
    }
};
struct EpiResid {
    static constexpr bool PERM = false, AFTER_DRAIN = false;
    const float* inL; const float* inC; float* outL; float* outC; const float* gate  ; float scale;
    DI void operator()(const accv (&acc)[2][2][4][2], const pg8::Unit& u, int wr, int wc, int fr, int fq) const {
        const bool lat = u.pm < 64;
        const int rloc = (lat ? u.pm * 256 : (u.pm - 64) * 256) + wr * 64 + fr, col0 = u.pn * 256 + wc * 32 + 4 * fq;
        const int bidx = lat ? (u.pm >> 4) : 4;
        const float* ib = lat ? inL : inC; float* ob = lat ? outL : outC;
        accv gv[2][2];
#pragma unroll
        for (int bj = 0; bj < 2; ++bj)
#pragma unroll
            for (int n = 0; n < 2; ++n) gv[bj][n] = *(const accv*)(gate + (size_t)bidx * MODW + col0 + bj * 128 + n * 16) * scale;
#pragma unroll
        for (int ai = 0; ai < 2; ++ai) {
            accv xi[4][2][2];
#pragma unroll
            for (int m = 0; m < 4; ++m) { const size_t ro = (size_t)(rloc + ai * 128 + m * 16) * DM + col0;
#pragma unroll
                for (int bj = 0; bj < 2; ++bj)
#pragma unroll
                    for (int n = 0; n < 2; ++n) xi[m][bj][n] = *(const accv*)(ib + ro + bj * 128 + n * 16); }
            asm volatile("" ::: "memory");
#pragma unroll
            for (int m = 0; m < 4; ++m) { const size_t ro = (size_t)(rloc + ai * 128 + m * 16) * DM + col0;
#pragma unroll
                for (int bj = 0; bj < 2; ++bj)
#pragma unroll
                    for (int n = 0; n < 2; ++n) *(accv*)(ob + ro + bj * 128 + n * 16) = xi[m][bj][n] + gv[bj][n] * acc[ai][bj][m][n]; }
            asm volatile("" ::: "memory");
        }
    }
};
struct EpiResidNorm {
    static constexpr bool PERM = true, AFTER_DRAIN = true;
    const float* inL; float* outL; const float* gate;
    const float* gn; const float* modn; bf16* XN;
    float* xbuf; unsigned* cnt; unsigned* bar;
    float scale;
    DI void fused(accv (&acc)[2][2][4][2], const pg8::Unit& u, int wr, int wc, int fr, int fq, LAS unsigned char* lds, int wid, int lane) const {
        const int rloc = u.pm * 256 + wr * 64 + fr, col0 = u.pn * 256 + wc * 32 + 8 * fq, bidx = u.pm >> 4;
        LAS float* P = (LAS float*)lds;
        LAS float* S = (LAS float*)(lds + 4096);
        {
            accv gv[2][2];
#pragma unroll
            for (int bj = 0; bj < 2; ++bj)
#pragma unroll
                for (int n = 0; n < 2; ++n) gv[bj][n] = *(const accv*)(gate + (size_t)bidx * MODW + col0 + bj * 128 + 4 * n) * scale;
#pragma unroll
            for (int ai = 0; ai < 2; ++ai) {
                accv xi[4][2][2];
#pragma unroll
                for (int m = 0; m < 4; ++m) { const size_t ro = (size_t)(rloc + ai * 128 + m * 16) * DM + col0;
#pragma unroll
                    for (int bj = 0; bj < 2; ++bj)
#pragma unroll
                        for (int n = 0; n < 2; ++n) xi[m][bj][n] = *(const accv*)(inL + ro + bj * 128 + 4 * n); }
                asm volatile("" ::: "memory");
#pragma unroll
                for (int m = 0; m < 4; ++m)
#pragma unroll
                    for (int bj = 0; bj < 2; ++bj)
#pragma unroll
                        for (int n = 0; n < 2; ++n) { acc[ai][bj][m][n] = xi[m][bj][n] + gv[bj][n] * acc[ai][bj][m][n]; asm volatile("" : "+v"(acc[ai][bj][m][n])); }
                asm volatile("" ::: "memory");
            }
        }
#pragma unroll
        for (int ai = 0; ai < 2; ++ai)
#pragma unroll
            for (int m = 0; m < 4; ++m) { float s = 0.f;
#pragma unroll
                for (int bj = 0; bj < 2; ++bj)
#pragma unroll
                    for (int n = 0; n < 2; ++n) { const accv x = acc[ai][bj][m][n]; s += (x[0] * x[0] + x[1] * x[1]) + (x[2] * x[2] + x[3] * x[3]); }
                s += __shfl_xor(s, 16); s += __shfl_xor(s, 32);
                if (fq == 0) P[(ai * 128 + wr * 64 + m * 16 + fr) * 4 + wc] = s; }
        asm volatile("s_waitcnt lgkmcnt(0)" ::: "memory"); __builtin_amdgcn_s_barrier(); asm volatile("" ::: "memory");
        const int row = wid * 32 + (lane & 31);
        if (lane < 32) { const float t = (P[row * 4 + 0] + P[row * 4 + 1]) + (P[row * 4 + 2] + P[row * 4 + 3]);
            __hip_atomic_store(xbuf + ((size_t)u.pm * 256 + row) * 8 + u.pn, t, __ATOMIC_RELAXED, __HIP_MEMORY_SCOPE_AGENT); }
        asm volatile("s_waitcnt vmcnt(0)" ::: "memory");
        if (lane == 0) __hip_atomic_fetch_add(cnt + 64 * u.pm, 1u, __ATOMIC_RELAXED, __HIP_MEMORY_SCOPE_AGENT);
        asm volatile("" ::: "memory");
#pragma unroll
        for (int ai = 0; ai < 2; ++ai)
#pragma unroll
            for (int m = 0; m < 4; ++m) { const size_t ro = (size_t)(rloc + ai * 128 + m * 16) * DM + col0;
#pragma unroll
                for (int bj = 0; bj < 2; ++bj)
#pragma unroll
                    for (int n = 0; n < 2; ++n) *(accv*)(outL + ro + bj * 128 + 4 * n) = acc[ai][bj][m][n]; }
        asm volatile("" ::: "memory");
        if (wid == 0) {
            XB_SPIN((unsigned)__builtin_amdgcn_readfirstlane(xb_ld(cnt + 64 * u.pm)) < 64u, bar);
            __builtin_amdgcn_fence(__ATOMIC_ACQUIRE, "agent");
        }
        asm volatile("s_waitcnt vmcnt(0) lgkmcnt(0)" ::: "memory"); __builtin_amdgcn_s_barrier(); asm volatile("" ::: "memory");
        if (lane < 32) { const float* sl = xbuf + ((size_t)u.pm * 256 + row) * 8;
            const float t0 = __hip_atomic_load(sl + 0, __ATOMIC_RELAXED, __HIP_MEMORY_SCOPE_AGENT), t1 = __hip_atomic_load(sl + 1, __ATOMIC_RELAXED, __HIP_MEMORY_SCOPE_AGENT),
                        t2 = __hip_atomic_load(sl + 2, __ATOMIC_RELAXED, __HIP_MEMORY_SCOPE_AGENT), t3 = __hip_atomic_load(sl + 3, __ATOMIC_RELAXED, __HIP_MEMORY_SCOPE_AGENT),
                        t4 = __hip_atomic_load(sl + 4, __ATOMIC_RELAXED, __HIP_MEMORY_SCOPE_AGENT), t5 = __hip_atomic_load(sl + 5, __ATOMIC_RELAXED, __HIP_MEMORY_SCOPE_AGENT),
                        t6 = __hip_atomic_load(sl + 6, __ATOMIC_RELAXED, __HIP_MEMORY_SCOPE_AGENT), t7 = __hip_atomic_load(sl + 7, __ATOMIC_RELAXED, __HIP_MEMORY_SCOPE_AGENT);
            S[row] = __frsqrt_rn((((t0 + t1) + (t2 + t3)) + ((t4 + t5) + (t6 + t7))) * (1.f / DM) + EPS); }
        accv c1[2][2], c0[2][2];
#pragma unroll
        for (int bj = 0; bj < 2; ++bj)
#pragma unroll
            for (int n = 0; n < 2; ++n) { const int col = col0 + bj * 128 + 4 * n; const accv g4 = *(const accv*)(gn + col), sc4 = *(const accv*)(modn + (size_t)bidx * MODW + DM + col);
                c0[bj][n] = *(const accv*)(modn + (size_t)bidx * MODW + col); c1[bj][n] = g4 * (sc4 + 1.f); }
        asm volatile("s_waitcnt vmcnt(0) lgkmcnt(0)" ::: "memory"); __builtin_amdgcn_s_barrier(); asm volatile("" ::: "memory");
#pragma unroll
        for (int ai = 0; ai < 2; ++ai)
#pragma unroll
            for (int m = 0; m < 4; ++m) { const int r = ai * 128 + wr * 64 + m * 16 + fr; const float rs = S[r]; bf16* orow = XN + (size_t)(u.pm * 256 + r) * DM + col0;
#pragma unroll
                for (int bj = 0; bj < 2; ++bj) { const accv y0 = (acc[ai][bj][m][0] * rs) * c1[bj][0] + c0[bj][0], y1 = (acc[ai][bj][m][1] * rs) * c1[bj][1] + c0[bj][1];
                    v4u w; w.x = pk2(y0[0], y0[1]); w.y = pk2(y0[2], y0[3]); w.z = pk2(y1[0], y1[1]); w.w = pk2(y1[2], y1[3]); *(v4u*)(orow + bj * 128) = w; } }
    }
};
struct EpiPlain {
    static constexpr bool PERM = true, AFTER_DRAIN = false;
    bf16* O; int ldc; int ngelu;
    DI void operator()(const accv (&acc)[2][2][4][2], const pg8::Unit& u, int wr, int wc, int fr, int fq) const {
        const int row0 = u.pm * 256 + wr * 64 + fr, col0 = u.pn * 256 + wc * 32 + 8 * fq; const bool act = u.pn < ngelu;
#pragma unroll
        for (int ai = 0; ai < 2; ++ai)
#pragma unroll
            for (int m = 0; m < 4; ++m)
#pragma unroll
                for (int bj = 0; bj < 2; ++bj) {
                    accv v0 = acc[ai][bj][m][0], v1 = acc[ai][bj][m][1];
                    if (act) {
#pragma unroll
                        for (int e = 0; e < 4; ++e) { v0[e] = gelu_tanh(v0[e]); v1[e] = gelu_tanh(v1[e]); } }
                    v4u w; w.x = pk2(v0[0], v0[1]); w.y = pk2(v0[2], v0[3]); w.z = pk2(v1[0], v1[1]); w.w = pk2(v1[2], v1[3]);
                    *(v4u*)(O + (size_t)(row0 + ai * 128 + m * 16) * ldc + col0 + bj * 128) = w;
                }
    }
};
struct EpiProjAB {
    static constexpr bool PERM = true, AFTER_DRAIN = false;
    bf16* O; float* gates; const float* gate_b; const float* ropec; const float* ropes;
    DI void operator()(const accv (&acc)[2][2][4][2], const pg8::Unit& u, int wr, int wc, int fr, int fq) const {
        const int pn = u.pn, row0 = u.pm * 256 + wr * 64 + fr; const bool lat = u.pm < 64;
        if (pn == 24) {
            if (wc == 0 && fq < 2) {
                const accv b0 = *(const accv*)(gate_b + 8 * fq), b1 = *(const accv*)(gate_b + 8 * fq + 4);
#pragma unroll
                for (int ai = 0; ai < 2; ++ai)
#pragma unroll
                    for (int m = 0; m < 4; ++m) { float* gp = gates + (size_t)(row0 + ai * 128 + m * 16) * 16 + 8 * fq;
                        *(accv*)gp = acc[ai][0][m][0] + b0; *(accv*)(gp + 4) = acc[ai][0][m][1] + b1; }
            }
            return;
        }
        const bool rope = (pn < 4) && lat;
        const float sc = (pn == 2 || pn == 3 || pn == 12 || pn == 13) ? 0.08838834764831845f : 1.f;
        const int actk = (pn >= 8 && pn < 12) ? 1 : ((pn >= 20 && pn < 24) ? 2 : 0);
        const int col0 = pn * 256 + wc * 32 + 8 * fq;
        accv csv[2][4], snv[2][4];
#pragma unroll
        for (int ai = 0; ai < 2; ++ai)
#pragma unroll
            for (int m = 0; m < 4; ++m) { csv[ai][m] = (accv){1.f, 1.f, 1.f, 1.f}; snv[ai][m] = (accv){0.f, 0.f, 0.f, 0.f};
                if (rope) { const int pos = (row0 + ai * 128 + m * 16) & (SEQ - 1); csv[ai][m] = *(const accv*)(ropec + pos * 64 + 16 * wc + 4 * fq); snv[ai][m] = *(const accv*)(ropes + pos * 64 + 16 * wc + 4 * fq); } }
        asm volatile("" ::: "memory");
#pragma unroll
        for (int ai = 0; ai < 2; ++ai)
#pragma unroll
            for (int m = 0; m < 4; ++m) {
                const int row = row0 + ai * 128 + m * 16;
                const accv cs = csv[ai][m], sn = snv[ai][m];
#pragma unroll
                for (int bj = 0; bj < 2; ++bj) {
                    accv v0 = acc[ai][bj][m][0], v1 = acc[ai][bj][m][1];
                    if (rope) { const accv x1 = v0, x2 = v1; v0 = x1 * cs - x2 * sn; v1 = x1 * sn + x2 * cs; }
                    v0 = v0 * sc; v1 = v1 * sc;
                    if (actk == 1) {
#pragma unroll
                        for (int e = 0; e < 4; ++e) { v0[e] = siluf_(v0[e]); v1[e] = siluf_(v1[e]); } }
                    if (actk == 2) {
#pragma unroll
                        for (int e = 0; e < 4; ++e) { v0[e] = sigmoidf_(v0[e]); v1[e] = sigmoidf_(v1[e]); } }
                    v4u w; w.x = pk2(v0[0], v0[1]); w.y = pk2(v0[2], v0[3]); w.z = pk2(v1[0], v1[1]); w.w = pk2(v1[2], v1[3]);
                    *(v4u*)(O + (size_t)row * AB_LD + col0 + bj * 128) = w;
                }
            }
    }
};

struct EpiPartial {
    static constexpr bool PERM = true, AFTER_DRAIN = false;
    bf16* P;
    DI void operator()(const accv (&acc)[2][2][4][2], const pg8::Unit& u, int wr, int wc, int fr, int fq) const {
        const int row0 = u.pm * 256 + wr * 64 + fr, col0 = u.pn * 256 + wc * 32 + 8 * fq;
#pragma unroll
        for (int ai = 0; ai < 2; ++ai)
#pragma unroll
            for (int m = 0; m < 4; ++m) { bf16* rp = P + (size_t)(row0 + ai * 128 + m * 16) * DM + col0;
#pragma unroll
                for (int bj = 0; bj < 2; ++bj) { const accv v0 = acc[ai][bj][m][0], v1 = acc[ai][bj][m][1];
                    v4u w; w.x = pk2(v0[0], v0[1]); w.y = pk2(v0[2], v0[3]); w.z = pk2(v1[0], v1[1]); w.w = pk2(v1[2], v1[3]); *(v4u*)(rp + bj * 128) = w; } }
    }
};

template <bool P> struct EpiNull {
    static constexpr bool PERM = P, AFTER_DRAIN = false;
    float* O;
    DI void operator()(const accv (&acc)[2][2][4][2], const pg8::Unit& u, int wr, int wc, int fr, int fq) const {
        accv s = {0.f, 0.f, 0.f, 0.f};
#pragma unroll
        for (int ai = 0; ai < 2; ++ai)
#pragma unroll
            for (int bj = 0; bj < 2; ++bj)
#pragma unroll
                for (int m = 0; m < 4; ++m)
#pragma unroll
                    for (int n = 0; n < 2; ++n) s = s + acc[ai][bj][m][n];
        *(accv*)(O + (size_t)((wr * 4 + wc) * 64 + fq * 16 + fr) * 4) = s;
    }
};

struct Frame {
    LAS unsigned char* lds;
    int wave, G;
    const Args* a;
};
#define WSP(T, off) ((T*)(A.ws + (off)))
#define TID(F) ((F).wave * 64 + lane_id())

DI void cvt_item(const float* W, int ldw, int K, bf16* WT, int k0, int n0, int srcc, LAS float* scr, int lane) {
    const float* wp = W + (size_t)k0 * ldw + (srcc >= 0 ? srcc : 0);
#pragma unroll
    for (int i = 0; i < 32; ++i) { const int kk = 2 * i + (lane >> 5); scr[kk * 33 + (lane & 31)] = (srcc >= 0) ? wp[(size_t)kk * ldw] : 0.f; }
    LDS_WAIT(); asm volatile("" ::: "memory");
    const int c = lane & 7;
#pragma unroll
    for (int j = 0; j < 4; ++j) { const int n = (lane >> 3) + 8 * j; const LAS float* s = scr + (8 * c) * 33 + n;
        v4u o; o.x = pk2(s[0 * 33], s[1 * 33]); o.y = pk2(s[2 * 33], s[3 * 33]); o.z = pk2(s[4 * 33], s[5 * 33]); o.w = pk2(s[6 * 33], s[7 * 33]);
        *(v4u*)(WT + (size_t)(n0 + n) * K + k0 + 8 * c) = o; }
    LDS_WAIT(); asm volatile("" ::: "memory");
}
DI void cvt_item4(const float* W, int ldw, int K, bf16* WT, int k0, int n0, int srcc0, LAS float* scr, int lane) {
    const int kk8 = lane >> 3, n4 = lane & 7;
    const float* wp = W + (size_t)(k0 + kk8) * ldw + (srcc0 >= 0 ? srcc0 : 0) + 4 * n4;
    f32x4 v[8];
#pragma unroll
    for (int i = 0; i < 8; ++i) v[i] = (srcc0 >= 0) ? *(const f32x4*)(wp + (size_t)(8 * i) * ldw) : (f32x4){0.f, 0.f, 0.f, 0.f};
#pragma unroll
    for (int i = 0; i < 8; ++i) { LAS float* d = scr + (8 * i + kk8) * 33 + 4 * n4; d[0] = v[i].x; d[1] = v[i].y; d[2] = v[i].z; d[3] = v[i].w; }
    LDS_WAIT(); asm volatile("" ::: "memory");
    const int c = lane & 7;
#pragma unroll
    for (int j = 0; j < 4; ++j) { const int n = (lane >> 3) + 8 * j; const LAS float* s = scr + (8 * c) * 33 + n;
        v4u o; o.x = pk2(s[0 * 33], s[1 * 33]); o.y = pk2(s[2 * 33], s[3 * 33]); o.z = pk2(s[4 * 33], s[5 * 33]); o.w = pk2(s[6 * 33], s[7 * 33]);
        *(v4u*)(WT + (size_t)(n0 + n) * K + k0 + 8 * c) = o; }
    LDS_WAIT(); asm volatile("" ::: "memory");
}
DI int rope_src(int p) { const int e = p & 7, hi = (p >> 3) * 4; return e < 4 ? hi + e : 64 + hi + (e - 4); }

DI void phase_pre(const Frame& F, const Args& A, bool do_adaln) {
    const int lane = lane_id(), wave = F.wave, tid = wave * 64 + lane, G = F.G;
    {
        float* rc = WSP(float, WS_ROPEC); float* rs = WSP(float, WS_ROPES); float* ac = WSP(float, WS_AXC); float* as = WSP(float, WS_AXS);
        for (int i = blockIdx.x * NTHR + tid; i < SEQ * 64 + 64 * 16; i += G * NTHR) {
            int pos, k; float fr_;
            if (i < SEQ * 64) { pos = i >> 6; k = i & 63; fr_ = exp2f(-(float)k * (13.287712379549449f / 64.f)); }
            else { const int i2 = i - SEQ * 64; pos = i2 >> 4; k = i2 & 15; fr_ = exp2f(-(float)k * (13.287712379549449f / 16.f)); }
            const float ang = (float)pos * fr_;
            const double rev = (double)ang * 0.15915494309189535; const float fr2 = (float)(rev - rint(rev));
            const float s = __builtin_amdgcn_sinf(fr2), c = __builtin_amdgcn_cosf(fr2);
            if (i < SEQ * 64) { rc[i] = c; rs[i] = s; } else { ac[i - SEQ * 64] = c; as[i - SEQ * 64] = s; }
        }
    }
    if (do_adaln) {
        LAS float* sc = (LAS float*)F.lds;
        LAS float* red = (LAS float*)(F.lds + 40960);
        const float* cc = A.in[I_C]; const float* cx = A.in[I_CCTX];
        for (int i = tid; i < 5 * DM; i += NTHR) { const int r = i / DM, k = i % DM; const float v = r < 4 ? cc[r * DM + k] : cx[k]; sc[i] = siluf_(v); }
        __syncthreads();
        float* MOD = WSP(float, WS_MOD);
        for (int unit = blockIdx.x; unit < 576; unit += G) {
            const int kh = unit & 1, u2 = unit >> 1, l = u2 / 144, n0 = (u2 % 144) * 128;
            const float* W = A.in[I_ADAW] + (size_t)l * DM * MODW + n0 + 2 * lane;
            float acc[5][2];
#pragma unroll
            for (int r = 0; r < 5; ++r) { acc[r][0] = 0.f; acc[r][1] = 0.f; }
            const int kb = kh * 1024 + wave * 128;
#pragma unroll 16
            for (int k = 0; k < 128; ++k) {
                const f32x2 w = *(const f32x2*)(W + (size_t)(kb + k) * MODW);
#pragma unroll
                for (int r = 0; r < 5; ++r) { const float s = sc[r * DM + kb + k]; acc[r][0] += s * w.x; acc[r][1] += s * w.y; }
            }
#pragma unroll
            for (int r = 0; r < 5; ++r) { red[(wave * 5 + r) * 128 + 2 * lane] = acc[r][0]; red[(wave * 5 + r) * 128 + 2 * lane + 1] = acc[r][1]; }
            __syncthreads();
            for (int i = tid; i < 640; i += NTHR) { const int r = i >> 7, c = i & 127; float s = kh ? 0.f : A.in[I_ADAB][l * MODW + n0 + c];
#pragma unroll
                for (int w = 0; w < 8; ++w) s += red[(w * 5 + r) * 128 + c];
                atomicAdd(&MOD[(size_t)(l * 5 + r) * MODW + n0 + c], s); }
            __syncthreads();
        }
    }
    {
        LAS float* scr = (LAS float*)(F.lds + wave * 8448);
        const int gw = blockIdx.x * NWAVES + wave, NGW = G * NWAVES;
        constexpr int I_GU = 32 * (NGU / 32), I_D = (FF / 64) * (DM / 32), I_ABI = 32 * (AB_N / 32), I_SQ = 32 * 64, I_CDI = 32 * (CD_N / 32), I_UQ = 8 * 48, I_UKV = 4 * 64, I_LW = 2 * 4;
        constexpr int NITEMS = 4 * I_GU + 4 * I_D + I_ABI + I_SQ + I_CDI + I_SQ + I_UQ + I_UKV + 32 * I_LW;
        for (int it = gw; it < NITEMS; it += NGW) {
            int r = it;
            if (r < 4 * I_GU) { const int q = r / I_GU; r -= q * I_GU; const int nbk = NGU / 32, kb = r / nbk, nb = r % nbk;
                const float* W = (((32 * nb) & 255) < 128 ? A.in[I_WG] : A.in[I_WU]) + (size_t)q * DM * FF;
                cvt_item4(W, FF, DM, WSP(bf16, WS_WGU) + (size_t)q * NGU * DM, 64 * kb, 32 * nb, (nb >> 3) * 128 + ((32 * nb) & 127), scr, lane); continue; }
            r -= 4 * I_GU;
            if (r < 4 * I_D) { const int q = r / I_D; r -= q * I_D; const int nbk = DM / 32, kb = r / nbk, nb = r % nbk;
                cvt_item4(A.in[I_WD] + (size_t)q * FF * DM, DM, FF, WSP(bf16, WS_WD) + (size_t)q * DM * FF, 64 * kb, 32 * nb, 32 * nb, scr, lane); continue; }
            r -= 4 * I_D;
            if (r < I_ABI) { const int nbk = AB_N / 32, kb = r / nbk, nb = r % nbk, R = 32 * nb + (lane & 31), tile = R >> 8;
                int src = R;
                if (tile < 4 || (tile >= 12 && tile < 16)) src = (R & ~127) + rope_src(R & 127);
                if (R >= 6160) src = -1;
                cvt_item(A.in[I_ABWIN], 6160, DM, WSP(bf16, WS_ABWIN), 64 * kb, 32 * nb, src, scr, lane); continue; }
            r -= I_ABI;
            if (r < I_SQ) { const int kb = r / 64, nb = r % 64; cvt_item4(A.in[I_ABWOUT], DM, DM, WSP(bf16, WS_ABWOUT), 64 * kb, 32 * nb, 32 * nb, scr, lane); continue; }
            r -= I_SQ;
            if (r < I_CDI) { const int nbk = CD_N / 32, kb = r / nbk, nb = r % nbk, R = 32 * nb + (lane & 31);
                cvt_item4(A.in[I_CDWIN], 2880, DM, WSP(bf16, WS_CDWIN), 64 * kb, 32 * nb, 32 * nb < 2880 ? 32 * nb : -1, scr, lane); continue; }
            r -= I_CDI;
            if (r < I_SQ) { const int kb = r / 64, nb = r % 64; cvt_item4(A.in[I_CDWOUT], DM, DM, WSP(bf16, WS_CDWOUT), 64 * kb, 32 * nb, 32 * nb, scr, lane); continue; }
            r -= I_SQ;
            if (r < I_UQ) { const int kb = r / 48, nb = r % 48; cvt_item4(A.in[I_WUQ], 1536, 512, WSP(bf16, WS_WUQ), 64 * kb, 32 * nb, 32 * nb, scr, lane); continue; }
            r -= I_UQ;
            if (r < I_UKV) { const int kb = r / 64, nb = r % 64, R = 32 * nb + (lane & 31);
                cvt_item4(nb < 32 ? A.in[I_WUK] : A.in[I_WUV], 1024, 256, WSP(bf16, WS_WUKV), 64 * kb, 32 * nb, (32 * nb) & 1023, scr, lane); continue; }
            r -= I_UKV;
            { const int mg = r / I_LW; r -= mg * I_LW; const int mat = mg >> 3, g = mg & 7, kb = r / 4, nb = r % 4;
              const float* W = ((mat & 1) ? A.in[I_LWX] : A.in[I_LWA]) + (size_t)((mat >> 1) * 8 + g) * 128 * 128;
              cvt_item4(W, 128, 128, WSP(bf16, WS_LWT) + (size_t)mg * 128 * 128, 64 * kb, 32 * nb, 32 * nb, scr, lane); }
        }
    }
}

struct CtxFix { const float* cin; const bf16* part; const float* gate; float scale; };
DI void phase_norm(const Frame& F, const Args& A, int l, int which, int nrows, bool first, const CtxFix cf, int rbase = 0) {
    const int lane = lane_id(), gw = blockIdx.x * NWAVES + F.wave, NGW = F.G * NWAVES;
    const f32x4* gn = (const f32x4*)(A.in[I_NORMG] + (size_t)(l * 3 + which) * DM);
    const float* XL = first ? A.in[I_X] : A.out; const float* XC = first ? A.in[I_CTX] : WSP(float, WS_XC);
    const float* MOD = WSP(float, WS_MOD); bf16* XN = WSP(bf16, WS_XN);
    f32x4 g[8];
#pragma unroll
    for (int j = 0; j < 4; ++j) { g[2 * j] = gn[2 * lane + 128 * j]; g[2 * j + 1] = gn[2 * lane + 128 * j + 1]; }
    f32x4 nv[8];
#define NORM_SIMPLE(r_) ((r_) < ML || cf.part == nullptr)
#define NORM_LOAD(r_) do { const f32x4* xr_ = (const f32x4*)((r_) < ML ? XL + (size_t)(r_) * DM : XC + (size_t)((r_) - ML) * DM) + 2 * lane; _Pragma("unroll") for (int j = 0; j < 4; ++j) { nv[2 * j] = xr_[128 * j]; nv[2 * j + 1] = xr_[128 * j + 1]; } } while (0)
    if (rbase + gw < nrows && NORM_SIMPLE(rbase + gw)) NORM_LOAD(rbase + gw);
    for (int row = rbase + gw; row < nrows; row += NGW) {
        const bool lat = row < ML;
        const int bidx = lat ? (row >> 12) : 4;
        const f32x4* shp = (const f32x4*)(MOD + (size_t)(l * 5 + bidx) * MODW + (3 * which) * DM) + 2 * lane; const f32x4* scp = shp + DM / 4;
        f32x4 v[8]; float ss = 0.f;
        if (NORM_SIMPLE(row)) {
#pragma unroll
            for (int j = 0; j < 8; ++j) v[j] = nv[j];
        } else {
            const size_t ro = (size_t)(row - ML) * DM; const f32x4* xr = (const f32x4*)(cf.cin + ro) + 2 * lane; const f32x4* gt = (const f32x4*)cf.gate + 2 * lane;
            f32x4* xo = (f32x4*)(WSP(float, WS_XC) + ro) + 2 * lane;
#pragma unroll
            for (int jj = 0; jj < 4; ++jj) { f32x4 s0 = {0.f, 0.f, 0.f, 0.f}, s1 = {0.f, 0.f, 0.f, 0.f};
#pragma unroll
                for (int k = 0; k < 8; ++k) { const v4u pw = *((const v4u*)(cf.part + (size_t)k * MC * DM + ro) + lane + 64 * jj);
                    s0 = s0 + (f32x4){bflo(pw.x), bfhi(pw.x), bflo(pw.y), bfhi(pw.y)}; s1 = s1 + (f32x4){bflo(pw.z), bfhi(pw.z), bflo(pw.w), bfhi(pw.w)}; }
                v[2 * jj] = xr[128 * jj] + gt[128 * jj] * s0 * cf.scale; v[2 * jj + 1] = xr[128 * jj + 1] + gt[128 * jj + 1] * s1 * cf.scale; }
            asm volatile("" ::: "memory");
#pragma unroll
            for (int j = 0; j < 8; ++j) xo[128 * (j >> 1) + (j & 1)] = v[j];
        }
        { const int nr = row + NGW; if (nr < nrows && NORM_SIMPLE(nr)) NORM_LOAD(nr); }
#pragma unroll
        for (int j = 0; j < 8; ++j) ss += (v[j].x * v[j].x + v[j].y * v[j].y) + (v[j].z * v[j].z + v[j].w * v[j].w);
        const float rs = __frsqrt_rn(wave_sum(ss) * (1.f / DM) + EPS);
        v4u* o16 = (v4u*)(XN + (size_t)row * DM) + lane;
        f32x4 cs_[8], ch_[8];
#pragma unroll
        for (int j = 0; j < 4; ++j) { cs_[2 * j] = scp[128 * j]; cs_[2 * j + 1] = scp[128 * j + 1]; ch_[2 * j] = shp[128 * j]; ch_[2 * j + 1] = shp[128 * j + 1]; }
        asm volatile("" ::: "memory");
#pragma unroll
        for (int j = 0; j < 4; ++j) { const f32x4 y0 = (v[2 * j] * rs) * g[2 * j] * (cs_[2 * j] + 1.f) + ch_[2 * j], y1 = (v[2 * j + 1] * rs) * g[2 * j + 1] * (cs_[2 * j + 1] + 1.f) + ch_[2 * j + 1];
            v4u w; w.x = pk2(y0.x, y0.y); w.y = pk2(y0.z, y0.w); w.z = pk2(y1.x, y1.y); w.w = pk2(y1.z, y1.w); o16[64 * j] = w; }
    }
#undef NORM_SIMPLE
#undef NORM_LOAD
}

DI int chunk_row0(int b, int j) { return j < 2 ? ML + b * CTXL + 128 * j : b * SEQ + 128 * (j - 2); }
DI int us_slot(int b, int h, int mx, int j, int d) { return ((((b * 4 + h) * 2 + mx) * NCH + j) * 2 + d); }
DI int sc_idx(int b, int h, int d, int j) { return ((b * 4 + h) * 2 + d) * NCH + j; }
constexpr int LV_STRIDE = 544, LK_STRIDE = 272, LKT_STRIDE = 288;
DI void mlstm_gate_scan(const float* gates, int R0, int h, int d, int lane, float (&Av)[2], float (&Bv)[2], int (&cpos)[2], float& blast) {
    float iv[2], lf[2];
#pragma unroll
    for (int t = 0; t < 2; ++t) { const int e = 2 * lane + t; cpos[t] = d ? 127 - e : e; const float* g = gates + (size_t)(R0 + cpos[t]) * 16 + d * 8 + h; iv[t] = g[0]; lf[t] = logsigf_(g[4]); }
    float s = lf[0] + lf[1], inc = s;
#pragma unroll
    for (int o = 1; o < 64; o <<= 1) { const float t = __shfl_up(inc, o); if (lane >= o) inc += t; }
    const float exc = inc - s;
    Bv[0] = exc + lf[0]; Bv[1] = exc + s; Av[0] = iv[0] - Bv[0]; Av[1] = iv[1] - Bv[1];
    blast = __shfl(inc, 63);
}

DI void phase_m1(const Frame& F, const Args& A) {
    const int lane = lane_id(), wave = F.wave, tid = wave * 64 + lane, r16 = lane & 15, q4 = lane >> 4;
    LAS unsigned char* LV = F.lds; LAS unsigned char* LKf = F.lds + 71680; LAS unsigned char* LKb = LKf + 36864;
    LAS float* TW = (LAS float*)(LKb + 36864);
    const bf16* PROJ = WSP(bf16, WS_BIG); const float* GATES = WSP(float, WS_GATES); bf16* U = WSP(bf16, WS_A); float* SCAL = WSP(float, WS_SCAL);
    for (int unit = blockIdx.x; unit < NB * 4 * 2 * NCH; unit += F.G) {
        const int j = unit % NCH, t_ = unit / NCH, mx = t_ & 1, h = (t_ >> 1) & 3, b = t_ >> 3;
        const int R0 = chunk_row0(b, j);
        const int kcol = mx ? 3584 + 128 * h : 512 + 128 * h, vcol = mx ? 4096 + 256 * h : 1024 + 256 * h;
        v4u kst[4], vst[8];
#pragma unroll
        for (int x = 0; x < 8; ++x) { const int i = tid + NTHR * x, rr = i >> 5, c = i & 31; vst[x] = *(const v4u*)(PROJ + (size_t)(R0 + rr) * AB_LD + vcol + 8 * c); }
#pragma unroll
        for (int x = 0; x < 4; ++x) { const int i = tid + NTHR * x, rr = i >> 4, c = i & 15; kst[x] = *(const v4u*)(PROJ + (size_t)(R0 + rr) * AB_LD + kcol + 8 * c); }
        asm volatile("" ::: "memory");
        if (mx == 0) {
            if (tid < 128) { const float lgf = logsigf_(A.in[I_DECAY][h]), lgb = logsigf_(A.in[I_DECAY][4 + h]); TW[tid] = __expf((float)(127 - tid) * lgf); TW[128 + tid] = __expf((float)tid * lgb); }
        } else if (wave < 2) {
            const int d = wave; float Av[2], Bv[2], blast; int cp[2];
            mlstm_gate_scan(GATES, R0, h, d, lane, Av, Bv, cp, blast);
            const float mA = wave_max(fmaxf(Av[0], Av[1]));
            TW[d * 128 + cp[0]] = __expf(Av[0] - mA); TW[d * 128 + cp[1]] = __expf(Av[1] - mA);
            if (lane == 0) { SCAL[sc_idx(b, h, d, j)] = blast + mA; SCAL[2048 + sc_idx(b, h, d, j)] = blast; }
        }
        __syncthreads();
#pragma unroll
        for (int x = 0; x < 8; ++x) { const int i = tid + NTHR * x, rr = i >> 5, c = i & 31; *(LAS v4u*)(LV + rr * LV_STRIDE + c * 16) = vst[x]; }
        if (tid < 128) { unsigned z0 = 0u; asm volatile("" : "+v"(z0)); v4u one = {z0 + 0x3F80u, z0, z0, z0}, zero = {z0, z0, z0, z0}; *(LAS v4u*)(LV + tid * LV_STRIDE + 512) = one; *(LAS v4u*)(LV + tid * LV_STRIDE + 528) = zero; }
#pragma unroll
        for (int x = 0; x < 4; ++x) { const int i = tid + NTHR * x, rr = i >> 4, c = i & 15; const v4u kv = kst[x];
            const float wf = TW[rr], wb = TW[128 + rr]; v4u of, ob;
            of.x = pk2(bflo(kv.x) * wf, bfhi(kv.x) * wf); of.y = pk2(bflo(kv.y) * wf, bfhi(kv.y) * wf); of.z = pk2(bflo(kv.z) * wf, bfhi(kv.z) * wf); of.w = pk2(bflo(kv.w) * wf, bfhi(kv.w) * wf);
            ob.x = pk2(bflo(kv.x) * wb, bfhi(kv.x) * wb); ob.y = pk2(bflo(kv.y) * wb, bfhi(kv.y) * wb); ob.z = pk2(bflo(kv.z) * wb, bfhi(kv.z) * wb); ob.w = pk2(bflo(kv.w) * wb, bfhi(kv.w) * wb);
            *(LAS v4u*)(LKf + rr * LKT_STRIDE + c * 16) = of; *(LAS v4u*)(LKb + rr * LKT_STRIDE + c * 16) = ob; }
        __syncthreads();
#pragma unroll 1
        for (int d = 0; d < 2; ++d) {
            const LAS unsigned char* LK = d ? LKb : LKf;
            f32x4 acc[17];
#pragma unroll
            for (int c = 0; c < 17; ++c) acc[c] = (f32x4){0.f, 0.f, 0.f, 0.f};
            bf16x8 ka[2], vb[2][17];
#define M1_LOAD(buf_, s_) do { ka[buf_] = frag_tr(LK, LKT_STRIDE, 32 * (s_) + 8 * q4, 32 * (s_) + 8 * q4 + 4, 16 * wave, lane); \
                _Pragma("unroll") for (int c = 0; c < 17; ++c) vb[buf_][c] = frag_tr(LV, LV_STRIDE, 32 * (s_) + 8 * q4, 32 * (s_) + 8 * q4 + 4, 16 * c, lane); } while (0)
            M1_LOAD(0, 0);
#pragma unroll
            for (int s = 0; s < 4; ++s) {
                if (s < 3) M1_LOAD((s + 1) & 1, s + 1);
#pragma unroll
                for (int c = 0; c < 17; ++c) acc[c] = mfma16(ka[s & 1], vb[s & 1][c], acc[c]);
                __builtin_amdgcn_sched_barrier(0);
            }
#undef M1_LOAD
            bf16* Ub = U + (size_t)us_slot(b, h, mx, j, d) * USLOT;
#pragma unroll
            for (int c = 0; c < 17; ++c) { v2u w; w.x = pk2(acc[c][0], acc[c][1]); w.y = pk2(acc[c][2], acc[c][3]); *(v2u*)(Ub + (16 * c + r16) * 128 + 16 * wave + 4 * q4) = w; }
        }
        __syncthreads();
    }
}

DI void phase_m2(const Frame& F, const Args& A) {
    const v4u* U = WSP(const v4u, WS_A); v4u* S = WSP(v4u, WS_B); float* SCAL = WSP(float, WS_SCAL);
    constexpr int V8 = USLOT / 8, V8I = 257 * 16, NIT = 64 * V8I, NI = 3;
    const int t0 = blockIdx.x * NTHR + TID(F), NT = F.G * NTHR;
    float st[NI][8], m[NI], aret[NI]; int seqb[NI], e8[NI], dd[NI], mxx[NI], scb[NI]; bool ok[NI];
#pragma unroll
    for (int ii = 0; ii < NI; ++ii) { const int it = t0 + ii * NT; ok[ii] = it < NIT; const int itc = ok[ii] ? it : 0;
        const int seq = itc / V8I; e8[ii] = itc % V8I; const int d = seq & 1, mx = (seq >> 1) & 1, h = (seq >> 2) & 3, b = seq >> 4;
        dd[ii] = d; mxx[ii] = mx; seqb[ii] = (((b * 4 + h) * 2 + mx) * NCH) * 2 + d; scb[ii] = ((b * 4 + h) * 2 + d) * NCH; m[ii] = -1e30f;
        aret[ii] = __expf(128.f * logsigf_(A.in[I_DECAY][d * 4 + h]));
#pragma unroll
        for (int e = 0; e < 8; ++e) st[ii][e] = 0.f; }
#define M2_J(dir_, k_) ((dir_) ? ((k_) == 0 ? 1 : ((k_) == 1 ? 0 : 35 - (k_))) : (k_))
    v4u un[NI]; float mln[NI], bln[NI];
#pragma unroll
    for (int ii = 0; ii < NI; ++ii) { mln[ii] = 0.f; bln[ii] = 0.f; if (ok[ii]) { const int j0 = M2_J(dd[ii], 0); un[ii] = U[(size_t)(seqb[ii] + 2 * j0) * V8 + e8[ii]]; if (mxx[ii]) { mln[ii] = SCAL[scb[ii] + j0]; bln[ii] = SCAL[2048 + scb[ii] + j0]; } } }
#pragma unroll 1
    for (int k = 0; k < NCH; ++k) {
        v4u u[NI]; float mlc[NI], blc[NI];
#pragma unroll
        for (int ii = 0; ii < NI; ++ii) { u[ii] = un[ii]; mlc[ii] = mln[ii]; blc[ii] = bln[ii];
            if (ok[ii] && k + 1 < NCH) { const int j1 = M2_J(dd[ii], k + 1); un[ii] = U[(size_t)(seqb[ii] + 2 * j1) * V8 + e8[ii]]; if (mxx[ii]) { mln[ii] = SCAL[scb[ii] + j1]; bln[ii] = SCAL[2048 + scb[ii] + j1]; } } }
#pragma unroll
        for (int ii = 0; ii < NI; ++ii) if (ok[ii]) {
            const int j = M2_J(dd[ii], k); const size_t slot = (size_t)(seqb[ii] + 2 * j) * V8 + e8[ii];
            float a = aret[ii], g = 1.f;
            if (mxx[ii]) { const int si = scb[ii] + j; const float ml = mlc[ii], bl = blc[ii]; const float mn = fmaxf(bl + m[ii], ml);
                a = __expf(bl + m[ii] - mn); g = __expf(ml - mn); if (e8[ii] == 0) SCAL[4096 + si] = m[ii]; m[ii] = mn; }
            v4u o; o.x = pk2(st[ii][0], st[ii][1]); o.y = pk2(st[ii][2], st[ii][3]); o.z = pk2(st[ii][4], st[ii][5]); o.w = pk2(st[ii][6], st[ii][7]); S[slot] = o;
            st[ii][0] = a * st[ii][0] + g * bflo(u[ii].x); st[ii][1] = a * st[ii][1] + g * bfhi(u[ii].x); st[ii][2] = a * st[ii][2] + g * bflo(u[ii].y); st[ii][3] = a * st[ii][3] + g * bfhi(u[ii].y);
            st[ii][4] = a * st[ii][4] + g * bflo(u[ii].z); st[ii][5] = a * st[ii][5] + g * bfhi(u[ii].z); st[ii][6] = a * st[ii][6] + g * bflo(u[ii].w); st[ii][7] = a * st[ii][7] + g * bfhi(u[ii].w);
        }
    }
#undef M2_J
}

template <int MX, int VAR = 0> DI void m3_unit(const Frame& F, const Args& A, int b, int h, int j, bf16* MRG) {
    const int tid = TID(F);
    const int lane = tid & 63, wave = F.wave, r16 = lane & 15, q4 = lane >> 4;
    LAS unsigned char* LV = F.lds; LAS unsigned char* LS = F.lds + 71680;
    LAS float* TB = (LAS float*)(F.lds + 71680 + 73984);
    const bf16* PROJ = WSP(bf16, WS_BIG); const v4u* S = WSP(const v4u, WS_B);
    constexpr int mx = MX;
    const int R0 = chunk_row0(b, j);
    const int qcol = mx ? 3072 + 128 * h : 128 * h, kcol = mx ? 3584 + 128 * h : 512 + 128 * h, vcol = mx ? 4096 + 256 * h : 1024 + 256 * h, gcol = mx ? 5120 + 256 * h : 2048 + 256 * h;
    const float lgf = logsigf_(A.in[I_DECAY][h]), lgb = logsigf_(A.in[I_DECAY][4 + h]);
    const int myq = 16 * wave + r16;
    v4u kst[4], vst[8]; bf16x8 qf[4];
#pragma unroll
    for (int x = 0; x < 4; ++x) { const int i = tid + NTHR * x, rr = i >> 4, c = i & 15; kst[x] = *(const v4u*)(PROJ + (size_t)(R0 + rr) * AB_LD + kcol + 8 * c); }
#pragma unroll
    for (int x = 0; x < 8; ++x) { const int i = tid + NTHR * x, rr = i >> 5, c = i & 31; vst[x] = *(const v4u*)(PROJ + (size_t)(R0 + rr) * AB_LD + vcol + 8 * c); }
#pragma unroll
    for (int s = 0; s < 4; ++s) qf[s] = *(const bf16x8*)(PROJ + (size_t)(R0 + myq) * AB_LD + qcol + 32 * s + 8 * q4);
    asm volatile("" ::: "memory");
    if (mx == 0) {
        if (tid < 128) { TB[3 * 128 + tid] = __expf((float)(tid + 1) * lgf); TB[(4 + 3) * 128 + tid] = __expf((float)(128 - tid) * lgb); }
    } else if (wave < 2) {
        const int d = wave; float Av[2], Bv[2], blast; int cp[2];
        mlstm_gate_scan(WSP(float, WS_GATES), R0, h, d, lane, Av, Bv, cp, blast);
        const float mprev = WSP(float, WS_SCAL)[4096 + sc_idx(b, h, d, j)];
        float inc = fmaxf(Av[0], Av[1]);
#pragma unroll
        for (int o = 1; o < 64; o <<= 1) { const float t = __shfl_up(inc, o); if (lane >= o) inc = fmaxf(inc, t); }
        float prev = __shfl_up(inc, 1); if (lane == 0) prev = -3.0e38f;
        const float rm0 = fmaxf(prev, Av[0]), rm1 = inc;
        const float M0 = fmaxf(mprev, rm0), M1 = fmaxf(mprev, rm1);
        LAS float* T = TB + d * 4 * 128;
        T[cp[0]] = Av[0]; T[cp[1]] = Av[1]; T[128 + cp[0]] = M0; T[128 + cp[1]] = M1; T[256 + cp[0]] = Bv[0]; T[256 + cp[1]] = Bv[1];
        T[384 + cp[0]] = __expf(mprev - M0); T[384 + cp[1]] = __expf(mprev - M1);
    }
#pragma unroll
    for (int x = 0; x < 4; ++x) { const int i = tid + NTHR * x, rr = i >> 4, c = i & 15; *(LAS v4u*)(LS + rr * LK_STRIDE + c * 16) = kst[x]; }
#pragma unroll
    for (int x = 0; x < 8; ++x) { const int i = tid + NTHR * x, rr = i >> 5, c = i & 31; *(LAS v4u*)(LV + rr * LV_STRIDE + c * 16) = vst[x]; }
    if (tid < 128) { unsigned z0 = 0u; asm volatile("" : "+v"(z0)); v4u one = {z0 + 0x3F80u, z0, z0, z0}, zero = {z0, z0, z0, z0}; *(LAS v4u*)(LV + tid * LV_STRIDE + 512) = one; *(LAS v4u*)(LV + tid * LV_STRIDE + 528) = zero; }
    const unsigned ls_lds = (unsigned)(size_t)LS;
#define M3_DMA_S(d_, hi_) do { const v4u* Sp_ = S + (size_t)us_slot(b, h, mx, j, (d_)) * (USLOT / 8); const int p0_ = (hi_) ? 2176 : 0, lim_ = (hi_) ? 4624 : 2176; \
        _Pragma("unroll 1") for (int ins = wave; ins < ((hi_) ? 39 : 34); ins += 8) { { const int p = p0_ + ins * 64 + lane; if (p < lim_) { const int rr = p / 17, c0_ = p - rr * 17, c = c0_ == 16 ? 0 : c0_; \
            glds16(Sp_ + rr * 16 + c, ls_lds + (unsigned)(p0_ + ins * 64) * 16u); } } } } while (0)
    __syncthreads();
    asm volatile("" : "+v"(qf[0]), "+v"(qf[1]), "+v"(qf[2]), "+v"(qf[3]));
    if (!(VAR & 1)) M3_DMA_S(0, 1);
    f32x4 sc[8];
#pragma unroll
    for (int c = 0; c < 8; ++c) { sc[c] = (f32x4){0.f, 0.f, 0.f, 0.f};
#pragma unroll
        for (int s = 0; s < 4; ++s) sc[c] = mfma16(frag_row(LS, LK_STRIDE, 16 * c, 32 * s, lane), qf[s], sc[c]); }
    f32x4 hs[16];
    { float z0 = 0.f; asm volatile("" : "+v"(z0), "+v"(sc[7][3]));
#pragma unroll
      for (int c = 0; c < 16; ++c) hs[c] = (f32x4){z0, z0, z0, z0}; }
    asm volatile("s_waitcnt vmcnt(0)" ::: "memory");
    __syncthreads();
#pragma unroll 1
    for (int d = 0; d < 2; ++d) {
        const LAS float* T = TB + d * 4 * 128;
        const float sdq = T[384 + myq], Mq = mx ? T[128 + myq] : 0.f, Bq = mx ? T[256 + myq] : 0.f;
        const float lg2 = (d ? lgb : lgf) * 1.4426950408889634f;
        float inv = 1.f;
#pragma unroll
        for (int half = 0; half < 2; ++half) {
            constexpr int NTL[2] = {9, 8}; const int c0 = half ? 0 : 8;
            if (!(VAR & 1)) { if (half == 0) M3_DMA_S(d, 0); else if (d == 0) M3_DMA_S(1, 1); }
            int myq_d = myq, q4_d = q4; float sdq_d = sdq; asm volatile("" : "+v"(myq_d), "+v"(q4_d), "+v"(sdq_d));
            f32x4 acc[9];
#pragma unroll
            for (int c = 0; c < 9; ++c) acc[c] = (f32x4){0.f, 0.f, 0.f, 0.f};
#pragma unroll
            for (int s = 0; s < ((VAR & 2) ? 0 : 4); ++s) {
                float pv[8];
#pragma unroll
                for (int jj = 0; jj < 8; ++jj) { const int c = 2 * s + (jj >> 2), i = jj & 3, key = 16 * c + 4 * q4_d + i;
                    const bool valid = d ? (key >= myq_d) : (key <= myq_d);
                    float w;
                    if (mx == 0) w = __builtin_amdgcn_exp2f((float)(d ? key - myq_d : myq_d - key) * lg2); else w = __expf(T[key] - Mq);
                    pv[jj] = valid ? sc[c][i] * w : 0.f; }
                v4u pw; pw.x = pk2(pv[0], pv[1]); pw.y = pk2(pv[2], pv[3]); pw.z = pk2(pv[4], pv[5]); pw.w = pk2(pv[6], pv[7]);
                const bf16x8 pf = __builtin_bit_cast(bf16x8, pw);
                const v4u qw = __builtin_bit_cast(v4u, qf[s]); v4u qs;
                qs.x = pk2(bflo(qw.x) * sdq_d, bfhi(qw.x) * sdq_d); qs.y = pk2(bflo(qw.y) * sdq_d, bfhi(qw.y) * sdq_d); qs.z = pk2(bflo(qw.z) * sdq_d, bfhi(qw.z) * sdq_d); qs.w = pk2(bflo(qw.w) * sdq_d, bfhi(qw.w) * sdq_d);
                const bf16x8 qd = __builtin_bit_cast(bf16x8, qs);
#pragma unroll
                for (int c = 0; c < NTL[half]; ++c) {
                    acc[c] = mfma16(frag_tr(LV, LV_STRIDE, 32 * s + 4 * q4, 32 * s + 16 + 4 * q4, 16 * (c0 + c), lane), pf, acc[c]);
                    acc[c] = mfma16(frag_row(LS, LK_STRIDE, 16 * (c0 + c), 32 * s, lane), qd, acc[c]);
                    if (c % 2 == 1) __builtin_amdgcn_sched_barrier(0);
                }
                __builtin_amdgcn_sched_barrier(0);
            }
            if (half == 0 && mx == 1) { const float den = __shfl(acc[8][0], r16);
                inv = 1.f / fmaxf(fabsf(den), __expf(-(Bq + Mq))); }
#pragma unroll
            for (int c = 0; c < 8; ++c) hs[c0 + c] = hs[c0 + c] + acc[c] * inv;
            asm volatile("s_waitcnt vmcnt(0)" ::: "memory");
            __syncthreads();
        }
    }
#undef M3_DMA_S
    float s1 = 0.f;
#pragma unroll
    for (int c = 0; c < 16; ++c) s1 += (hs[c][0] + hs[c][1]) + (hs[c][2] + hs[c][3]);
    s1 += __shfl_xor(s1, 16); s1 += __shfl_xor(s1, 32);
    const float mu = s1 * (1.f / 256.f); float s2 = 0.f;
#pragma unroll
    for (int c = 0; c < 16; ++c) { const f32x4 dd = hs[c] - mu; s2 += (dd[0] * dd[0] + dd[1] * dd[1]) + (dd[2] * dd[2] + dd[3] * dd[3]); }
    s2 += __shfl_xor(s2, 16); s2 += __shfl_xor(s2, 32);
    const float rstd = __frsqrt_rn(s2 * (1.f / 256.f) + EPS);
    const float* gn = (mx ? A.in[I_MLGN] : A.in[I_RETGN]) + h * 256;
    const size_t row = (size_t)(R0 + myq);
    v2u gwv[16]; f32x4 gnv[16];
#pragma unroll
    for (int c = 0; c < 16; ++c) { gwv[c] = *(const v2u*)(PROJ + row * AB_LD + gcol + 16 * c + 4 * q4); gnv[c] = *(const f32x4*)(gn + 16 * c + 4 * q4); }
    asm volatile("" ::: "memory");
#pragma unroll
    for (int c = 0; c < ((VAR & 8) ? 1 : 16); ++c) { const int dv = 16 * c + 4 * q4;
        const f32x4 g4 = gnv[c]; const v2u gw = gwv[c];
        const f32x4 y = (hs[c] - mu) * rstd * g4;
        v2u w; w.x = pk2(y[0] * bflo(gw.x), y[1] * bfhi(gw.x)); w.y = pk2(y[2] * bflo(gw.y), y[3] * bfhi(gw.y));
        *(v2u*)(MRG + row * DM + mx * 1024 + h * 256 + dv) = w; }
}
template <int VAR> DI void phase_m3(const Frame& F, const Args& A, bf16* MRG) {
    for (int unit = blockIdx.x; unit < 2 * NB * 4 * NCH; unit += F.G) { const bool m1_ = unit >= NB * 4 * NCH; const int u_ = m1_ ? unit - NB * 4 * NCH : unit, j = u_ % NCH, t_ = u_ / NCH;
        if (m1_) m3_unit<1, VAR>(F, A, t_ >> 2, t_ & 3, j, MRG); else m3_unit<0, VAR>(F, A, t_ >> 2, t_ & 3, j, MRG); }
}

template <bool FINAL> DI void phase_lru(const Frame& F, const Args& A) {
    LAS unsigned char* LXB = F.lds;
    LAS float* LXF = (LAS float*)(F.lds + 35904);
    LAS unsigned char* LXL = F.lds + 35904 + 67584;
    const bf16* P2 = WSP(bf16, WS_BIG); const bf16* LWT = WSP(bf16, WS_LWT); float* AGG = WSP(float, WS_AGG); bf16* MRG = WSP(bf16, WS_XN);
    for (int unit = blockIdx.x; unit < NB * NCH * 8; unit += F.G) {
        const int g = unit & 7, bj_ = unit >> 3, j = bj_ % NCH, b = bj_ / NCH;
        if (FINAL && j < 2) continue;
        const int tid = TID(F);
        const int lane = tid & 63, wave = F.wave, r16 = lane & 15, q4 = lane >> 4;
        const int R0 = chunk_row0(b, j), seq0 = j < 2 ? ML + b * CTXL : b * SEQ, seqlen = j < 2 ? CTXL : SEQ, t0 = R0 - seq0;
        for (int i = tid; i < 131 * 16; i += NTHR) { const int rr = i >> 4, c = i & 15, t = t0 - 2 + rr; v4u v = {0u, 0u, 0u, 0u};
            if (t >= 0 && t < seqlen) v = *(const v4u*)(P2 + (size_t)(seq0 + t) * CD_N + 1024 + 128 * g + 8 * c);
            *(LAS v4u*)(LXB + rr * 272 + c * 16) = v; }
        __syncthreads();
        { const int c2 = tid & 63; const float* cw = A.in[I_CONVW] + 128 * g + 2 * c2;
          const f32x2 w0 = *(const f32x2*)cw, w1 = *(const f32x2*)(cw + 1024), w2 = *(const f32x2*)(cw + 2048), w3 = *(const f32x2*)(cw + 3072), cb = *(const f32x2*)(A.in[I_CONVB] + 128 * g + 2 * c2);
#pragma unroll 4
          for (int k = 0; k < 16; ++k) { const int row = (tid >> 6) + 8 * k; const LAS unsigned* xp = (const LAS unsigned*)(LXB + row * 272 + c2 * 4);
              const unsigned x0 = xp[0], x1 = xp[68], x2 = xp[136], x3 = xp[204];
              const f32x2 xl = cb + w0 * (f32x2){bflo(x0), bfhi(x0)} + w1 * (f32x2){bflo(x1), bfhi(x1)} + w2 * (f32x2){bflo(x2), bfhi(x2)} + w3 * (f32x2){bflo(x3), bfhi(x3)};
              *(LAS f32x2*)(LXF + row * 132 + 2 * c2) = xl; *(LAS unsigned*)(LXL + row * 272 + c2 * 4) = pk2(xl.x, xl.y); } }
        __syncthreads();
        const int chb = 16 * wave + r16, ch = 128 * g + chb;
        float hsum[8][4];
        v4u yv[FINAL ? 4 : 1];
        if (FINAL) {
#pragma unroll
            for (int k = 0; k < 4; ++k) { const int p = tid + NTHR * k; yv[k] = *(const v4u*)(P2 + (size_t)(R0 + (p >> 4)) * CD_N + 128 * g + 8 * (p & 15)); }
            asm volatile("" ::: "memory"); }
#pragma unroll
        for (int d = 0; d < 2; ++d) {
            bf16x8 wa[4], wx[4];
#pragma unroll
            for (int s = 0; s < 4; ++s) { wa[s] = *(const bf16x8*)(LWT + (size_t)((2 * d) * 8 + g) * 16384 + chb * 128 + 32 * s + 8 * q4);
                                          wx[s] = *(const bf16x8*)(LWT + (size_t)((2 * d + 1) * 8 + g) * 16384 + chb * 128 + 32 * s + 8 * q4); }
            const float ba = A.in[I_LBA][d * 1024 + ch], bx = A.in[I_LBX][d * 1024 + ch], lam = A.in[I_LAM][d * 1024 + ch];
            const float sp8 = -8.f * (fmaxf(-lam, 0.f) + log1pf(__expf(-fabsf(lam))));
            const f32x2 nl2 = {-1.4426950408889634f, -1.4426950408889634f}, nba2 = {-1.4426950408889634f * ba, -1.4426950408889634f * ba}, nbx2 = {-1.4426950408889634f * bx, -1.4426950408889634f * bx}, sp8l2 = {1.4426950408889634f * sp8, 1.4426950408889634f * sp8}, cap2 = {60.f, 60.f};
            float carry = 0.f;
            if (FINAL) {
                const float* ag = AGG + ((size_t)(d * NB + b) * NCH) * 2048 + 2 * ch;
                const int kpos = d ? (j == 1 ? 0 : (j == 0 ? 1 : 35 - j)) : j;
#pragma unroll
                for (int kb = 0; kb < 1; ++kb) {
                    f32x2 ph[34];
#pragma unroll
                    for (int kk = 0; kk < 34; ++kk) { const int k = kk, jj = d ? (k == 0 ? 1 : (k == 1 ? 0 : 35 - k)) : k; ph[kk] = *(const f32x2*)(ag + (size_t)jj * 2048); }
                    asm volatile("" ::: "memory");
#pragma unroll
                    for (int kk = 0; kk < 34; ++kk) { const float cn = ph[kk].y + ph[kk].x * carry; carry = (kk < kpos) ? cn : carry; }
                }
            }
            float ptot = 1.f;
#pragma unroll
            for (int mm = 0; mm < 8; ++mm) {
                const int m = d ? 7 - mm : mm;
                f32x4 aa = {0.f, 0.f, 0.f, 0.f}, ax = {0.f, 0.f, 0.f, 0.f};
#pragma unroll
                for (int s = 0; s < 4; ++s) { const bf16x8 xf = frag_row(LXL, 272, 16 * m, 32 * s, lane); aa = mfma16(xf, wa[s], aa); ax = mfma16(xf, wx[s], ax); }
                float av[4], bv[4];
#pragma unroll
                for (int p = 0; p < 2; ++p) {
                    const int row = 16 * m + 4 * q4 + 2 * p;
                    const f32x2 xin = {LXF[row * 132 + chb], LXF[(row + 1) * 132 + chb]};
                    f32x2 ua = (f32x2){aa[2 * p], aa[2 * p + 1]} * nl2 + nba2, ux = (f32x2){ax[2 * p], ax[2 * p + 1]} * nl2 + nbx2;
                    ua = __builtin_elementwise_min(ua, cap2); ux = __builtin_elementwise_min(ux, cap2);
                    const f32x2 da = (f32x2){__builtin_amdgcn_exp2f(ua.x), __builtin_amdgcn_exp2f(ua.y)} + 1.f, dx = (f32x2){__builtin_amdgcn_exp2f(ux.x), __builtin_amdgcn_exp2f(ux.y)} + 1.f;
                    const f32x2 dd = da * dx; const f32x2 rr = {__builtin_amdgcn_rcpf(dd.x), __builtin_amdgcn_rcpf(dd.y)};
                    const f32x2 la = (rr * dx) * sp8l2, ig = rr * da;
                    const f32x2 a2 = {__builtin_amdgcn_exp2f(la.x), __builtin_amdgcn_exp2f(la.y)};
                    const f32x2 om = 1.f - a2 * a2;
                    const f32x2 bb = (f32x2){__builtin_amdgcn_sqrtf(om.x), __builtin_amdgcn_sqrtf(om.y)} * ig * xin;
                    av[2 * p] = a2.x; av[2 * p + 1] = a2.y; bv[2 * p] = bb.x; bv[2 * p + 1] = bb.y; }
                float P = 1.f, H = 0.f;
#pragma unroll
                for (int ii = 0; ii < 4; ++ii) { const int i = d ? 3 - ii : ii; H = av[i] * H + bv[i]; P *= av[i]; }
                float hstart = carry, cnext = carry;
#pragma unroll
                for (int qq_ = 0; qq_ < 4; ++qq_) { const int qq = d ? 3 - qq_ : qq_;
                    const float Pq = __shfl(P, r16 + 16 * qq), Hq = __shfl(H, r16 + 16 * qq);
                    const bool before = d ? (qq > q4) : (qq < q4);
                    if (before) hstart = Hq + Pq * hstart;
                    cnext = Hq + Pq * cnext; ptot *= Pq; }
                if (FINAL) { float hcur = hstart;
#pragma unroll
                    for (int ii = 0; ii < 4; ++ii) { const int i = d ? 3 - ii : ii; hcur = av[i] * hcur + bv[i]; if (d == 0) hsum[m][i] = hcur; else hsum[m][i] += hcur; } }
                carry = cnext;
                __builtin_amdgcn_sched_barrier(0);
            }
            if (!FINAL && q4 == 0) { f32x2 ph; ph.x = ptot; ph.y = carry; *(f32x2*)(AGG + ((size_t)(d * NB + b) * NCH + j) * 2048 + 2 * ch) = ph; }
        }
        if (FINAL) {
#pragma unroll
            for (int m = 0; m < 8; ++m)
#pragma unroll
                for (int i = 0; i < 4; ++i) LXF[(16 * m + 4 * q4 + i) * 132 + chb] = hsum[m][i];
            __syncthreads();
#pragma unroll
            for (int k = 0; k < 4; ++k) { const int p = tid + NTHR * k, row = p >> 4, c8 = 8 * (p & 15);
                const f32x4 h0 = *(const LAS f32x4*)(LXF + row * 132 + c8), h1 = *(const LAS f32x4*)(LXF + row * 132 + c8 + 4);
                v4u o; o.x = pk2(bflo(yv[k].x) * h0[0], bfhi(yv[k].x) * h0[1]); o.y = pk2(bflo(yv[k].y) * h0[2], bfhi(yv[k].y) * h0[3]);
                o.z = pk2(bflo(yv[k].z) * h1[0], bfhi(yv[k].z) * h1[1]); o.w = pk2(bflo(yv[k].w) * h1[2], bfhi(yv[k].w) * h1[3]);
                *(v4u*)(MRG + (size_t)(R0 + row) * DM + 128 * g + c8) = o; }
        }
        __syncthreads();
    }
}
DI void phase_mla_norm(const Frame& F, const Args& A) {
    const int lane = lane_id(), gw = blockIdx.x * NWAVES + F.wave, NGW = F.G * NWAVES;
    const bf16* P2 = WSP(bf16, WS_BIG); bf16* CQN = WSP(bf16, WS_CQN); bf16* CKVN = WSP(bf16, WS_CKVN);
    for (int row = gw; row < MT; row += NGW) {
        const v4u q = *(const v4u*)(P2 + (size_t)row * CD_N + 2048 + 8 * lane); const v2u k = *(const v2u*)(P2 + (size_t)row * CD_N + 2560 + 4 * lane);
        float qv[8] = {bflo(q.x), bfhi(q.x), bflo(q.y), bfhi(q.y), bflo(q.z), bfhi(q.z), bflo(q.w), bfhi(q.w)}, kv[4] = {bflo(k.x), bfhi(k.x), bflo(k.y), bfhi(k.y)};
        float sq = 0.f, sk = 0.f;
#pragma unroll
        for (int e = 0; e < 8; ++e) sq += qv[e] * qv[e];
#pragma unroll
        for (int e = 0; e < 4; ++e) sk += kv[e] * kv[e];
        const float rq = __frsqrt_rn(wave_sum(sq) * (1.f / 512.f) + EPS), rk = __frsqrt_rn(wave_sum(sk) * (1.f / 256.f) + EPS);
        const float* gq = A.in[I_QNG] + 8 * lane; const float* gk = A.in[I_KVNG] + 4 * lane;
        v4u oq; oq.x = pk2(qv[0] * rq * gq[0], qv[1] * rq * gq[1]); oq.y = pk2(qv[2] * rq * gq[2], qv[3] * rq * gq[3]); oq.z = pk2(qv[4] * rq * gq[4], qv[5] * rq * gq[5]); oq.w = pk2(qv[6] * rq * gq[6], qv[7] * rq * gq[7]);
        v2u ok; ok.x = pk2(kv[0] * rk * gk[0], kv[1] * rk * gk[1]); ok.y = pk2(kv[2] * rk * gk[2], kv[3] * rk * gk[3]);
        *(v4u*)(CQN + (size_t)row * 512 + 8 * lane) = oq; *(v2u*)(CKVN + (size_t)row * 256 + 4 * lane) = ok;
    }
}
DI void qk_head_norm(const v4u (&x)[3], const float (&g)[24], float scale, bool rot, const f32x4 (&cs)[2], const f32x4 (&sn)[2], int sub, bf16* op) {
    float v[24];
#pragma unroll
    for (int i = 0; i < 3; ++i) { v[8 * i] = bflo(x[i].x); v[8 * i + 1] = bfhi(x[i].x); v[8 * i + 2] = bflo(x[i].y); v[8 * i + 3] = bfhi(x[i].y); v[8 * i + 4] = bflo(x[i].z); v[8 * i + 5] = bfhi(x[i].z); v[8 * i + 6] = bflo(x[i].w); v[8 * i + 7] = bfhi(x[i].w); }
    float ss = 0.f;
#pragma unroll
    for (int i = 0; i < 24; ++i) ss += v[i] * v[i];
    ss += __shfl_xor(ss, 1); ss += __shfl_xor(ss, 2); ss += __shfl_xor(ss, 4);
    const float rs = __frsqrt_rn(ss * (1.f / 192.f) + EPS) * scale;
#pragma unroll
    for (int i = 0; i < 24; ++i) v[i] = v[i] * rs * g[i];
#pragma unroll
    for (int i = 0; i < 8; ++i) { const float own = v[16 + i], pr = __shfl_xor(own, 2); const float c = cs[i >> 2][i & 3], s_ = sn[i >> 2][i & 3];
        if (rot) v[16 + i] = (sub & 2) ? pr * s_ + own * c : own * c - pr * s_; }
    v4u o0, o1, o2;
    o0.x = pk2(v[0], v[1]); o0.y = pk2(v[2], v[3]); o0.z = pk2(v[4], v[5]); o0.w = pk2(v[6], v[7]);
    o1.x = pk2(v[8], v[9]); o1.y = pk2(v[10], v[11]); o1.z = pk2(v[12], v[13]); o1.w = pk2(v[14], v[15]);
    o2.x = pk2(v[16], v[17]); o2.y = pk2(v[18], v[19]); o2.z = pk2(v[20], v[21]); o2.w = pk2(v[22], v[23]);
    *(v4u*)(op + sub * 16) = o0; *(v4u*)(op + sub * 16 + 8) = o1; *(v4u*)(op + 128 + sub * 8) = o2;
}
DI void phase_qk_norm(const Frame& F, const Args& A) {
    const int lane = lane_id(), gw = blockIdx.x * NWAVES + F.wave, NGW = F.G * NWAVES, h = lane >> 3, sub = lane & 7;
    const bf16* P2 = WSP(bf16, WS_BIG); const bf16* QRAW = WSP(bf16, WS_A); const bf16* KVRAW = WSP(bf16, WS_KVRAW); bf16* QF = WSP(bf16, WS_QF); bf16* KF = WSP(bf16, WS_KF);
    const float* axc = WSP(float, WS_AXC); const float* axs = WSP(float, WS_AXS);
    const float* g0 = A.in[I_QKNG]; const float* g1 = g0 + 192;
    float gq[24], gk[24];
#pragma unroll
    for (int i = 0; i < 16; ++i) { gq[i] = g0[sub * 16 + i]; gk[i] = g1[sub * 16 + i]; }
#pragma unroll
    for (int i = 0; i < 8; ++i) { gq[16 + i] = g0[128 + sub * 8 + i]; gk[16 + i] = g1[128 + sub * 8 + i]; }
    constexpr float QS = 0.07216878364870323f * 1.4426950408889634f;
    for (int row = gw; row < MT; row += NGW) {
        const bool lat = row < ML;
        f32x4 cs[2] = {{1.f, 1.f, 1.f, 1.f}, {1.f, 1.f, 1.f, 1.f}}, sn[2] = {{0.f, 0.f, 0.f, 0.f}, {0.f, 0.f, 0.f, 0.f}};
        if (lat) { const int t = row & (SEQ - 1), pos = sub < 4 ? (t >> 6) : (t & 63); const f32x4* cp = (const f32x4*)(axc + pos * 16 + (sub & 1) * 8); const f32x4* sp = (const f32x4*)(axs + pos * 16 + (sub & 1) * 8);
            cs[0] = cp[0]; cs[1] = cp[1]; sn[0] = sp[0]; sn[1] = sp[1]; }
        v4u kx[3]; kx[0] = *(const v4u*)(KVRAW + (size_t)row * 2048 + h * 128 + sub * 16); kx[1] = *(const v4u*)(KVRAW + (size_t)row * 2048 + h * 128 + sub * 16 + 8); kx[2] = *(const v4u*)(P2 + (size_t)row * CD_N + 2816 + sub * 8);
        v4u qx[3];
        if (lat) { const bf16* qp = QRAW + (size_t)row * 1536 + h * 192; qx[0] = *(const v4u*)(qp + sub * 16); qx[1] = *(const v4u*)(qp + sub * 16 + 8); qx[2] = *(const v4u*)(qp + 128 + sub * 8); }
        else { qx[0] = kx[0]; qx[1] = kx[1]; qx[2] = kx[2]; }
        qk_head_norm(kx, gk, 1.f, lat, cs, sn, sub, KF + (size_t)row * 1536 + h * 192);
        if (lat) qk_head_norm(qx, gq, QS, true, cs, sn, sub, QF + (size_t)row * 1536 + h * 192);
    }
}
constexpr int AK_STRIDE = 400, AV_STRIDE = 288, AK_BYTES = 64 * AK_STRIDE, AV_BYTES = 64 * AV_STRIDE, ABUF = AK_BYTES + AV_BYTES;
DI int key_row(int b, int n) { return n < CTXL ? ML + b * CTXL + n : b * SEQ + (n - CTXL); }
constexpr int AKB = AK_BYTES, AVB = 64 * AV_STRIDE;
template <int VAR> DI void phase_attn(const Frame& F, const Args& A, bf16* MRG, int vcu) {
    const bf16* QF = WSP(bf16, WS_QF); const bf16* KF = WSP(bf16, WS_KF); const bf16* KVRAW = WSP(bf16, WS_KVRAW);
    constexpr int NT = (CTXL + SEQ) / 64;
    LAS unsigned char* KB0 = F.lds; LAS unsigned char* VB0 = F.lds + 2 * AKB;
    const unsigned kb_lds = (unsigned)(size_t)KB0, vb_lds = (unsigned)(size_t)VB0;
    const bool xa = F.G == 256; const int nit = xa ? 2 : (NB * 8 * 16 - (int)blockIdx.x + F.G - 1) / F.G;
    for (int it = 0; it < nit; ++it) {
        const int unit = xa ? (((it * 16 + (vcu & 7) * 2 + (vcu >> 7)) << 4) | ((vcu >> 3) & 15)) : (int)blockIdx.x + it * F.G;
        const int tid = TID(F);
        const int lane = tid & 63, wave = F.wave, r16 = lane & 15, q4 = lane >> 4;
        const int qb = unit & 15, h = (unit >> 4) & 7, b = unit >> 7;
        const size_t qrow0 = (size_t)b * SEQ + qb * 256 + 32 * wave + r16;
        bf16x8 qf[2][6];
#pragma unroll
        for (int qt = 0; qt < 2; ++qt)
#pragma unroll
            for (int s = 0; s < 6; ++s) qf[qt][s] = *(const bf16x8*)(QF + (qrow0 + 16 * qt) * 1536 + h * 192 + 32 * s + 8 * q4);
#define ATT_DMA_K(t, buf) do { _Pragma("unroll") for (int x = 0; x < 4; ++x) { const int ins = wave + 8 * x; if (ins < 25) { const int p = ins * 64 + lane, rr = p / 25, c0_ = p - rr * 25, c = c0_ == 24 ? 0 : c0_; \
            glds16(KF + (size_t)key_row(b, 64 * (t) + rr) * 1536 + h * 192 + 8 * c, kb_lds + (buf) * AKB + ins * 1024); } } } while (0)
#define ATT_DMA_V(t, buf) do { _Pragma("unroll") for (int x = 0; x < 3; ++x) { const int ins = wave + 8 * x; if (ins < 18) { const int p = ins * 64 + lane, rr = p / 18, c0_ = p - rr * 18, c = c0_ >= 16 ? 0 : c0_; \
            glds16(KVRAW + (size_t)key_row(b, 64 * (t) + rr) * 2048 + 1024 + h * 128 + 8 * c, vb_lds + (buf) * AVB + ins * 1024); } } } while (0)
        ATT_DMA_K(0, 0); ATT_DMA_V(0, 0);
        asm volatile("s_waitcnt vmcnt(0)" ::: "memory");
        __syncthreads();
        f32x4 o[2][8];
#pragma unroll
        for (int qt = 0; qt < 2; ++qt)
#pragma unroll
            for (int c = 0; c < 8; ++c) o[qt][c] = (f32x4){0.f, 0.f, 0.f, 0.f};
        float mrun[2] = {-1e30f, -1e30f}, lrun[2] = {0.f, 0.f};
#pragma unroll 1
        for (int t = 0; t < NT; ++t) {
            if (t + 1 < NT) { ATT_DMA_K(t + 1, (t + 1) & 1); ATT_DMA_V(t + 1, (t + 1) & 1); }
            const LAS unsigned char* kb = KB0 + (t & 1) * AKB; const LAS unsigned char* vb = VB0 + (t & 1) * AVB;
            f32x4 sc[2][4]; bf16x8 kf[2][6];
#pragma unroll
            for (int s = 0; s < 6; ++s) kf[0][s] = frag_row(kb, AK_STRIDE, 0, 32 * s, lane);
#pragma unroll
            for (int c = 0; c < 4; ++c) {
                if (c < 3) {
#pragma unroll
                    for (int s = 0; s < 6; ++s) kf[(c + 1) & 1][s] = frag_row(kb, AK_STRIDE, 16 * (c + 1), 32 * s, lane); }
                sc[0][c] = (f32x4){0.f, 0.f, 0.f, 0.f}; sc[1][c] = (f32x4){0.f, 0.f, 0.f, 0.f};
#pragma unroll
                for (int s = 0; s < ((VAR & 1) ? 1 : 6); ++s) { sc[0][c] = mfma16(kf[c & 1][s], qf[0][s], sc[0][c]); sc[1][c] = mfma16(kf[c & 1][s], qf[1][s], sc[1][c]); }
                __builtin_amdgcn_sched_barrier(0);
            }
            bf16x8 vf[2][4];
#define ATT_LOADV_GRP(dst, g_) do { _Pragma("unroll") for (int j = 0; j < 4; ++j) dst[j] = frag_tr(vb, AV_STRIDE, 32 * ((g_) >> 1) + 4 * q4, 32 * ((g_) >> 1) + 16 + 4 * q4, 16 * (4 * ((g_) & 1) + j), lane); } while (0)
            ATT_LOADV_GRP(vf[0], 0);
            bf16x8 pf[2][2];
#pragma unroll
            for (int qt = 0; qt < 2; ++qt) {
                float mx = fmaxf(fmaxf(fmaxf(sc[qt][0][0], sc[qt][0][1]), fmaxf(sc[qt][0][2], sc[qt][0][3])), fmaxf(fmaxf(sc[qt][1][0], sc[qt][1][1]), fmaxf(sc[qt][1][2], sc[qt][1][3])));
                mx = fmaxf(mx, fmaxf(fmaxf(fmaxf(sc[qt][2][0], sc[qt][2][1]), fmaxf(sc[qt][2][2], sc[qt][2][3])), fmaxf(fmaxf(sc[qt][3][0], sc[qt][3][1]), fmaxf(sc[qt][3][2], sc[qt][3][3]))));
                mx = fmaxf(mx, __shfl_xor(mx, 16)); mx = fmaxf(mx, __shfl_xor(mx, 32));
                float mnew = mrun[qt];
                if (__any(mx > mrun[qt] + 10.f)) {
                    mnew = fmaxf(mrun[qt], mx); const float alpha = __builtin_amdgcn_exp2f(mrun[qt] - mnew); mrun[qt] = mnew; lrun[qt] *= alpha;
#pragma unroll
                    for (int c = 0; c < 8; ++c) o[qt][c] = o[qt][c] * alpha;
                }
                float ps = 0.f;
#pragma unroll
                for (int c = 0; c < 4; ++c)
#pragma unroll
                    for (int i = 0; i < 4; ++i) { sc[qt][c][i] = __builtin_amdgcn_exp2f(sc[qt][c][i] - mnew); ps += sc[qt][c][i]; }
                lrun[qt] += ps;
#pragma unroll
                for (int s = 0; s < 2; ++s) { v4u pw; pw.x = pk2(sc[qt][2 * s][0], sc[qt][2 * s][1]); pw.y = pk2(sc[qt][2 * s][2], sc[qt][2 * s][3]); pw.z = pk2(sc[qt][2 * s + 1][0], sc[qt][2 * s + 1][1]); pw.w = pk2(sc[qt][2 * s + 1][2], sc[qt][2 * s + 1][3]);
                    pf[qt][s] = __builtin_bit_cast(bf16x8, pw); }
            }
            __builtin_amdgcn_sched_barrier(0);
#pragma unroll
            for (int g = 0; g < ((VAR & 4) ? 1 : 4); ++g) {
                if (g < 3) ATT_LOADV_GRP(vf[(g + 1) & 1], g + 1);
#pragma unroll
                for (int j = 0; j < 4; ++j) { const int c = 4 * (g & 1) + j; o[0][c] = mfma16(vf[g & 1][j], pf[0][g >> 1], o[0][c]); o[1][c] = mfma16(vf[g & 1][j], pf[1][g >> 1], o[1][c]); }
                __builtin_amdgcn_sched_barrier(0);
            }
#undef ATT_LOADV_GRP
            asm volatile("s_waitcnt vmcnt(0)" ::: "memory");
            __syncthreads();
        }
#undef ATT_DMA_K
#undef ATT_DMA_V
#pragma unroll
        for (int qt = 0; qt < 2; ++qt) {
            float l = lrun[qt]; l += __shfl_xor(l, 16); l += __shfl_xor(l, 32);
            const float inv = 1.f / l;
#pragma unroll
            for (int c = 0; c < 8; ++c) { v2u w; w.x = pk2(o[qt][c][0] * inv, o[qt][c][1] * inv); w.y = pk2(o[qt][c][2] * inv, o[qt][c][3] * inv); *(v2u*)(MRG + (qrow0 + 16 * qt) * DM + 1024 + h * 128 + 16 * c + 4 * q4) = w; }
        }
    }
}

#ifndef MK_KROT
#define MK_KROT 0
#endif
#define GEMM_PHASE(EPI, Aptr, Bptr, M_, N_, K_, Eobj) do { pg8::Gemm g_{(const pg8::bf16_t*)(Aptr), (const pg8::bf16_t*)(Bptr), (M_), (N_), (K_), (K_)}; pg8::StaticOrder S_; S_.init((M_), (N_), F.G, vcu, (MK_KROT) && (K_) >= 1024); \
        pg8::gemm_phase<EPI, pg8::StaticOrder, true, true>(F.lds, g_, S_, (Eobj)); } while (0)
#ifndef MK_FUSE_NORM
#define MK_FUSE_NORM 1
#endif
#define GEMM_RESID_NORM_SLICE(s_, Aptr, Bptr, K_, INL, GATE, SCALE, L_, WHICH_, STAGE_) { \
        const EpiResidNorm E_{(INL), XL, (GATE), A.in[I_NORMG] + (size_t)((L_) * 3 + (WHICH_)) * DM, MOD + (size_t)(L_) * 5 * MODW + 3 * (WHICH_) * DM, XN, \
                        WSP(float, WS_NSTAT) + (size_t)(STAGE_) * 64 * 256 * 8, (unsigned*)(A.ws + WS_CTL) + CW_NCNT + (STAGE_) * 4096, (unsigned*)(A.ws + WS_CTL) + CW_BAR, (SCALE)}; \
        const pg8::Gemm g_{(const pg8::bf16_t*)(Aptr), (const pg8::bf16_t*)(Bptr), ML, DM, (K_), (K_)}; \
        pg8::SliceOrder S_; S_.init(ML, DM, F.G, vcu, 0, 4); S_.s = (s_); \
        pg8::gemm_phase<EpiResidNorm, pg8::SliceOrder, true, true>(F.lds, g_, S_, E_); __syncthreads(); }
#define GEMM_RESID_NORM(Aptr, Bptr, K_, INL, GATE, SCALE, L_, WHICH_, STAGE_) do { \
        GEMM_RESID_NORM_SLICE(0, Aptr, Bptr, K_, INL, GATE, SCALE, L_, WHICH_, STAGE_) GEMM_RESID_NORM_SLICE(1, Aptr, Bptr, K_, INL, GATE, SCALE, L_, WHICH_, STAGE_) } while (0)
#define GEMM_CTX_SPLIT(Aptr, Bptr, KP, LDK) do { const int c_ = vcu, ks_ = c_ >> 5; int p0_, np_; \
        if ((KP) == 43) { np_ = ks_ < 3 ? 6 : 5; p0_ = ks_ < 3 ? 6 * ks_ : 18 + 5 * (ks_ - 3); } else { np_ = (KP) / 8; p0_ = np_ * ks_; } \
        pg8::Gemm g_{(const pg8::bf16_t*)(Aptr), (const pg8::bf16_t*)(Bptr), MC, DM, np_ * 128, (LDK)}; pg8::SplitOrder S_{c_, p0_ * 128}; EpiPartial E_{PART + (size_t)ks_ * MC * DM}; \
        pg8::gemm_phase<EpiPartial, pg8::SplitOrder, true, true>(F.lds, g_, S_, E_); } while (0)

DI void xcd_or_nothing(const XcdBarrier& bar, bool multi) { if (multi) xcd_barrier(bar); }
__global__ void __launch_bounds__(NTHR, 2) mk_fwd(Args A) {
    extern __shared__ __attribute__((aligned(16))) unsigned char lds_raw[];
    Frame F; F.lds = (LAS unsigned char*)lds_raw; F.wave = __builtin_amdgcn_readfirstlane((int)threadIdx.x >> 6); F.G = gridDim.x; F.a = &A;
    volatile LAS unsigned* MISC = (volatile LAS unsigned*)(F.lds + MISC_OFF);
    if (threadIdx.x < 64) MISC[threadIdx.x] = 0u;
    __syncthreads();
    const int lo = A.ph_lo, hi = A.ph_hi < MK_STOP_AFTER + 1 ? A.ph_hi : MK_STOP_AFTER + 1;
    const bool multi = (hi - lo) > 1;
    XcdBarrier bar; bar.bar = (unsigned*)(A.ws + WS_CTL) + CW_BAR; bar.x = 0; bar.st = nullptr; bar.w = F.wave;
    if (multi) bar = xcd_barrier_post((unsigned*)(A.ws + WS_CTL) + CW_BAR, MISC + 8);
    int vcu = (int)blockIdx.x;
    if (multi && F.G <= 256) { if (threadIdx.x == 0) { unsigned* ctl = (unsigned*)(A.ws + WS_CTL); const unsigned x = xb_xcc_id() & 7u; const unsigned rk = atomicAdd(&ctl[8192 + 64 * x], 1u);
            __hip_atomic_store(&ctl[16384 + blockIdx.x], rk * 8u + x + 1u, RLX_AGENT); } }
#ifndef MK_PHASE_MASK
#define MK_PHASE_MASK 0xFFFFFFFFull
#endif
#define IN(k) ((((MK_PHASE_MASK) >> (k)) & 1ull) && lo <= (k) && (k) < hi)
#if defined(MK_DOUBLE_BAR)
#define SEAM(k) do { if (IN((k) + 1)) { xcd_barrier(bar); xcd_barrier(bar); } } while (0)
#else
#define SEAM(k) do { if (IN((k) + 1)) xcd_barrier(bar); } while (0)
#endif
#ifndef MK_REPEAT_MASK
#define MK_REPEAT_MASK 0ull
#endif
#define REPK(k) ((int)(((MK_REPEAT_MASK) >> (k)) & 1ull))
    float* XL = A.out; float* XC = WSP(float, WS_XC); float* SCRL = WSP(float, WS_B); float* SCRC = WSP(float, WS_B + 128 * MiB); bf16* PART = WSP(bf16, WS_A); const CtxFix NOFIX{nullptr, nullptr, nullptr, 0.f}; const float* MOD = WSP(float, WS_MOD);
    bf16* XN = WSP(bf16, WS_XN); bf16* BIG = WSP(bf16, WS_BIG);

    if (IN(0)) { _Pragma("unroll") for (int rep = 0; rep < 1 + REPK(0); ++rep) { if (rep) xcd_or_nothing(bar, multi); phase_pre(F, A, rep == 0); } SEAM(0); }
    if (multi && F.G <= 256) {
        const unsigned* ctl = (const unsigned*)(A.ws + WS_CTL); LAS unsigned* cnt = (LAS unsigned*)(F.lds + MISC_OFF + 64);
        const int tid_ = TID(F);
        if (tid_ == 0) *cnt = 0u;
        __syncthreads();
        const unsigned mine = __hip_atomic_load(&ctl[16384 + blockIdx.x], RLX_AGENT);
        if (tid_ < F.G) { const unsigned kj = __hip_atomic_load(&ctl[16384 + tid_], RLX_AGENT); if (kj < mine) atomicAdd((unsigned*)cnt, 1u); }
        __syncthreads();
        vcu = (int)*cnt;
        __syncthreads();
    }
    if (IN(1)) { _Pragma("unroll") for (int rep = 0; rep < 1 + REPK(1); ++rep) { if (rep) xcd_or_nothing(bar, multi); phase_norm(F, A, 0, 0, MT, true, NOFIX); } SEAM(1); }
    if (IN(2)) { { EpiUp E{BIG}; GEMM_PHASE(EpiUp, XN, WSP(bf16, WS_WGU), MT, NGU, DM, E); }
#if defined(MK_PROBE_SAMETILE)
        { xcd_or_nothing(bar, multi); EpiUp E{(bf16*)SCRL}; pg8::Gemm g_{(const pg8::bf16_t*)XN, (const pg8::bf16_t*)WSP(bf16, WS_WGU), MT, NGU, DM, DM}; pg8::SameTileOrder S_; S_.init(MT, NGU, F.G, (int)blockIdx.x);
          pg8::gemm_phase<EpiUp, pg8::SameTileOrder, true, true>(F.lds, g_, S_, E); }
#endif
#if defined(MK_PROBE_NULLEPI)
        { xcd_or_nothing(bar, multi); EpiNull<true> E{SCRL + (size_t)blockIdx.x * 4096}; pg8::Gemm g_{(const pg8::bf16_t*)XN, (const pg8::bf16_t*)WSP(bf16, WS_WGU), MT, NGU, DM, DM}; pg8::StaticOrder S_; S_.init(MT, NGU, F.G, vcu);
          pg8::gemm_phase<EpiNull<true>, pg8::StaticOrder, true, true>(F.lds, g_, S_, E); }
#endif
#if defined(MK_PROBE_FEW)
        { xcd_or_nothing(bar, multi); EpiUp E{(bf16*)SCRL}; pg8::Gemm g_{(const pg8::bf16_t*)XN, (const pg8::bf16_t*)WSP(bf16, WS_WGU), MT, NGU, DM, DM}; pg8::FewTileOrder S_; S_.init(MT, NGU, F.G, vcu);
          pg8::gemm_phase<EpiUp, pg8::FewTileOrder, true, true>(F.lds, g_, S_, E); }
#endif
#if defined(MK_PROBE_FIX)
        { xcd_or_nothing(bar, multi); EpiUp E{(bf16*)SCRL}; pg8::Gemm g_{(const pg8::bf16_t*)XN, (const pg8::bf16_t*)WSP(bf16, WS_WGU), MT, NGU, DM, DM}; pg8::ProbeOrder<(MK_PROBE_FIX & 1) != 0, (MK_PROBE_FIX & 2) != 0> S_; S_.init(MT, NGU, F.G, vcu);
          pg8::gemm_phase<EpiUp, pg8::ProbeOrder<(MK_PROBE_FIX & 1) != 0, (MK_PROBE_FIX & 2) != 0>, true, true>(F.lds, g_, S_, E); }
#endif
        SEAM(2); }
#if MK_FUSE_NORM
    if (IN(3)) { GEMM_RESID_NORM(BIG, WSP(bf16, WS_WD), FF, A.in[I_X], MOD + 2 * DM, 0.5f, 0, 1, 0); GEMM_CTX_SPLIT(BIG + (size_t)ML * FF, WSP(bf16, WS_WD), 43, FF); SEAM(3); }
#else
    if (IN(3)) { _Pragma("unroll") for (int rep = 0; rep < 1 + REPK(3); ++rep) { if (rep) xcd_or_nothing(bar, multi); EpiResid E{A.in[I_X], A.in[I_CTX], rep ? SCRL : XL, rep ? SCRC : XC, MOD + 2 * DM, 0.5f}; GEMM_PHASE(EpiResid, BIG, WSP(bf16, WS_WD), ML, DM, FF, E); if (!rep) GEMM_CTX_SPLIT(BIG + (size_t)ML * FF, WSP(bf16, WS_WD), 43, FF); }
#if defined(MK_PROBE_NULLEPI_DOWN)
        { xcd_or_nothing(bar, multi); EpiNull<false> E{SCRL + (size_t)blockIdx.x * 4096}; pg8::Gemm g_{(const pg8::bf16_t*)BIG, (const pg8::bf16_t*)WSP(bf16, WS_WD), ML, DM, FF, FF}; pg8::StaticOrder S_; S_.init(ML, DM, F.G, vcu);
          pg8::gemm_phase<EpiNull<false>, pg8::StaticOrder, true, true>(F.lds, g_, S_, E); }
#endif
#if defined(MK_PROBE_SAMETILE_DOWN)
        { xcd_or_nothing(bar, multi); EpiResid E{A.in[I_X], A.in[I_CTX], SCRL, SCRC, MOD + 2 * DM, 0.5f}; pg8::Gemm g_{(const pg8::bf16_t*)BIG, (const pg8::bf16_t*)WSP(bf16, WS_WD), ML, DM, FF, FF}; pg8::SameTileOrder S_; S_.init(ML, DM, F.G, (int)blockIdx.x);
          pg8::gemm_phase<EpiResid, pg8::SameTileOrder, true, true>(F.lds, g_, S_, E); }
#endif
        SEAM(3); }
#endif
#if MK_FUSE_NORM
    if (IN(4)) { phase_norm(F, A, 0, 1, MT, false, CtxFix{A.in[I_CTX], PART, MOD + 4 * MODW + 2 * DM, 0.5f}, ML); SEAM(4); }
#else
    if (IN(4)) { _Pragma("unroll") for (int rep = 0; rep < 1 + REPK(4); ++rep) { if (rep) xcd_or_nothing(bar, multi); phase_norm(F, A, 0, 1, MT, false, CtxFix{A.in[I_CTX], PART, MOD + 4 * MODW + 2 * DM, 0.5f}); } SEAM(4); }
#endif
    if (IN(5)) { _Pragma("unroll") for (int rep = 0; rep < 1 + REPK(5); ++rep) { if (rep) xcd_or_nothing(bar, multi); EpiProjAB E{BIG, WSP(float, WS_GATES), A.in[I_GATEB], WSP(float, WS_ROPEC), WSP(float, WS_ROPES)}; GEMM_PHASE(EpiProjAB, XN, WSP(bf16, WS_ABWIN), MT, AB_N, DM, E); } SEAM(5); }
    if (IN(6)) { _Pragma("unroll") for (int rep = 0; rep < 1 + REPK(6); ++rep) { if (rep) xcd_or_nothing(bar, multi); phase_m1(F, A); } SEAM(6); }
    if (IN(7)) { _Pragma("unroll") for (int rep = 0; rep < 1 + REPK(7); ++rep) { if (rep) xcd_or_nothing(bar, multi); phase_m2(F, A); } SEAM(7); }
    if (IN(8)) { phase_m3<0>(F, A, XN);
#if defined(MK_PROBE_M3)
        xcd_or_nothing(bar, multi); phase_m3<MK_PROBE_M3>(F, A, (bf16*)SCRL);
#endif
        SEAM(8); }
#if MK_FUSE_NORM
    if (IN(9)) { GEMM_RESID_NORM(XN, WSP(bf16, WS_ABWOUT), DM, XL, MOD + 5 * DM, 1.f, 0, 2, 1); GEMM_CTX_SPLIT(XN + (size_t)ML * DM, WSP(bf16, WS_ABWOUT), 16, DM); SEAM(9); }
#else
    if (IN(9)) { _Pragma("unroll") for (int rep = 0; rep < 1 + REPK(9); ++rep) { if (rep) xcd_or_nothing(bar, multi); EpiResid E{XL, XC, rep ? SCRL : XL, rep ? SCRC : XC, MOD + 5 * DM, 1.f}; GEMM_PHASE(EpiResid, XN, WSP(bf16, WS_ABWOUT), ML, DM, DM, E); if (!rep) GEMM_CTX_SPLIT(XN + (size_t)ML * DM, WSP(bf16, WS_ABWOUT), 16, DM); } SEAM(9); }
#endif
#if MK_FUSE_NORM
    if (IN(10)) { phase_norm(F, A, 0, 2, MT, false, CtxFix{XC, PART, MOD + 4 * MODW + 5 * DM, 1.f}, ML); SEAM(10); }
#else
    if (IN(10)) { _Pragma("unroll") for (int rep = 0; rep < 1 + REPK(10); ++rep) { if (rep) xcd_or_nothing(bar, multi); phase_norm(F, A, 0, 2, MT, false, CtxFix{XC, PART, MOD + 4 * MODW + 5 * DM, 1.f}); } SEAM(10); }
#endif
    if (IN(11)) { _Pragma("unroll") for (int rep = 0; rep < 1 + REPK(11); ++rep) { if (rep) xcd_or_nothing(bar, multi); EpiUp E{BIG}; GEMM_PHASE(EpiUp, XN, WSP(bf16, WS_WGU) + (size_t)1 * NGU * DM, MT, NGU, DM, E); } SEAM(11); }
#if MK_FUSE_NORM
    if (IN(12)) { GEMM_RESID_NORM(BIG, WSP(bf16, WS_WD) + (size_t)1 * DM * FF, FF, XL, MOD + 8 * DM, 0.5f, 1, 0, 2); GEMM_CTX_SPLIT(BIG + (size_t)ML * FF, WSP(bf16, WS_WD) + (size_t)1 * DM * FF, 43, FF); SEAM(12); }
#else
    if (IN(12)) { _Pragma("unroll") for (int rep = 0; rep < 1 + REPK(12); ++rep) { if (rep) xcd_or_nothing(bar, multi); EpiResid E{XL, XC, rep ? SCRL : XL, rep ? SCRC : XC, MOD + 8 * DM, 0.5f}; GEMM_PHASE(EpiResid, BIG, WSP(bf16, WS_WD) + (size_t)1 * DM * FF, ML, DM, FF, E); if (!rep) GEMM_CTX_SPLIT(BIG + (size_t)ML * FF, WSP(bf16, WS_WD) + (size_t)1 * DM * FF, 43, FF); } SEAM(12); }
#endif
    const float* MOD1 = MOD + 5 * MODW;
#if MK_FUSE_NORM
    if (IN(13)) { phase_norm(F, A, 1, 0, MT, false, CtxFix{XC, PART, MOD + 4 * MODW + 8 * DM, 0.5f}, ML); SEAM(13); }
#else
    if (IN(13)) { _Pragma("unroll") for (int rep = 0; rep < 1 + REPK(13); ++rep) { if (rep) xcd_or_nothing(bar, multi); phase_norm(F, A, 1, 0, MT, false, CtxFix{XC, PART, MOD + 4 * MODW + 8 * DM, 0.5f}); } SEAM(13); }
#endif
    if (IN(14)) { _Pragma("unroll") for (int rep = 0; rep < 1 + REPK(14); ++rep) { if (rep) xcd_or_nothing(bar, multi); EpiUp E{BIG}; GEMM_PHASE(EpiUp, XN, WSP(bf16, WS_WGU) + (size_t)2 * NGU * DM, MT, NGU, DM, E); } SEAM(14); }
#if MK_FUSE_NORM
    if (IN(15)) { GEMM_RESID_NORM(BIG, WSP(bf16, WS_WD) + (size_t)2 * DM * FF, FF, XL, MOD1 + 2 * DM, 0.5f, 1, 1, 3); GEMM_CTX_SPLIT(BIG + (size_t)ML * FF, WSP(bf16, WS_WD) + (size_t)2 * DM * FF, 43, FF); SEAM(15); }
#else
    if (IN(15)) { _Pragma("unroll") for (int rep = 0; rep < 1 + REPK(15); ++rep) { if (rep) xcd_or_nothing(bar, multi); EpiResid E{XL, XC, rep ? SCRL : XL, rep ? SCRC : XC, MOD1 + 2 * DM, 0.5f}; GEMM_PHASE(EpiResid, BIG, WSP(bf16, WS_WD) + (size_t)2 * DM * FF, ML, DM, FF, E); if (!rep) GEMM_CTX_SPLIT(BIG + (size_t)ML * FF, WSP(bf16, WS_WD) + (size_t)2 * DM * FF, 43, FF); } SEAM(15); }
#endif
#if MK_FUSE_NORM
    if (IN(16)) { phase_norm(F, A, 1, 1, MT, false, CtxFix{XC, PART, MOD1 + 4 * MODW + 2 * DM, 0.5f}, ML); SEAM(16); }
#else
    if (IN(16)) { _Pragma("unroll") for (int rep = 0; rep < 1 + REPK(16); ++rep) { if (rep) xcd_or_nothing(bar, multi); phase_norm(F, A, 1, 1, MT, false, CtxFix{XC, PART, MOD1 + 4 * MODW + 2 * DM, 0.5f}); } SEAM(16); }
#endif
    if (IN(17)) { _Pragma("unroll") for (int rep = 0; rep < 1 + REPK(17); ++rep) { if (rep) xcd_or_nothing(bar, multi); EpiPlain E{BIG, CD_N, 4}; GEMM_PHASE(EpiPlain, XN, WSP(bf16, WS_CDWIN), MT, CD_N, DM, E); } SEAM(17); }
    if (IN(18)) { _Pragma("unroll") for (int rep = 0; rep < 1 + REPK(18); ++rep) { if (rep) xcd_or_nothing(bar, multi); phase_mla_norm(F, A); phase_lru<false>(F, A); } SEAM(18); }
    if (IN(19)) { _Pragma("unroll") for (int rep = 0; rep < 1 + REPK(19); ++rep) { if (rep) xcd_or_nothing(bar, multi); { EpiPlain E{WSP(bf16, WS_A), 1536, 0}; GEMM_PHASE(EpiPlain, WSP(bf16, WS_CQN), WSP(bf16, WS_WUQ), ML, 1536, 512, E); }
                  { EpiPlain E{WSP(bf16, WS_KVRAW), 2048, 0}; GEMM_PHASE(EpiPlain, WSP(bf16, WS_CKVN), WSP(bf16, WS_WUKV), MT, 2048, 256, E); }
                  phase_lru<true>(F, A); } SEAM(19); }
    if (IN(20)) { _Pragma("unroll") for (int rep = 0; rep < 1 + REPK(20); ++rep) { if (rep) xcd_or_nothing(bar, multi); phase_qk_norm(F, A); } SEAM(20); }
    if (IN(21)) { phase_attn<0>(F, A, XN, vcu);
#if defined(MK_PROBE_ATT)
        xcd_or_nothing(bar, multi); phase_attn<MK_PROBE_ATT>(F, A, (bf16*)SCRL, vcu);
#endif
        SEAM(21); }
#if MK_FUSE_NORM
    if (IN(22)) { GEMM_RESID_NORM(XN, WSP(bf16, WS_CDWOUT), DM, XL, MOD1 + 5 * DM, 1.f, 1, 2, 4); SEAM(22); }
#else
    if (IN(22)) { _Pragma("unroll") for (int rep = 0; rep < 1 + REPK(22); ++rep) { if (rep) xcd_or_nothing(bar, multi); EpiResid E{XL, XC, rep ? SCRL : XL, rep ? SCRC : XC, MOD1 + 5 * DM, 1.f}; GEMM_PHASE(EpiResid, XN, WSP(bf16, WS_CDWOUT), ML, DM, DM, E); } SEAM(22); }
#endif
#if MK_FUSE_NORM
#else
    if (IN(23)) { _Pragma("unroll") for (int rep = 0; rep < 1 + REPK(23); ++rep) { if (rep) xcd_or_nothing(bar, multi); phase_norm(F, A, 1, 2, ML, false, NOFIX); } SEAM(23); }
#endif
    if (IN(24)) { _Pragma("unroll") for (int rep = 0; rep < 1 + REPK(24); ++rep) { if (rep) xcd_or_nothing(bar, multi); EpiUp E{BIG}; GEMM_PHASE(EpiUp, XN, WSP(bf16, WS_WGU) + (size_t)3 * NGU * DM, ML, NGU, DM, E); } SEAM(24); }
    if (IN(25)) { _Pragma("unroll") for (int rep = 0; rep < 1 + REPK(25); ++rep) { if (rep) xcd_or_nothing(bar, multi); EpiResid E{XL, XC, rep ? SCRL : XL, rep ? SCRC : XC, MOD1 + 8 * DM, 0.5f}; GEMM_PHASE(EpiResid, BIG, WSP(bf16, WS_WD) + (size_t)3 * DM * FF, ML, DM, FF, E); } }
#undef IN
#undef SEAM
}

extern "C" void kernel_launch(void* const* d_in, const int* in_sizes, int n_in, void* d_out, int out_size, void* d_ws, size_t ws_size, hipStream_t stream) {
    static int grid = 0;
    if (grid == 0) {
        if (n_in != 31 || out_size != ML * DM || ws_size < WS_END) { fprintf(stderr, "kernel_launch: unexpected problem (n_in %d, out %d, ws %zu < %zu); nothing launched\n", n_in, out_size, ws_size, (size_t)WS_END); grid = -1; return; }
        int dev = 0, cus = 0, per_cu = 0;
        if (hipGetDevice(&dev) != hipSuccess || hipDeviceGetAttribute(&cus, hipDeviceAttributeMultiprocessorCount, dev) != hipSuccess) { grid = -1; return; }
        if (hipFuncSetAttribute((const void*)mk_fwd, hipFuncAttributeMaxDynamicSharedMemorySize, LDS_BYTES) != hipSuccess) { fprintf(stderr, "kernel_launch: hipFuncSetAttribute failed\n"); grid = -1; return; }
        if (hipOccupancyMaxActiveBlocksPerMultiprocessor(&per_cu, (const void*)mk_fwd, NTHR, LDS_BYTES) != hipSuccess || per_cu < 1 || cus < 256) {
            fprintf(stderr, "kernel_launch: the occupancy query reports %d workgroups per CU on %d CUs; the grid barrier needs 256 resident workgroups; nothing launched\n", per_cu, cus); (void)hipGetLastError(); grid = -1; return; }
        (void)hipGetLastError();
        grid = 256;
    }
    if (grid < 0) return;
    if (hipMemsetAsync((char*)d_ws + WS_CTL, 0, CTL_ZERO_BYTES, stream) != hipSuccess) return;
    Args a{};
    for (int i = 0; i < 31; ++i) a.in[i] = (const float*)d_in[i];
    a.out = (float*)d_out; a.ws = (unsigned char*)d_ws;
#if MK_ONE_LAUNCH
    a.ph_lo = 0; a.ph_hi = NPHASE;
    hipLaunchKernelGGL(mk_fwd, dim3(grid), dim3(NTHR), LDS_BYTES, stream, a);
#else
    for (int ph = 0; ph < NPHASE && ph <= MK_STOP_AFTER; ++ph) { a.ph_lo = ph; a.ph_hi = ph + 1; hipLaunchKernelGGL(mk_fwd, dim3(grid), dim3(NTHR), LDS_BYTES, stream, a); }
#endif
#if defined(MK_DEBUG_HASH)
    hipLaunchKernelGGL(dbg_hash, dim3(2048), dim3(256), 0, stream, a);
    hipLaunchKernelGGL(dbg_hash_apply, dim3(1024), dim3(256), 0, stream, a);
#endif
#if defined(MK_DEBUG_CHECKS)
    hipLaunchKernelGGL(dbg_checks, dim3(1), dim3(256), 0, stream, a);
    hipLaunchKernelGGL(dbg_apply, dim3(1024), dim3(256), 0, stream, a);
#endif
}
```
